# Optimizing an MI355X kernel written in HIP

```python
import jax, jax.numpy as jnp
from jax import lax
import numpy as np

D_MODEL = 1024
BATCH = 2
SEQ = 8192
DEPTH = 4
DEC_BATCH = 32
DEC_SEQ = 1
PAST_LEN = 8192
PAGE_SIZE = 128

HEAD_DIM = 64
SCALE = HEAD_DIM ** -0.5
N_MIXERS = 2
N_A_LAYERS = (DEPTH + 1) // N_MIXERS
N_B_LAYERS = DEPTH // N_MIXERS
RMS_EPS = 1e-6
N_MEM = 256
X_HEADS = 4
X_WIDTH = X_HEADS * HEAD_DIM
A_PATTERNS = ((128, 1), (512, 4), (2048, 16))
A_GROUPS = len(A_PATTERNS)
A_HEADS = 4
A_WIDTH = A_HEADS * HEAD_DIM
A_QKV = 3 * A_GROUPS * A_WIDTH
W_IN_A = A_QKV + A_WIDTH + 2 * X_WIDTH
B_HEADS = 12
B_KV = 2
B_GROUP = B_HEADS // B_KV
B_WIDTH = B_HEADS * HEAD_DIM
B_KV_WIDTH = 6 * B_KV * HEAD_DIM
W_IN_B = B_WIDTH + B_KV_WIDTH + 3 * B_HEADS + B_WIDTH + 2 * X_WIDTH
CMP_LEN = 32
CMP_STRIDE = 16
CMP_HIDDEN = 128
SEL_BLOCK = 64
SEL_TOPK = 16
WIN_B = 512
Q_BLOCK = 128
FORCE_SCORE = 1e4

kernel_name = "hybrid_dilated_nsa_memory_decoder_step"


def _rms(x, g):
    xf = x.astype(jnp.float32)
    y = xf * lax.rsqrt(jnp.mean(xf * xf, axis=-1, keepdims=True) + RMS_EPS)
    return (y * g.astype(jnp.float32)).astype(x.dtype)


def _alibi_slopes(n):
    return 2.0 ** (-8.0 * jnp.arange(1, n + 1, dtype=jnp.float32) / n)


def _masked_softmax(s, mask):
    s = jnp.where(mask, s, -jnp.inf)
    m = jnp.max(s, axis=-1, keepdims=True)
    m = jnp.where(jnp.isfinite(m), m, 0.0)
    e = jnp.where(mask, jnp.exp(s - m), 0.0)
    den = jnp.maximum(jnp.sum(e, axis=-1, keepdims=True), 1e-30)
    return e / den, (m + jnp.log(den))[..., 0]


def _cross(qx, mkv):
    s = jnp.einsum('nthe,nmhe->nhtm', qx, mkv[:, :, 0], preferred_element_type=jnp.float32) * SCALE
    p = jax.nn.softmax(s, axis=-1)
    return jnp.einsum('nhtm,nmhe->nthe', p.astype(mkv.dtype), mkv[:, :, 1])


def _finish(x, mix, gate_m, qx, gate_x, mkv, w_out, g_post):
    n, t = x.shape[:2]
    cx = _cross(qx, mkv).reshape(n, t, X_WIDTH)
    z = jnp.concatenate([mix.astype(x.dtype) * jax.nn.silu(gate_m), cx * jax.nn.silu(gate_x)], axis=-1)
    return x + _rms(z @ w_out, g_post)


def _split_a(proj):
    n, t, _ = proj.shape
    qkv = proj[..., :A_QKV].reshape(n, t, 3, A_GROUPS, A_HEADS, HEAD_DIM)
    gate_m = proj[..., A_QKV:A_QKV + A_WIDTH]
    qx = proj[..., A_QKV + A_WIDTH:A_QKV + A_WIDTH + X_WIDTH].reshape(n, t, X_HEADS, HEAD_DIM)
    gate_x = proj[..., A_QKV + A_WIDTH + X_WIDTH:]
    return qkv, gate_m, qx, gate_x


def _dilated_group_prompt(q, k, v, dil, n_back, slopes):
    n, s_len, h, e = q.shape
    c = n_back
    span = dil * c
    s_pad = -(-s_len // span) * span
    u = s_pad // dil
    nb = u // c

    def to_blocks(t):
        t = jnp.pad(t, ((0, 0), (0, s_pad - s_len), (0, 0), (0, 0)))
        t = t.reshape(n, u, dil, h, e).transpose(0, 2, 1, 3, 4)
        return t.reshape(n, dil, nb, c, h, e)

    def with_prev(t):
        prev = jnp.pad(t, ((0, 0), (0, 0), (1, 0), (0, 0), (0, 0), (0, 0)))[:, :, :-1]
        return jnp.concatenate([prev, t], axis=3)

    qb = to_blocks(q)
    kk = with_prev(to_blocks(k))
    vv = with_prev(to_blocks(v))
    i = jnp.arange(c)[:, None]
    j = jnp.arange(2 * c)[None, :]
    back = c + i - j
    blk = jnp.arange(nb)[:, None, None]
    valid = (back >= 0) & (back <= n_back) & ((blk > 0) | (j >= c))
    s = jnp.einsum('nrbihe,nrbjhe->nrbhij', qb, kk, preferred_element_type=jnp.float32) * SCALE
    s = s - slopes[:, None, None] * (back * dil).astype(jnp.float32)
    p, lse = _masked_softmax(s, valid[:, None])
    o = jnp.einsum('nrbhij,nrbjhe->nrbihe', p.astype(v.dtype), vv)
    o = o.reshape(n, dil, u, h, e).transpose(0, 2, 1, 3, 4).reshape(n, s_pad, h, e)[:, :s_len]
    lse = lse.transpose(0, 1, 2, 4, 3).reshape(n, dil, u, h).transpose(0, 2, 1, 3).reshape(n, s_pad, h)[:, :s_len]
    return o, lse


def _dilated_group_step(q, kk, vv, lb, dil, n_back, slopes):
    t = q.shape[1]
    jj = jnp.arange(n_back + 1)
    idx = lb + jnp.arange(t)[:, None] - jj[None, :] * dil
    valid = idx >= 0
    idx = jnp.maximum(idx, 0)
    kg = kk[:, idx]
    vg = vv[:, idx]
    s = jnp.einsum('nthe,ntjhe->nhtj', q, kg, preferred_element_type=jnp.float32) * SCALE
    s = s - slopes[:, None, None] * (jj * dil).astype(jnp.float32)
    p, lse = _masked_softmax(s, valid)
    o = jnp.einsum('nhtj,ntjhe->nthe', p.astype(vv.dtype), vg)
    return o, lse.transpose(0, 2, 1)


def _dilated_combine(outs, lses):
    w = jax.nn.softmax(jnp.stack(lses, axis=0), axis=0)
    o = jnp.einsum('gnth,gnthe->nthe', w, jnp.stack(outs, axis=0).astype(jnp.float32))
    n, t = o.shape[:2]
    return o.reshape(n, t, A_WIDTH)


def _mixer_a_prompt(qkv, slopes):
    s_len = qkv.shape[1]
    outs, lses, bufs = [], [], []
    for g, (win, dil) in enumerate(A_PATTERNS):
        o, lse = _dilated_group_prompt(qkv[:, :, 0, g], qkv[:, :, 1, g], qkv[:, :, 2, g], dil, win // dil, slopes[g])
        outs.append(o)
        lses.append(lse)
        bufs.append(qkv[:, s_len - min(win, s_len):, 1:, g])
    return _dilated_combine(outs, lses), bufs


def _mixer_a_step(qkv, bufs, slopes):
    outs, lses, rows_new = [], [], []
    for g, (win, dil) in enumerate(A_PATTERNS):
        new = qkv[:, :, 1:, g]
        rows = jnp.concatenate([bufs[g], new], axis=1)
        o, lse = _dilated_group_step(qkv[:, :, 0, g], rows[:, :, 0], rows[:, :, 1], bufs[g].shape[1], dil, win // dil, slopes[g])
        outs.append(o)
        lses.append(lse)
        rows_new.append(new)
    return _dilated_combine(outs, lses), rows_new


def _split_b(proj):
    n, t, _ = proj.shape
    o1 = B_WIDTH
    o2 = o1 + B_KV_WIDTH
    o3 = o2 + 3 * B_HEADS
    o4 = o3 + B_WIDTH
    o5 = o4 + X_WIDTH
    q = proj[..., :o1].reshape(n, t, B_KV, B_GROUP, HEAD_DIM)
    kv6 = proj[..., o1:o2].reshape(n, t, 6, B_KV, HEAD_DIM)
    gates = jax.nn.sigmoid(proj[..., o2:o3].astype(jnp.float32)).reshape(n, t, B_KV, B_GROUP, 3)
    return q, kv6, gates, proj[..., o3:o4], proj[..., o4:o5].reshape(n, t, X_HEADS, HEAD_DIM), proj[..., o5:]


def _compress(k, pos_emb, w1, w2):
    n, l, kv, e = k.shape
    c = (l - CMP_LEN) // CMP_STRIDE + 1
    idx = jnp.arange(c)[:, None] * CMP_STRIDE + jnp.arange(CMP_LEN)[None, :]
    blocks = k[:, idx] + pos_emb[:, None, :]
    flat = blocks.transpose(0, 1, 3, 2, 4).reshape(n, c, kv, CMP_LEN * e)
    return jax.nn.silu(flat @ w1) @ w2


def _to_sel_blocks(k, n_sel):
    n, l, kv, e = k.shape
    k = jnp.pad(k, ((0, 0), (0, n_sel * SEL_BLOCK - l), (0, 0), (0, 0)))
    return k.reshape(n, n_sel, SEL_BLOCK, kv, e).transpose(0, 3, 1, 2, 4)


def _block_importance(p, n_sel):
    c = p.shape[-1]
    per = SEL_BLOCK // CMP_STRIDE
    ov = CMP_LEN // CMP_STRIDE
    length = n_sel * per
    pp = jnp.pad(p, [(0, 0)] * (p.ndim - 1) + [(ov - 1, length - c)])
    r = sum(pp[..., ov - 1 - m:ov - 1 - m + length] for m in range(ov))
    return r.reshape(p.shape[:-1] + (n_sel, per)).sum(-1)


def _nsa_core(q, q_pos, gates, kcmp, vcmp, c_end, ksb, vsb, kw, vw, kw_pos, slopes):
    n, t, kv, g, e = q.shape
    tq = q_pos[:, None]
    sl = slopes[:, :, None, None]
    s = jnp.einsum('ntkge,ncke->nkgtc', q, kcmp, preferred_element_type=jnp.float32) * SCALE
    s = s - sl * (tq - c_end[None, :]).astype(jnp.float32)
    p_c, _ = _masked_softmax(s, c_end[None, :] <= tq)
    o_c = jnp.einsum('nkgtc,ncke->ntkge', p_c.astype(vcmp.dtype), vcmp)
    n_sel = ksb.shape[2]
    imp = _block_importance(p_c.sum(2), n_sel)
    blk = jnp.arange(n_sel)[None, :]
    cur = tq // SEL_BLOCK
    forced = (blk == 0) | (blk == cur) | (blk == cur - 1)
    imp = jnp.where(blk * SEL_BLOCK > tq, -jnp.inf, jnp.where(forced, FORCE_SCORE, imp))
    _, sel = lax.top_k(imp, min(SEL_TOPK, n_sel))
    gather = jax.vmap(jax.vmap(lambda blocks, ix: blocks[ix]))
    kg = gather(ksb, sel)
    vg = gather(vsb, sel)
    kpos = sel[..., None] * SEL_BLOCK + jnp.arange(SEL_BLOCK)
    dist = q_pos[:, None, None] - kpos
    s = jnp.einsum('ntkge,nktjse->nkgtjs', q, kg, preferred_element_type=jnp.float32) * SCALE
    s = s - slopes[None, :, :, None, None, None] * dist[:, :, None].astype(jnp.float32)
    kk = sel.shape[-1] * SEL_BLOCK
    p_s, _ = _masked_softmax(s.reshape(n, kv, g, t, kk), (dist >= 0)[:, :, None].reshape(n, kv, 1, t, kk))
    o_s = jnp.einsum('nkgtx,nktxe->ntkge', p_s.astype(vg.dtype), vg.reshape(n, kv, t, kk, e))
    dw = tq - kw_pos[None, :]
    s = jnp.einsum('ntkge,nlke->nkgtl', q, kw, preferred_element_type=jnp.float32) * SCALE
    s = s - sl * dw.astype(jnp.float32)
    p_w, _ = _masked_softmax(s, (dw >= 0) & (dw <= WIN_B) & (kw_pos[None, :] >= 0))
    o_w = jnp.einsum('nkgtl,nlke->ntkge', p_w.astype(vw.dtype), vw)
    return gates[..., 0:1] * o_c + gates[..., 1:2] * o_s + gates[..., 2:3] * o_w


def _cmp_pair(kc, vc, cmp_pos, cmp_w1, cmp_w2):
    kcmp = _compress(kc, cmp_pos[0], cmp_w1[0], cmp_w2[0])
    vcmp = _compress(vc, cmp_pos[1], cmp_w1[1], cmp_w2[1])
    c_end = jnp.arange(kcmp.shape[1]) * CMP_STRIDE + CMP_LEN - 1
    return kcmp, vcmp, c_end


def _mixer_b_prompt(q, kv6, gates, slopes, cmp_pos, cmp_w1, cmp_w2):
    n, s_len = q.shape[:2]
    kcmp, vcmp, c_end = _cmp_pair(kv6[:, :, 0], kv6[:, :, 1], cmp_pos, cmp_w1, cmp_w2)
    n_sel = -(-s_len // SEL_BLOCK)
    ksb = _to_sel_blocks(kv6[:, :, 2], n_sel)
    vsb = _to_sel_blocks(kv6[:, :, 3], n_sel)
    pad = ((0, 0), (WIN_B, 0), (0, 0), (0, 0))
    kw_pad = jnp.pad(kv6[:, :, 4], pad)
    vw_pad = jnp.pad(kv6[:, :, 5], pad)

    def one(b):
        start = b * Q_BLOCK
        qb = lax.dynamic_slice_in_dim(q, start, Q_BLOCK, axis=1)
        gb = lax.dynamic_slice_in_dim(gates, start, Q_BLOCK, axis=1)
        kwb = lax.dynamic_slice_in_dim(kw_pad, start, Q_BLOCK + WIN_B, axis=1)
        vwb = lax.dynamic_slice_in_dim(vw_pad, start, Q_BLOCK + WIN_B, axis=1)
        q_pos = start + jnp.arange(Q_BLOCK)
        kw_pos = start - WIN_B + jnp.arange(Q_BLOCK + WIN_B)
        return _nsa_core(qb, q_pos, gb, kcmp, vcmp, c_end, ksb, vsb, kwb, vwb, kw_pos, slopes)

    o = lax.map(one, jnp.arange(s_len // Q_BLOCK))
    o = o.transpose(1, 0, 2, 3, 4, 5).reshape(n, s_len, B_WIDTH)
    return o, kv6[:, :, :4], kv6[:, s_len - min(WIN_B, s_len):, 4:]


def _mixer_b_step(q, kv6, gates, past_rows, win_buf, past_len, slopes, cmp_pos, cmp_w1, cmp_w2):
    n, t = q.shape[:2]
    rows = jnp.concatenate([past_rows, kv6[:, :, :4]], axis=1)
    kcmp, vcmp, c_end = _cmp_pair(rows[:, :, 0], rows[:, :, 1], cmp_pos, cmp_w1, cmp_w2)
    n_sel = -(-rows.shape[1] // SEL_BLOCK)
    ksb = _to_sel_blocks(rows[:, :, 2], n_sel)
    vsb = _to_sel_blocks(rows[:, :, 3], n_sel)
    lb = win_buf.shape[1]
    win = jnp.concatenate([win_buf, kv6[:, :, 4:]], axis=1)
    q_pos = past_len + jnp.arange(t)
    kw_pos = past_len - lb + jnp.arange(lb + t)
    o = _nsa_core(q, q_pos, gates, kcmp, vcmp, c_end, ksb, vsb, win[:, :, 0], win[:, :, 1], kw_pos, slopes)
    return o.reshape(n, t, B_WIDTH), kv6[:, :, :4], kv6[:, :, 4:]


def setup_inputs(seed: int = 0) -> dict:
    key = jax.random.key(seed)
    ks = jax.random.split(key, 24)
    nrm = jax.random.normal
    n_pages = PAST_LEN // PAGE_SIZE
    n_used = DEC_BATCH * n_pages
    n_pool = n_used + -(-n_used // 4)
    return {
        "x_prompt": nrm(ks[0], (BATCH, SEQ, D_MODEL), jnp.float32),
        "x_sample": nrm(ks[1], (DEC_BATCH, DEC_SEQ, D_MODEL), jnp.float32),
        "cache_mem_kv": nrm(ks[2], (DEPTH, DEC_BATCH, N_MEM, 2, X_HEADS, HEAD_DIM), jnp.float32),
        "cache_a_w128_kv": nrm(ks[3], (N_A_LAYERS, DEC_BATCH, min(A_PATTERNS[0][0], PAST_LEN), 2, A_HEADS, HEAD_DIM), jnp.float32),
        "cache_a_w512_kv": nrm(ks[4], (N_A_LAYERS, DEC_BATCH, min(A_PATTERNS[1][0], PAST_LEN), 2, A_HEADS, HEAD_DIM), jnp.float32),
        "cache_a_w2048_kv": nrm(ks[5], (N_A_LAYERS, DEC_BATCH, min(A_PATTERNS[2][0], PAST_LEN), 2, A_HEADS, HEAD_DIM), jnp.float32),
        "cache_b_pages": nrm(ks[6], (n_pool, PAGE_SIZE, N_B_LAYERS, 4, B_KV, HEAD_DIM), jnp.float32),
        "cache_b_win_kv": nrm(ks[7], (N_B_LAYERS, DEC_BATCH, min(WIN_B, PAST_LEN), 2, B_KV, HEAD_DIM), jnp.float32),
        "page_table": jax.random.permutation(ks[8], n_pool)[:n_used].reshape(DEC_BATCH, n_pages).astype(jnp.int32),
        "mem_prompt": nrm(ks[9], (BATCH, N_MEM, D_MODEL), jnp.float32),
        "norm_pre": 1.0 + 0.05 * nrm(ks[10], (DEPTH, D_MODEL), jnp.float32),
        "norm_post": 1.0 + 0.05 * nrm(ks[11], (DEPTH, D_MODEL), jnp.float32),
        "norm_mem": 1.0 + 0.05 * nrm(ks[12], (DEPTH, D_MODEL), jnp.float32),
        "w_mem_kv": nrm(ks[13], (DEPTH, D_MODEL, 2 * X_WIDTH), jnp.float32) * D_MODEL ** -0.5,
        "w_in_a": nrm(ks[14], (N_A_LAYERS, D_MODEL, W_IN_A), jnp.float32) * D_MODEL ** -0.5,
        "w_out_a": nrm(ks[15], (N_A_LAYERS, A_WIDTH + X_WIDTH, D_MODEL), jnp.float32) * (A_WIDTH + X_WIDTH) ** -0.5,
        "w_in_b": nrm(ks[16], (N_B_LAYERS, D_MODEL, W_IN_B), jnp.float32) * D_MODEL ** -0.5,
        "w_out_b": nrm(ks[17], (N_B_LAYERS, B_WIDTH + X_WIDTH, D_MODEL), jnp.float32) * (B_WIDTH + X_WIDTH) ** -0.5,
        "cmp_pos": 0.02 * nrm(ks[18], (N_B_LAYERS, 2, CMP_LEN, HEAD_DIM), jnp.float32),
        "cmp_w1": nrm(ks[19], (N_B_LAYERS, 2, CMP_LEN * HEAD_DIM, CMP_HIDDEN), jnp.float32) * (CMP_LEN * HEAD_DIM) ** -0.5,
        "cmp_w2": nrm(ks[20], (N_B_LAYERS, 2, CMP_HIDDEN, HEAD_DIM), jnp.float32) * CMP_HIDDEN ** -0.5,
    }


def reference(x_prompt, x_sample, cache_mem_kv, cache_a_w128_kv, cache_a_w512_kv, cache_a_w2048_kv,
              cache_b_pages, cache_b_win_kv, page_table, mem_prompt, norm_pre, norm_post, norm_mem,
              w_mem_kv, w_in_a, w_out_a, w_in_b, w_out_b, cmp_pos, cmp_w1, cmp_w2):
    cache_a = (cache_a_w128_kv, cache_a_w512_kv, cache_a_w2048_kv)
    n_pages = page_table.shape[1]
    past_len = n_pages * cache_b_pages.shape[1]
    slopes_a = _alibi_slopes(A_GROUPS * A_HEADS).reshape(A_GROUPS, A_HEADS)
    slopes_b = _alibi_slopes(B_HEADS).reshape(B_KV, B_GROUP)
    xp, xs = x_prompt, x_sample
    n_p, n_s = xp.shape[0], xs.shape[0]
    mem_new = []
    a_p = [[] for _ in A_PATTERNS]
    a_s = [[] for _ in A_PATTERNS]
    b_p, b_s, bw_p, bw_s = [], [], [], []
    for i in range(DEPTH):
        li = i // N_MIXERS
        hp = _rms(xp, norm_pre[i])
        hs = _rms(xs, norm_pre[i])
        mkv_p = (_rms(mem_prompt, norm_mem[i]) @ w_mem_kv[i]).reshape(n_p, N_MEM, 2, X_HEADS, HEAD_DIM)
        mem_new.append(mkv_p)
        mkv_s = cache_mem_kv[i]
        if i % N_MIXERS == 0:
            qkv_p, gm_p, qx_p, gx_p = _split_a(hp @ w_in_a[li])
            qkv_s, gm_s, qx_s, gx_s = _split_a(hs @ w_in_a[li])
            mix_p, bufs_p = _mixer_a_prompt(qkv_p, slopes_a)
            mix_s, rows_s = _mixer_a_step(qkv_s, [c[li] for c in cache_a], slopes_a)
            for g in range(A_GROUPS):
                a_p[g].append(bufs_p[g])
                a_s[g].append(rows_s[g])
            w_out = w_out_a[li]
        else:
            q_p, kv6_p, gt_p, gm_p, qx_p, gx_p = _split_b(hp @ w_in_b[li])
            q_s, kv6_s, gt_s, gm_s, qx_s, gx_s = _split_b(hs @ w_in_b[li])
            mix_p, rows_p, win_p = _mixer_b_prompt(q_p, kv6_p, gt_p, slopes_b, cmp_pos[li], cmp_w1[li], cmp_w2[li])
            past = cache_b_pages[page_table, :, li].reshape(n_s, past_len, 4, B_KV, HEAD_DIM)
            mix_s, rows_s, win_s = _mixer_b_step(q_s, kv6_s, gt_s, past, cache_b_win_kv[li], past_len, slopes_b,
                                                 cmp_pos[li], cmp_w1[li], cmp_w2[li])
            b_p.append(rows_p)
            b_s.append(rows_s)
            bw_p.append(win_p)
            bw_s.append(win_s)
            w_out = w_out_b[li]
        xp = _finish(xp, mix_p, gm_p, qx_p, gx_p, mkv_p, w_out, norm_post[i])
        xs = _finish(xs, mix_s, gm_s, qx_s, gx_s, mkv_s, w_out, norm_post[i])
    p_mem_kv = jnp.stack(mem_new, axis=0)
    p_a_w128_kv = jnp.stack(a_p[0], axis=0)
    p_a_w512_kv = jnp.stack(a_p[1], axis=0)
    p_a_w2048_kv = jnp.stack(a_p[2], axis=0)
    p_b_rows = jnp.stack(b_p, axis=2)
    p_b_win_kv = jnp.stack(bw_p, axis=0)
    s_a_w128_kv = jnp.stack(a_s[0], axis=0)
    s_a_w512_kv = jnp.stack(a_s[1], axis=0)
    s_a_w2048_kv = jnp.stack(a_s[2], axis=0)
    s_b_rows = jnp.stack(b_s, axis=2)
    s_b_win_kv = jnp.stack(bw_s, axis=0)
    return (xp, xs, p_mem_kv, p_a_w128_kv, p_a_w512_kv, p_a_w2048_kv, p_b_rows, p_b_win_kv,
            s_a_w128_kv, s_a_w512_kv, s_a_w2048_kv, s_b_rows, s_b_win_kv)
```

```cpp
#include <hip/hip_runtime.h>
#include <cstring>
#include <cmath>

#ifdef SMALL
constexpr int D = 128, NB = 1, S = 2048, NS = 2, PL = 2048, NM = 32;
#else
constexpr int D = 1024, NB = 2, S = 8192, NS = 32, PL = 8192, NM = 256;
#endif
constexpr int MP = NB * S, M = MP + NS;
constexpr int MPAD = ((M + 255) / 256) * 256;
constexpr int WP = 3072;
constexpr int W_IN_B = 2852;
constexpr int NPAGES = PL / 128;
constexpr int NC_P = (S - 32) / 16 + 1;
constexpr int NC_S = (PL + 1 - 32) / 16 + 1;
constexpr int NSEL_P = (S + 63) / 64, NSEL_S = (PL + 1 + 63) / 64;
constexpr int CSTR = 512;
constexpr int IMPSTR = 160;
constexpr float SCALE = 0.125f, RMS_EPS = 1e-6f;
constexpr int WROWS0 = (128 < S ? 128 : S), WROWS1 = (512 < S ? 512 : S), WROWS2 = (2048 < S ? 2048 : S);
constexpr int LB0 = (128 < PL ? 128 : PL), LB1 = (512 < PL ? 512 : PL), LB2 = (2048 < PL ? 2048 : PL);
constexpr int LBW = (512 < PL ? 512 : PL);
static_assert(NC_P <= CSTR && NC_S <= CSTR, "cmp stride");
static_assert(NSEL_S <= IMPSTR, "imp stride");

typedef unsigned short bf16_t;

struct Params {
    const float *x_prompt, *x_sample, *cache_mem_kv, *cache_a0, *cache_a1, *cache_a2, *cache_b_pages, *cache_b_win;
    const int* page_table;
    const float *mem_prompt, *norm_pre, *norm_post, *norm_mem, *w_mem_kv, *w_in_a, *w_out_a, *w_in_b, *w_out_b, *cmp_pos, *cmp_w1, *cmp_w2;
    float *o_y, *o_ys, *o_mem, *o_pa0, *o_pa1, *o_pa2, *o_pb, *o_pbw, *o_sa0, *o_sa1, *o_sa2, *o_sb, *o_sbw;
    bf16_t *wt_in;
    bf16_t *wt_out;
    bf16_t *wt_mem;
    bf16_t *w1t;
    bf16_t *w2t;
    float  *cb;
    bf16_t *xb;
    float  *rstd;
    float  *mrstd;
    bf16_t *proj;
    bf16_t *vta;
    bf16_t *vts, *vtw;
    bf16_t *kc, *vc;
    bf16_t *mkb;
    bf16_t *mvt;
    float  *hid;
    float  *hid_s;
    bf16_t *kcmp;
    bf16_t *vcmpt;
    bf16_t *kcmp_s;
    bf16_t *vcmpt_s;
    bf16_t *z;
    float  *y;
    float  *pc;
    float  *oc;
    float  *imp;
    int    *selb;
    unsigned* bar;
};

__device__ __host__ inline bf16_t f2bf(float f) {
    union { float f; unsigned u; } v; v.f = f;
    unsigned u = v.u;
    u += 0x7FFFu + ((u >> 16) & 1u);
    return (bf16_t)(u >> 16);
}
__device__ __host__ inline float bf2f(bf16_t b) {
    union { float f; unsigned u; } v; v.u = ((unsigned)b) << 16; return v.f;
}
__device__ __host__ inline float silu_f(float x) { return x / (1.0f + expf(-x)); }
__device__ __host__ inline float sigmoid_f(float x) { return 1.0f / (1.0f + expf(-x)); }
__device__ __host__ inline float slope_a(int g, int h) { return exp2f(-8.0f * (float)(g * 4 + h + 1) / 12.0f); }
__device__ __host__ inline float slope_b(int hd) { return exp2f(-8.0f * (float)(hd + 1) / 12.0f); }
__device__ __host__ inline int dil_of(int g) { return g == 0 ? 1 : (g == 1 ? 4 : 16); }
__device__ __host__ inline int wrows_of(int g) { return g == 0 ? WROWS0 : (g == 1 ? WROWS1 : WROWS2); }
__device__ __host__ inline int lb_of(int g) { return g == 0 ? LB0 : (g == 1 ? LB1 : LB2); }
__device__ __host__ inline int cpos(int t, int d) { return (t % d) * (S / d) + t / d; }

__device__ __host__ inline void inproj_store8(const Params& p, int i, int r, int c0, const float* v) {
    const int li = i >> 1;
    bf16_t* pr = p.proj + (size_t)r * WP + c0;
    for (int j = 0; j < 8; ++j) pr[j] = f2bf(v[j]);
    const bool samp = r >= MP;
    const int n = samp ? r - MP : r / S, t = samp ? 0 : r % S;
    if ((i & 1) == 0) {
        if (c0 >= 768 && c0 < 2304) {
            const int s = c0 / 768, g = (c0 % 768) / 256, h = (c0 % 256) / 64, e0 = c0 % 64;
            float* ob = samp ? (g == 0 ? p.o_sa0 : (g == 1 ? p.o_sa1 : p.o_sa2)) : (g == 0 ? p.o_pa0 : (g == 1 ? p.o_pa1 : p.o_pa2));
            if (samp) {
                float* o = ob + (size_t)(li * NS + n) * 512 + (s - 1) * 256 + h * 64 + e0;
                for (int j = 0; j < 8; ++j) o[j] = v[j];
            } else {
                const int wr = wrows_of(g);
                if (t >= S - wr) {
                    float* o = ob + ((size_t)(li * NB + n) * wr + (t - (S - wr))) * 512 + (s - 1) * 256 + h * 64 + e0;
                    for (int j = 0; j < 8; ++j) o[j] = v[j];
                }
                if (s == 2) {
                    const int d = dil_of(g);
                    bf16_t* vt = p.vta + ((((size_t)g * NB + n) * 4 + h) * 64 + e0) * S + cpos(t, d);
                    for (int j = 0; j < 8; ++j) vt[(size_t)j * S] = f2bf(v[j]);
                }
            }
        }
    } else {
        if (c0 >= 768 && c0 < 1536) {
            const int cc = c0 - 768, ty = cc / 128, kv = (cc % 128) / 64, e0 = cc % 64;
            if (ty < 4) {
                float* o = samp ? p.o_sb + (size_t)(n * 2 + li) * 512 + cc : p.o_pb + ((size_t)(n * S + t) * 2 + li) * 512 + cc;
                for (int j = 0; j < 8; ++j) o[j] = v[j];
            } else {
                if (samp) {
                    float* o = p.o_sbw + (size_t)(li * NS + n) * 256 + (cc - 512);
                    for (int j = 0; j < 8; ++j) o[j] = v[j];
                } else if (t >= S - WROWS1) {
                    float* o = p.o_pbw + ((size_t)(li * NB + n) * WROWS1 + (t - (S - WROWS1))) * 256 + (cc - 512);
                    for (int j = 0; j < 8; ++j) o[j] = v[j];
                }
            }
            if (!samp) {
                if (ty == 0 || ty == 1) {
                    bf16_t* o = (ty == 0 ? p.kc : p.vc) + (((size_t)n * 2 + kv) * S + t) * 64 + e0;
                    for (int j = 0; j < 8; ++j) o[j] = f2bf(v[j]);
                } else if (ty == 3 || ty == 5) {
                    bf16_t* o = (ty == 3 ? p.vts : p.vtw) + (((size_t)n * 2 + kv) * 64 + e0) * S + t;
                    for (int j = 0; j < 8; ++j) o[(size_t)j * S] = f2bf(v[j]);
                }
            }
        }
    }
}

#define GS_LOOP(it, n) for (long it = gtid; it < (long)(n); it += gsz)

__device__ inline void ld8(const bf16_t* p, float* f) {
    const uint4 u = *(const uint4*)p;
    f[0] = __uint_as_float(u.x << 16); f[1] = __uint_as_float(u.x & 0xffff0000u);
    f[2] = __uint_as_float(u.y << 16); f[3] = __uint_as_float(u.y & 0xffff0000u);
    f[4] = __uint_as_float(u.z << 16); f[5] = __uint_as_float(u.z & 0xffff0000u);
    f[6] = __uint_as_float(u.w << 16); f[7] = __uint_as_float(u.w & 0xffff0000u);
}
__device__ inline void ld4f(const float* p, float* f) { const float4 u = *(const float4*)p; f[0] = u.x; f[1] = u.y; f[2] = u.z; f[3] = u.w; }
__device__ inline float dot_bb(const bf16_t* a, const bf16_t* b, int n) {
    float acc = 0.f;
    for (int k = 0; k < n; k += 8) { float x[8], y[8]; ld8(a + k, x); ld8(b + k, y);
#pragma unroll
        for (int j = 0; j < 8; ++j) acc += x[j] * y[j]; }
    return acc;
}
#define DOT64_B(acc, qf, kptr) do { _Pragma("unroll") for (int _k = 0; _k < 64; _k += 8) { float _y[8]; ld8((kptr) + _k, _y); _Pragma("unroll") for (int _j = 0; _j < 8; ++_j) acc += qf[_k + _j] * _y[_j]; } } while (0)
#define DOT64_F(acc, qf, kptr) do { _Pragma("unroll") for (int _k = 0; _k < 64; _k += 4) { float _y[4]; ld4f((kptr) + _k, _y); _Pragma("unroll") for (int _j = 0; _j < 4; ++_j) acc += qf[_k + _j] * _y[_j]; } } while (0)
#define LD64_B(dst, ptr) do { _Pragma("unroll") for (int _k = 0; _k < 64; _k += 8) ld8((ptr) + _k, (dst) + _k); } while (0)
#define LD64_F(dst, ptr) do { _Pragma("unroll") for (int _k = 0; _k < 64; _k += 4) ld4f((ptr) + _k, (dst) + _k); } while (0)

__device__ inline void nv_prep_weights(const Params& p, long gtid, long gsz) {
    GS_LOOP(it, (long)4 * WP * D) {
        const int k = it % D, c = (it / D) % WP, i = it / ((long)D * WP);
        const int li = i >> 1;
        float w = 0.f;
        if ((i & 1) == 0) w = p.w_in_a[((size_t)li * D + k) * 3072 + c];
        else if (c < W_IN_B) w = p.w_in_b[((size_t)li * D + k) * W_IN_B + c];
        p.wt_in[it] = f2bf(w * p.norm_pre[i * D + k]);
    }
    GS_LOOP(it, (long)4 * D * 1024) {
        const int i = it / ((long)D * 1024); const long rem = it % ((long)D * 1024);
        const int li = i >> 1;
        if ((i & 1) == 0) {
            if (rem < (long)D * 512) { const int k = rem % 512, c = rem / 512; p.wt_out[it] = f2bf(p.w_out_a[((size_t)li * 512 + k) * D + c]); }
        } else { const int k = rem % 1024, c = rem / 1024; p.wt_out[it] = f2bf(p.w_out_b[((size_t)li * 1024 + k) * D + c]); }
    }
    GS_LOOP(it, (long)4 * 512 * D) {
        const int k = it % D, c = (it / D) % 512, i = it / ((long)D * 512);
        p.wt_mem[it] = f2bf(p.w_mem_kv[((size_t)i * D + k) * 512 + c] * p.norm_mem[i * D + k]);
    }
    GS_LOOP(it, (long)4 * 128 * 2048) {
        const int k = it % 2048, j = (it / 2048) % 128, lt = it / (2048 * 128);
        p.w1t[it] = f2bf(p.cmp_w1[((size_t)lt * 2048 + k) * 128 + j]);
    }
    GS_LOOP(it, (long)4 * 64 * 128) {
        const int j = it % 128, e = (it / 128) % 64, lt = it / (128 * 64);
        p.w2t[it] = f2bf(p.cmp_w2[((size_t)lt * 128 + j) * 64 + e]);
    }
    GS_LOOP(it, (long)4 * 128) {
        const int j = it % 128, lt = it / 128;
        float a = 0.f;
        for (int k = 0; k < 2048; ++k) a += p.cmp_pos[(size_t)lt * 2048 + k] * p.cmp_w1[((size_t)lt * 2048 + k) * 128 + j];
        p.cb[it] = a;
    }
}

__device__ inline void nv_prep_x(const Params& p, long gtid, long gsz) {
    GS_LOOP(r, M) {
        const float* src = r < MP ? p.x_prompt + (size_t)r * D : p.x_sample + (size_t)(r - MP) * D;
        float* dst = r < MP ? p.o_y + (size_t)r * D : p.o_ys + (size_t)(r - MP) * D;
        float ss = 0.f;
        for (int k = 0; k < D; ++k) { const float v = src[k]; dst[k] = v; p.xb[(size_t)r * D + k] = f2bf(v); ss += v * v; }
        p.rstd[r] = 1.0f / sqrtf(ss / D + RMS_EPS);
    }
    GS_LOOP(r, NB * NM) {
        float ss = 0.f;
        for (int k = 0; k < D; ++k) { const float v = p.mem_prompt[(size_t)r * D + k]; ss += v * v; }
        p.mrstd[r] = 1.0f / sqrtf(ss / D + RMS_EPS);
    }
}

__device__ inline void nv_memkv(const Params& p, long gtid, long gsz) {
    GS_LOOP(it, (long)4 * NB * NM * 512) {
        const int c = it % 512, row = (it / 512) % (NB * NM), i = it / ((long)512 * NB * NM);
        const bf16_t* w = p.wt_mem + ((size_t)i * 512 + c) * D;
        const float* a = p.mem_prompt + (size_t)row * D;
        float acc = 0.f;
        for (int k = 0; k < D; ++k) acc += bf2f(f2bf(a[k])) * bf2f(w[k]);
        acc *= p.mrstd[row];
        p.o_mem[it] = acc;
        const int n = row / NM, m = row % NM, kvs = c / 256, h = (c % 256) / 64, e = c % 64;
        if (kvs == 0) p.mkb[((((size_t)i * NB + n) * 4 + h) * NM + m) * 64 + e] = f2bf(acc);
        else p.mvt[((((size_t)i * NB + n) * 4 + h) * 64 + e) * NM + m] = f2bf(acc);
    }
}

__device__ inline void nv_inproj(const Params& p, int i, long gtid, long gsz) {
    GS_LOOP(it, (long)M * (WP / 8)) {
        const int r = it % M, c0 = (it / M) * 8;
        const bf16_t* a = p.xb + (size_t)r * D;
        const bf16_t* w = p.wt_in + ((size_t)i * WP + c0) * D;
        float v[8];
#pragma unroll
        for (int j = 0; j < 8; ++j) v[j] = 0.f;
        for (int k = 0; k < D; k += 8) {
            float x[8]; ld8(a + k, x);
#pragma unroll
            for (int j = 0; j < 8; ++j) { float y[8]; ld8(w + (size_t)j * D + k, y);
#pragma unroll
                for (int q = 0; q < 8; ++q) v[j] += x[q] * y[q]; }
        }
        const float rs = p.rstd[r];
#pragma unroll
        for (int j = 0; j < 8; ++j) v[j] *= rs;
        inproj_store8(p, i, r, c0, v);
    }
}

#define OSM_UPDATE(sc, vv) do { const float _mn = fmaxf(mx, (sc)), _al = expf(mx - _mn), _pe = expf((sc) - _mn); den = den * _al + _pe; \
    _Pragma("unroll") for (int _e = 0; _e < 64; ++_e) o[_e] = o[_e] * _al + _pe * (vv)[_e]; mx = _mn; } while (0)

__device__ inline void nv_attn_a(const Params& p, int i, long gtid, long gsz) {
    const int li = i >> 1;
    GS_LOOP(it, (long)M * 4) {
        const int r = it % M, h = it / M;
        const bool samp = r >= MP;
        const int n = samp ? r - MP : r / S, t = samp ? 0 : r % S;
        float o[64], q[64], vv[64]; float mx = -INFINITY, den = 0.f;
#pragma unroll
        for (int e = 0; e < 64; ++e) o[e] = 0.f;
        for (int g = 0; g < 3; ++g) {
            const int d = dil_of(g); const float sl = slope_a(g, h);
            LD64_B(q, p.proj + (size_t)r * WP + g * 256 + h * 64);
            const float* cache = g == 0 ? p.cache_a0 : (g == 1 ? p.cache_a1 : p.cache_a2);
            const int lb = lb_of(g);
            for (int j = 0; j <= 128; ++j) {
                float sc = 0.f;
                if (!samp) {
                    const int tk = t - j * d; if (tk < 0) break;
                    const bf16_t* k = p.proj + (size_t)(n * S + tk) * WP + 768 + g * 256 + h * 64;
                    DOT64_B(sc, q, k);
                    const bf16_t* vt = p.vta + (((size_t)g * NB + n) * 4 + h) * 64 * S + cpos(tk, d);
#pragma unroll
                    for (int e = 0; e < 64; ++e) vv[e] = bf2f(vt[(size_t)e * S]);
                } else {
                    const int idx = lb - j * d; if (idx < 0) break;
                    if (j == 0) {
                        const bf16_t* k = p.proj + (size_t)r * WP + 768 + g * 256 + h * 64;
                        DOT64_B(sc, q, k); LD64_B(vv, k + 768);
                    } else {
                        const float* k = cache + (((size_t)li * NS + n) * lb + idx) * 512 + h * 64;
                        DOT64_F(sc, q, k); LD64_F(vv, k + 256);
                    }
                }
                sc = sc * SCALE - sl * (float)(j * d);
                OSM_UPDATE(sc, vv);
            }
        }
        const bf16_t* gm = p.proj + (size_t)r * WP + 2304 + h * 64;
        bf16_t* z = p.z + (size_t)r * 512 + h * 64;
        LD64_B(q, gm);
#pragma unroll
        for (int e = 0; e < 64; ++e) z[e] = f2bf(o[e] / den * silu_f(q[e]));
    }
}

__device__ inline void nv_cross(const Params& p, int i, int zld, int zoff, int qoff, int goff, long gtid, long gsz) {
    GS_LOOP(it, (long)M * 4) {
        const int r = it % M, h = it / M;
        const bool samp = r >= MP;
        const int n = samp ? r - MP : r / S;
        const bf16_t* qp = p.proj + (size_t)r * WP + qoff + h * 64;
        float o[64], q[64], vv[64]; float mx = -INFINITY, den = 0.f;
#pragma unroll
        for (int e = 0; e < 64; ++e) { o[e] = 0.f; q[e] = bf2f(qp[e]); }
        for (int m = 0; m < NM; ++m) {
            float sc = 0.f;
            if (!samp) {
                const bf16_t* k = p.mkb + ((((size_t)i * NB + n) * 4 + h) * NM + m) * 64;
                const bf16_t* vt = p.mvt + (((size_t)i * NB + n) * 4 + h) * 64 * NM + m;
                DOT64_B(sc, q, k);
#pragma unroll
                for (int e = 0; e < 64; ++e) vv[e] = bf2f(vt[(size_t)e * NM]);
            } else {
                const float* k = p.cache_mem_kv + ((((size_t)i * NS + n) * NM + m) * 2) * 256 + h * 64;
                DOT64_F(sc, q, k); LD64_F(vv, k + 256);
            }
            sc *= SCALE;
            OSM_UPDATE(sc, vv);
        }
        const bf16_t* gx = p.proj + (size_t)r * WP + goff + h * 64;
        bf16_t* z = p.z + (size_t)r * zld + zoff + h * 64;
#pragma unroll
        for (int e = 0; e < 64; ++e) z[e] = f2bf(o[e] / den * silu_f(bf2f(gx[e])));
    }
}

__device__ inline void nv_outproj(const Params& p, int i, long gtid, long gsz) {
    const int KO = (i & 1) ? 1024 : 512;
    GS_LOOP(it, (long)M * (D / 8)) {
        const int r = it % M, c0 = (it / M) * 8;
        const bf16_t* a = p.z + (size_t)r * KO;
        const bf16_t* w = p.wt_out + (size_t)i * D * 1024 + (size_t)c0 * KO;
        float v[8];
#pragma unroll
        for (int j = 0; j < 8; ++j) v[j] = 0.f;
        for (int k = 0; k < KO; k += 8) {
            float x[8]; ld8(a + k, x);
#pragma unroll
            for (int j = 0; j < 8; ++j) { float y[8]; ld8(w + (size_t)j * KO + k, y);
#pragma unroll
                for (int q = 0; q < 8; ++q) v[j] += x[q] * y[q]; }
        }
#pragma unroll
        for (int j = 0; j < 8; ++j) p.y[(size_t)r * D + c0 + j] = v[j];
    }
}

__device__ inline void nv_finish(const Params& p, int i, long gtid, long gsz) {
    GS_LOOP(r, M) {
        float* x = r < MP ? p.o_y + (size_t)r * D : p.o_ys + (size_t)(r - MP) * D;
        const float* y = p.y + (size_t)r * D;
        float ss = 0.f;
        for (int k = 0; k < D; ++k) ss += y[k] * y[k];
        const float yr = 1.0f / sqrtf(ss / D + RMS_EPS);
        float s2 = 0.f;
        for (int k = 0; k < D; ++k) { const float v = x[k] + y[k] * yr * p.norm_post[i * D + k]; x[k] = v; p.xb[(size_t)r * D + k] = f2bf(v); s2 += v * v; }
        p.rstd[r] = 1.0f / sqrtf(s2 / D + RMS_EPS);
    }
}

__device__ inline void nv_cmp1_p(const Params& p, int li, long gtid, long gsz) {
    GS_LOOP(it, (long)2 * NB * 2 * NC_P * 128) {
        const int j = it % 128, c = (it / 128) % NC_P, nk = (it / (128 * NC_P)) % (NB * 2), ty = it / ((long)128 * NC_P * NB * 2);
        const bf16_t* a = (ty == 0 ? p.kc : p.vc) + ((size_t)nk * S + 16 * c) * 64;
        const bf16_t* w = p.w1t + ((size_t)(li * 2 + ty) * 128 + j) * 2048;
        const float acc = p.cb[(li * 2 + ty) * 128 + j] + dot_bb(a, w, 2048);
        p.hid[(((size_t)ty * NB * 2 + nk) * CSTR + c) * 128 + j] = silu_f(acc);
    }
}
__device__ inline void nv_cmp1_s(const Params& p, int li, long gtid, long gsz) {
    GS_LOOP(it, (long)2 * NS * 2 * NC_S * 128) {
        const int j = it % 128, c = (it / 128) % NC_S, nk = (it / (128 * NC_S)) % (NS * 2), ty = it / ((long)128 * NC_S * NS * 2);
        const int n = nk / 2, kv = nk % 2;
        const bf16_t* w = p.w1t + ((size_t)(li * 2 + ty) * 128 + j) * 2048;
        float acc = p.cb[(li * 2 + ty) * 128 + j];
        for (int l = 0; l < 32; ++l) {
            const int pos = 16 * c + l;
            const int page = p.page_table[n * NPAGES + pos / 128];
            const float* a = p.cache_b_pages + ((((size_t)page * 128 + pos % 128) * 2 + li) * 4 + ty) * 128 + kv * 64;
            for (int e = 0; e < 64; e += 8) { float x[8], y[8]; ld4f(a + e, x); ld4f(a + e + 4, x + 4); ld8(w + l * 64 + e, y);
#pragma unroll
                for (int q = 0; q < 8; ++q) acc += bf2f(f2bf(x[q])) * y[q]; }
        }
        p.hid_s[((((size_t)li * 2 + ty) * NS * 2 + nk) * CSTR + c) * 128 + j] = silu_f(acc);
    }
}
__device__ inline void nv_cmp2_p(const Params& p, int li, long gtid, long gsz) {
    GS_LOOP(it, (long)2 * NB * 2 * NC_P * 64) {
        const int e = it % 64, c = (it / 64) % NC_P, nk = (it / (64 * NC_P)) % (NB * 2), ty = it / ((long)64 * NC_P * NB * 2);
        const float* hd = p.hid + (((size_t)ty * NB * 2 + nk) * CSTR + c) * 128;
        const bf16_t* w = p.w2t + ((size_t)(li * 2 + ty) * 64 + e) * 128;
        float acc = 0.f;
        for (int j = 0; j < 128; ++j) acc += bf2f(f2bf(hd[j])) * bf2f(w[j]);
        if (ty == 0) p.kcmp[((size_t)nk * CSTR + c) * 64 + e] = f2bf(acc);
        else p.vcmpt[((size_t)nk * 64 + e) * CSTR + c] = f2bf(acc);
    }
}
__device__ inline void nv_cmp2_s(const Params& p, int li, long gtid, long gsz) {
    GS_LOOP(it, (long)2 * NS * 2 * NC_S * 64) {
        const int e = it % 64, c = (it / 64) % NC_S, nk = (it / (64 * NC_S)) % (NS * 2), ty = it / ((long)64 * NC_S * NS * 2);
        const float* hd = p.hid_s + ((((size_t)li * 2 + ty) * NS * 2 + nk) * CSTR + c) * 128;
        const bf16_t* w = p.w2t + ((size_t)(li * 2 + ty) * 64 + e) * 128;
        float acc = 0.f;
        for (int j = 0; j < 128; ++j) acc += bf2f(f2bf(hd[j])) * bf2f(w[j]);
        if (ty == 0) p.kcmp_s[(((size_t)li * NS * 2 + nk) * CSTR + c) * 64 + e] = f2bf(acc);
        else p.vcmpt_s[(((size_t)li * NS * 2 + nk) * 64 + e) * CSTR + c] = f2bf(acc);
    }
}

__device__ inline void nv_nsa_cmp(const Params& p, int i, long gtid, long gsz) {
    const int li = i >> 1;
    GS_LOOP(it, (long)M * 12) {
        const int r = it % M, hd = it / M, kv = hd / 6;
        const bool samp = r >= MP;
        const int n = samp ? r - MP : r / S, tq = samp ? PL : r % S;
        const int nc = samp ? NC_S : NC_P;
        const bf16_t* kb = samp ? p.kcmp_s + ((size_t)li * NS * 2 + n * 2 + kv) * CSTR * 64 : p.kcmp + ((size_t)n * 2 + kv) * CSTR * 64;
        const bf16_t* vb = samp ? p.vcmpt_s + ((size_t)li * NS * 2 + n * 2 + kv) * 64 * CSTR : p.vcmpt + ((size_t)n * 2 + kv) * 64 * CSTR;
        float q[64], o[64];
        LD64_B(q, p.proj + (size_t)r * WP + hd * 64);
        const float sl = slope_b(hd);
        float* pc = p.pc + ((size_t)r * 12 + hd) * CSTR;
        float mx = -INFINITY;
        for (int c = 0; c < nc; ++c) {
            const int ce = 16 * c + 31; if (ce > tq) break;
            float sc = 0.f;
            DOT64_B(sc, q, kb + c * 64);
            sc = sc * SCALE - sl * (float)(tq - ce);
            pc[c] = sc; mx = fmaxf(mx, sc);
        }
        float den = 0.f;
        for (int c = 0; c < nc; ++c) { const int ce = 16 * c + 31; if (ce > tq) break; den += expf(pc[c] - mx); }
        den = fmaxf(den, 1e-30f);
#pragma unroll
        for (int e = 0; e < 64; ++e) o[e] = 0.f;
        for (int c = 0; c < CSTR; ++c) {
            const int ce = 16 * c + 31;
            if (c < nc && ce <= tq) {
                const float pe = expf(pc[c] - mx) / den; pc[c] = pe;
#pragma unroll
                for (int e = 0; e < 64; ++e) o[e] += pe * bf2f(vb[(size_t)e * CSTR + c]);
            } else pc[c] = 0.f;
        }
        float* oc = p.oc + ((size_t)r * 12 + hd) * 64;
#pragma unroll
        for (int e = 0; e < 64; ++e) oc[e] = o[e];
    }
}
__device__ inline void nv_nsa_imp(const Params& p, long gtid, long gsz) {
    GS_LOOP(it, (long)M * 2 * IMPSTR) {
        const int b = it % IMPSTR, kv = (it / IMPSTR) % 2, r = it / (2 * IMPSTR);
        const bool samp = r >= MP;
        const int tq = samp ? PL : r % S, nsel = samp ? NSEL_S : NSEL_P;
        float v = -INFINITY;
        if (b < nsel) {
            float a = 0.f;
            for (int g = 0; g < 6; ++g) {
                const float* pc = p.pc + ((size_t)r * 12 + kv * 6 + g) * CSTR;
                for (int ii = 4 * b; ii < 4 * b + 4; ++ii) {
                    if (ii < CSTR) a += pc[ii];
                    if (ii - 1 >= 0 && ii - 1 < CSTR) a += pc[ii - 1];
                }
            }
            const int cur = tq / 64;
            const bool forced = (b == 0) || (b == cur) || (b == cur - 1);
            v = (b * 64 > tq) ? -INFINITY : (forced ? 1e4f : a);
        }
        p.imp[it] = v;
    }
}
__device__ inline void nv_nsa_topk(const Params& p, long gtid, long gsz) {
    GS_LOOP(it, (long)M * 2 * IMPSTR) {
        const int b = it % IMPSTR, r = it / (2 * IMPSTR);
        const int nsel = r >= MP ? NSEL_S : NSEL_P;
        const float* im = p.imp + (it - b);
        int sel = 0;
        if (b < nsel) {
            const float v = im[b]; int rank = 0;
            for (int b2 = 0; b2 < nsel; ++b2) { const float w = im[b2]; rank += (w > v || (w == v && b2 < b)) ? 1 : 0; }
            sel = rank < 16 ? 1 : 0;
        }
        p.selb[it] = sel;
    }
}
__device__ inline void nv_nsa_main(const Params& p, int i, long gtid, long gsz) {
    const int li = i >> 1;
    GS_LOOP(it, (long)M * 12) {
        const int r = it % M, hd = it / M, kv = hd / 6;
        const bool samp = r >= MP;
        const int n = samp ? r - MP : r / S, tq = samp ? PL : r % S;
        const int nsel = samp ? NSEL_S : NSEL_P;
        const float sl = slope_b(hd);
        const int* selb = p.selb + ((size_t)r * 2 + kv) * IMPSTR;
        float o[64], q[64], vv[64], acc[64]; float mx = -INFINITY, den = 0.f;
        LD64_B(q, p.proj + (size_t)r * WP + hd * 64);
#pragma unroll
        for (int e = 0; e < 64; ++e) o[e] = 0.f;
        for (int b = 0; b < nsel; ++b) {
            if (!selb[b]) continue;
            for (int s = 0; s < 64; ++s) {
                const int kp = b * 64 + s; if (kp > tq) break;
                float sc = 0.f;
                if (!samp) {
                    const bf16_t* k = p.proj + (size_t)(n * S + kp) * WP + 768 + 2 * 128 + kv * 64;
                    const bf16_t* vt = p.vts + ((size_t)n * 2 + kv) * 64 * S + kp;
                    DOT64_B(sc, q, k);
#pragma unroll
                    for (int e = 0; e < 64; ++e) vv[e] = bf2f(vt[(size_t)e * S]);
                } else if (kp < PL) {
                    const int page = p.page_table[n * NPAGES + kp / 128];
                    const float* k = p.cache_b_pages + ((((size_t)page * 128 + kp % 128) * 2 + li) * 4 + 2) * 128 + kv * 64;
                    DOT64_F(sc, q, k); LD64_F(vv, k + 128);
                } else {
                    const bf16_t* k = p.proj + (size_t)r * WP + 768 + 2 * 128 + kv * 64;
                    DOT64_B(sc, q, k); LD64_B(vv, k + 128);
                }
                sc = sc * SCALE - sl * (float)(tq - kp);
                OSM_UPDATE(sc, vv);
            }
        }
        const float g0 = sigmoid_f(bf2f(p.proj[(size_t)r * WP + 1536 + hd * 3 + 0]));
        const float g1 = sigmoid_f(bf2f(p.proj[(size_t)r * WP + 1536 + hd * 3 + 1]));
        const float g2 = sigmoid_f(bf2f(p.proj[(size_t)r * WP + 1536 + hd * 3 + 2]));
        const float* oc = p.oc + ((size_t)r * 12 + hd) * 64;
        const float inv_s = den > 0.f ? 1.0f / den : 0.f;
#pragma unroll
        for (int e = 0; e < 64; ++e) acc[e] = g0 * oc[e] + g1 * o[e] * inv_s;
        mx = -INFINITY; den = 0.f;
#pragma unroll
        for (int e = 0; e < 64; ++e) o[e] = 0.f;
        for (int dw = 512; dw >= 0; --dw) {
            const int kp = tq - dw; if (kp < 0) continue;
            float sc = 0.f;
            if (!samp) {
                const bf16_t* k = p.proj + (size_t)(n * S + kp) * WP + 768 + 4 * 128 + kv * 64;
                const bf16_t* vt = p.vtw + ((size_t)n * 2 + kv) * 64 * S + kp;
                DOT64_B(sc, q, k);
#pragma unroll
                for (int e = 0; e < 64; ++e) vv[e] = bf2f(vt[(size_t)e * S]);
            } else if (dw > 0) {
                const int idx = LBW - dw; if (idx < 0) continue;
                const float* k = p.cache_b_win + ((((size_t)li * NS + n) * LBW + idx) * 2) * 128 + kv * 64;
                DOT64_F(sc, q, k); LD64_F(vv, k + 128);
            } else {
                const bf16_t* k = p.proj + (size_t)r * WP + 768 + 4 * 128 + kv * 64;
                DOT64_B(sc, q, k); LD64_B(vv, k + 128);
            }
            sc = sc * SCALE - sl * (float)dw;
            OSM_UPDATE(sc, vv);
        }
        const float inv_w = den > 0.f ? 1.0f / den : 0.f;
        const bf16_t* gm = p.proj + (size_t)r * WP + 1572 + hd * 64;
        bf16_t* z = p.z + (size_t)r * 1024 + hd * 64;
#pragma unroll
        for (int e = 0; e < 64; ++e) z[e] = f2bf((acc[e] + g2 * o[e] * inv_w) * silu_f(bf2f(gm[e])));
    }
}

enum { ST_PREPW, ST_PREPX, ST_MEMKV, ST_INPROJ, ST_ATTNA, ST_CROSS_A, ST_CROSS_B, ST_CMP1P, ST_CMP1S, ST_CMP2P, ST_CMP2S, ST_NSACMP, ST_NSAIMP, ST_NSATOPK, ST_NSAMAIN, ST_OUTPROJ, ST_FINISH };

template <int ST> __global__ void __launch_bounds__(256) k_stage(Params p, int i) {
    const long gtid = (long)blockIdx.x * blockDim.x + threadIdx.x, gsz = (long)gridDim.x * blockDim.x;
    const int li = i >> 1;
    if (ST == ST_PREPW) nv_prep_weights(p, gtid, gsz);
    if (ST == ST_PREPX) nv_prep_x(p, gtid, gsz);
    if (ST == ST_MEMKV) nv_memkv(p, gtid, gsz);
    if (ST == ST_INPROJ) nv_inproj(p, i, gtid, gsz);
    if (ST == ST_ATTNA) nv_attn_a(p, i, gtid, gsz);
    if (ST == ST_CROSS_A) nv_cross(p, i, 512, 256, 2560, 2816, gtid, gsz);
    if (ST == ST_CROSS_B) nv_cross(p, i, 1024, 768, 2340, 2596, gtid, gsz);
    if (ST == ST_CMP1P) nv_cmp1_p(p, li, gtid, gsz);
    if (ST == ST_CMP1S) nv_cmp1_s(p, li, gtid, gsz);
    if (ST == ST_CMP2P) nv_cmp2_p(p, li, gtid, gsz);
    if (ST == ST_CMP2S) nv_cmp2_s(p, li, gtid, gsz);
    if (ST == ST_NSACMP) nv_nsa_cmp(p, i, gtid, gsz);
    if (ST == ST_NSAIMP) nv_nsa_imp(p, gtid, gsz);
    if (ST == ST_NSATOPK) nv_nsa_topk(p, gtid, gsz);
    if (ST == ST_NSAMAIN) nv_nsa_main(p, i, gtid, gsz);
    if (ST == ST_OUTPROJ) nv_outproj(p, i, gtid, gsz);
    if (ST == ST_FINISH) nv_finish(p, i, gtid, gsz);
}

struct WsAlloc {
    char* base; size_t off;
    template <class T> T* get(size_t n) { T* r = (T*)(base + off); off += (n * sizeof(T) + 255) & ~(size_t)255; return r; }
};

static void fill_params(Params& p, void* const* d_in, void* d_out, void* d_ws) {
    memset(&p, 0, sizeof(p));
    p.x_prompt = (const float*)d_in[0]; p.x_sample = (const float*)d_in[1]; p.cache_mem_kv = (const float*)d_in[2];
    p.cache_a0 = (const float*)d_in[3]; p.cache_a1 = (const float*)d_in[4]; p.cache_a2 = (const float*)d_in[5];
    p.cache_b_pages = (const float*)d_in[6]; p.cache_b_win = (const float*)d_in[7]; p.page_table = (const int*)d_in[8];
    p.mem_prompt = (const float*)d_in[9]; p.norm_pre = (const float*)d_in[10]; p.norm_post = (const float*)d_in[11]; p.norm_mem = (const float*)d_in[12];
    p.w_mem_kv = (const float*)d_in[13]; p.w_in_a = (const float*)d_in[14]; p.w_out_a = (const float*)d_in[15]; p.w_in_b = (const float*)d_in[16];
    p.w_out_b = (const float*)d_in[17]; p.cmp_pos = (const float*)d_in[18]; p.cmp_w1 = (const float*)d_in[19]; p.cmp_w2 = (const float*)d_in[20];
    const size_t osz[13] = {(size_t)NB * S * D, (size_t)NS * D, (size_t)4 * NB * NM * 512, (size_t)2 * NB * WROWS0 * 512, (size_t)2 * NB * WROWS1 * 512, (size_t)2 * NB * WROWS2 * 512,
                            (size_t)NB * S * 1024, (size_t)2 * NB * WROWS1 * 256, (size_t)2 * NS * 512, (size_t)2 * NS * 512, (size_t)2 * NS * 512, (size_t)NS * 1024, (size_t)2 * NS * 256};
    float* o = (float*)d_out; float* outs[13];
    for (int i = 0; i < 13; ++i) { outs[i] = o; o += osz[i]; }
    p.o_y = outs[0]; p.o_ys = outs[1]; p.o_mem = outs[2]; p.o_pa0 = outs[3]; p.o_pa1 = outs[4]; p.o_pa2 = outs[5]; p.o_pb = outs[6]; p.o_pbw = outs[7];
    p.o_sa0 = outs[8]; p.o_sa1 = outs[9]; p.o_sa2 = outs[10]; p.o_sb = outs[11]; p.o_sbw = outs[12];
    WsAlloc a{(char*)d_ws, 0};
    p.bar = a.get<unsigned>(4096);
    p.wt_in = a.get<bf16_t>((size_t)4 * WP * D); p.wt_out = a.get<bf16_t>((size_t)4 * D * 1024); p.wt_mem = a.get<bf16_t>((size_t)4 * 512 * D);
    p.w1t = a.get<bf16_t>((size_t)4 * 128 * 2048); p.w2t = a.get<bf16_t>((size_t)4 * 64 * 128); p.cb = a.get<float>(4 * 128);
    p.xb = a.get<bf16_t>((size_t)MPAD * D); p.rstd = a.get<float>(MPAD); p.mrstd = a.get<float>(NB * NM);
    p.proj = a.get<bf16_t>((size_t)MPAD * WP); p.vta = a.get<bf16_t>((size_t)3 * NB * 4 * 64 * S);
    p.vts = a.get<bf16_t>((size_t)NB * 2 * 64 * S); p.vtw = a.get<bf16_t>((size_t)NB * 2 * 64 * S);
    p.kc = a.get<bf16_t>((size_t)NB * 2 * S * 64); p.vc = a.get<bf16_t>((size_t)NB * 2 * S * 64);
    p.mkb = a.get<bf16_t>((size_t)4 * NB * 4 * NM * 64); p.mvt = a.get<bf16_t>((size_t)4 * NB * 4 * 64 * NM);
    p.hid = a.get<float>((size_t)2 * NB * 2 * CSTR * 128); p.hid_s = a.get<float>((size_t)2 * 2 * NS * 2 * CSTR * 128);
    p.kcmp = a.get<bf16_t>((size_t)NB * 2 * CSTR * 64); p.vcmpt = a.get<bf16_t>((size_t)NB * 2 * 64 * CSTR);
    p.kcmp_s = a.get<bf16_t>((size_t)2 * NS * 2 * CSTR * 64); p.vcmpt_s = a.get<bf16_t>((size_t)2 * NS * 2 * 64 * CSTR);
    p.z = a.get<bf16_t>((size_t)MPAD * 1024); p.y = a.get<float>((size_t)MPAD * D);
    p.pc = a.get<float>((size_t)M * 12 * CSTR); p.oc = a.get<float>((size_t)M * 12 * 64);
    p.imp = a.get<float>((size_t)M * 2 * IMPSTR); p.selb = a.get<int>((size_t)M * 2 * IMPSTR);
}

#define LAUNCH(ST, i) k_stage<ST><<<2048, 256, 0, stream>>>(p, i)

extern "C" void kernel_launch(void* const* d_in, const int* in_sizes, int n_in,
                              void* d_out, int out_size, void* d_ws, size_t ws_size,
                              hipStream_t stream) {
    Params p; fill_params(p, d_in, d_out, d_ws);
    LAUNCH(ST_PREPW, 0); LAUNCH(ST_PREPX, 0); LAUNCH(ST_MEMKV, 0);
    for (int i = 0; i < 4; ++i) {
        LAUNCH(ST_INPROJ, i);
        if ((i & 1) == 0) { LAUNCH(ST_ATTNA, i); LAUNCH(ST_CROSS_A, i); }
        else {
            LAUNCH(ST_CMP1P, i); LAUNCH(ST_CMP1S, i); LAUNCH(ST_CMP2P, i); LAUNCH(ST_CMP2S, i);
            LAUNCH(ST_NSACMP, i); LAUNCH(ST_NSAIMP, i); LAUNCH(ST_NSATOPK, i); LAUNCH(ST_NSAMAIN, i); LAUNCH(ST_CROSS_B, i);
        }
        LAUNCH(ST_OUTPROJ, i); LAUNCH(ST_FINISH, i);
    }
}
```

```cpp
#include <hip/hip_runtime.h>
#include <cstring>
#include <cmath>

#ifdef SMALL
constexpr int D = 128, NB = 1, S = 2048, NS = 2, PL = 2048, NM = 32;
#else
constexpr int D = 1024, NB = 2, S = 8192, NS = 32, PL = 8192, NM = 256;
#endif
constexpr int MP = NB * S, M = MP + NS;
constexpr int MPAD = ((M + 255) / 256) * 256;
constexpr int WP = 3072;
constexpr int W_IN_B = 2852;
constexpr int NPAGES = PL / 128;
constexpr int NC_P = (S - 32) / 16 + 1;
constexpr int NC_S = (PL + 1 - 32) / 16 + 1;
constexpr int NSEL_P = (S + 63) / 64, NSEL_S = (PL + 1 + 63) / 64;
constexpr int CSTR = 512;
constexpr int IMPSTR = 160;
constexpr float SCALE = 0.125f, RMS_EPS = 1e-6f;
constexpr int WROWS0 = (128 < S ? 128 : S), WROWS1 = (512 < S ? 512 : S), WROWS2 = (2048 < S ? 2048 : S);
constexpr int LB0 = (128 < PL ? 128 : PL), LB1 = (512 < PL ? 512 : PL), LB2 = (2048 < PL ? 2048 : PL);
constexpr int LBW = (512 < PL ? 512 : PL);
static_assert(NC_P <= CSTR && NC_S <= CSTR, "cmp stride");
static_assert(NSEL_S <= IMPSTR, "imp stride");

typedef unsigned short bf16_t;

struct Params {
    const float *x_prompt, *x_sample, *cache_mem_kv, *cache_a0, *cache_a1, *cache_a2, *cache_b_pages, *cache_b_win;
    const int* page_table;
    const float *mem_prompt, *norm_pre, *norm_post, *norm_mem, *w_mem_kv, *w_in_a, *w_out_a, *w_in_b, *w_out_b, *cmp_pos, *cmp_w1, *cmp_w2;
    float *o_y, *o_ys, *o_mem, *o_pa0, *o_pa1, *o_pa2, *o_pb, *o_pbw, *o_sa0, *o_sa1, *o_sa2, *o_sb, *o_sbw;
    bf16_t *wt_in;
    bf16_t *wt_out;
    bf16_t *wt_mem;
    bf16_t *w1t;
    bf16_t *w2t;
    float  *cb;
    bf16_t *xb;
    float  *rstd;
    float  *mrstd;
    bf16_t *proj;
    bf16_t *vta;
    bf16_t *vts, *vtw;
    bf16_t *kc, *vc;
    bf16_t *mkb;
    bf16_t *mvt;
    float  *hid;
    float  *hid_s;
    bf16_t *kcmp;
    bf16_t *vcmpt;
    bf16_t *kcmp_s;
    bf16_t *vcmpt_s;
    bf16_t *z;
    float  *y;
    float  *pc;
    float  *oc;
    float  *imp;
    int    *selb;
    unsigned* bar;
};

__device__ __host__ inline bf16_t f2bf(float f) {
    union { float f; unsigned u; } v; v.f = f;
    unsigned u = v.u;
    u += 0x7FFFu + ((u >> 16) & 1u);
    return (bf16_t)(u >> 16);
}
__device__ __host__ inline float bf2f(bf16_t b) {
    union { float f; unsigned u; } v; v.u = ((unsigned)b) << 16; return v.f;
}
__device__ __host__ inline float silu_f(float x) { return x / (1.0f + expf(-x)); }
__device__ __host__ inline float sigmoid_f(float x) { return 1.0f / (1.0f + expf(-x)); }
__device__ __host__ inline float slope_a(int g, int h) { return exp2f(-8.0f * (float)(g * 4 + h + 1) / 12.0f); }
__device__ __host__ inline float slope_b(int hd) { return exp2f(-8.0f * (float)(hd + 1) / 12.0f); }
__device__ __host__ inline int dil_of(int g) { return g == 0 ? 1 : (g == 1 ? 4 : 16); }
__device__ __host__ inline int wrows_of(int g) { return g == 0 ? WROWS0 : (g == 1 ? WROWS1 : WROWS2); }
__device__ __host__ inline int lb_of(int g) { return g == 0 ? LB0 : (g == 1 ? LB1 : LB2); }
__device__ __host__ inline int cpos(int t, int d) { return (t % d) * (S / d) + t / d; }

__device__ __host__ inline void inproj_store8(const Params& p, int i, int r, int c0, const float* v) {
    const int li = i >> 1;
    bf16_t* pr = p.proj + (size_t)r * WP + c0;
    for (int j = 0; j < 8; ++j) pr[j] = f2bf(v[j]);
    const bool samp = r >= MP;
    const int n = samp ? r - MP : r / S, t = samp ? 0 : r % S;
    if ((i & 1) == 0) {
        if (c0 >= 768 && c0 < 2304) {
            const int s = c0 / 768, g = (c0 % 768) / 256, h = (c0 % 256) / 64, e0 = c0 % 64;
            float* ob = samp ? (g == 0 ? p.o_sa0 : (g == 1 ? p.o_sa1 : p.o_sa2)) : (g == 0 ? p.o_pa0 : (g == 1 ? p.o_pa1 : p.o_pa2));
            if (samp) {
                float* o = ob + (size_t)(li * NS + n) * 512 + (s - 1) * 256 + h * 64 + e0;
                for (int j = 0; j < 8; ++j) o[j] = v[j];
            } else {
                const int wr = wrows_of(g);
                if (t >= S - wr) {
                    float* o = ob + ((size_t)(li * NB + n) * wr + (t - (S - wr))) * 512 + (s - 1) * 256 + h * 64 + e0;
                    for (int j = 0; j < 8; ++j) o[j] = v[j];
                }
                if (s == 2) {
                    const int d = dil_of(g);
                    bf16_t* vt = p.vta + ((((size_t)g * NB + n) * 4 + h) * 64 + e0) * S + cpos(t, d);
                    for (int j = 0; j < 8; ++j) vt[(size_t)j * S] = f2bf(v[j]);
                }
            }
        }
    } else {
        if (c0 >= 768 && c0 < 1536) {
            const int cc = c0 - 768, ty = cc / 128, kv = (cc % 128) / 64, e0 = cc % 64;
            if (ty < 4) {
                float* o = samp ? p.o_sb + (size_t)(n * 2 + li) * 512 + cc : p.o_pb + ((size_t)(n * S + t) * 2 + li) * 512 + cc;
                for (int j = 0; j < 8; ++j) o[j] = v[j];
            } else {
                if (samp) {
                    float* o = p.o_sbw + (size_t)(li * NS + n) * 256 + (cc - 512);
                    for (int j = 0; j < 8; ++j) o[j] = v[j];
                } else if (t >= S - WROWS1) {
                    float* o = p.o_pbw + ((size_t)(li * NB + n) * WROWS1 + (t - (S - WROWS1))) * 256 + (cc - 512);
                    for (int j = 0; j < 8; ++j) o[j] = v[j];
                }
            }
            if (!samp) {
                if (ty == 0 || ty == 1) {
                    bf16_t* o = (ty == 0 ? p.kc : p.vc) + (((size_t)n * 2 + kv) * S + t) * 64 + e0;
                    for (int j = 0; j < 8; ++j) o[j] = f2bf(v[j]);
                } else if (ty == 3 || ty == 5) {
                    bf16_t* o = (ty == 3 ? p.vts : p.vtw) + (((size_t)n * 2 + kv) * 64 + e0) * S + t;
                    for (int j = 0; j < 8; ++j) o[(size_t)j * S] = f2bf(v[j]);
                }
            }
        }
    }
}

#define GS_LOOP(it, n) for (long it = gtid; it < (long)(n); it += gsz)

__device__ inline void ld8(const bf16_t* p, float* f) {
    const uint4 u = *(const uint4*)p;
    f[0] = __uint_as_float(u.x << 16); f[1] = __uint_as_float(u.x & 0xffff0000u);
    f[2] = __uint_as_float(u.y << 16); f[3] = __uint_as_float(u.y & 0xffff0000u);
    f[4] = __uint_as_float(u.z << 16); f[5] = __uint_as_float(u.z & 0xffff0000u);
    f[6] = __uint_as_float(u.w << 16); f[7] = __uint_as_float(u.w & 0xffff0000u);
}
__device__ inline void ld4f(const float* p, float* f) { const float4 u = *(const float4*)p; f[0] = u.x; f[1] = u.y; f[2] = u.z; f[3] = u.w; }
__device__ inline float dot_bb(const bf16_t* a, const bf16_t* b, int n) {
    float acc = 0.f;
    for (int k = 0; k < n; k += 8) { float x[8], y[8]; ld8(a + k, x); ld8(b + k, y);
#pragma unroll
        for (int j = 0; j < 8; ++j) acc += x[j] * y[j]; }
    return acc;
}
#define DOT64_B(acc, qf, kptr) do { _Pragma("unroll") for (int _k = 0; _k < 64; _k += 8) { float _y[8]; ld8((kptr) + _k, _y); _Pragma("unroll") for (int _j = 0; _j < 8; ++_j) acc += qf[_k + _j] * _y[_j]; } } while (0)
#define DOT64_F(acc, qf, kptr) do { _Pragma("unroll") for (int _k = 0; _k < 64; _k += 4) { float _y[4]; ld4f((kptr) + _k, _y); _Pragma("unroll") for (int _j = 0; _j < 4; ++_j) acc += qf[_k + _j] * _y[_j]; } } while (0)
#define LD64_B(dst, ptr) do { _Pragma("unroll") for (int _k = 0; _k < 64; _k += 8) ld8((ptr) + _k, (dst) + _k); } while (0)
#define LD64_F(dst, ptr) do { _Pragma("unroll") for (int _k = 0; _k < 64; _k += 4) ld4f((ptr) + _k, (dst) + _k); } while (0)

#define DOTM_B(acc, qp, kptr) do { _Pragma("unroll") for (int _k = 0; _k < 64; _k += 8) { float _x[8], _y[8]; ld8((qp) + _k, _x); ld8((kptr) + _k, _y); _Pragma("unroll") for (int _j = 0; _j < 8; ++_j) acc += _x[_j] * _y[_j]; } } while (0)
#define DOTM_F(acc, qp, kptr) do { _Pragma("unroll") for (int _k = 0; _k < 64; _k += 8) { float _x[8], _y[8]; ld8((qp) + _k, _x); ld4f((kptr) + _k, _y); ld4f((kptr) + _k + 4, _y + 4); _Pragma("unroll") for (int _j = 0; _j < 8; ++_j) acc += _x[_j] * _y[_j]; } } while (0)

__device__ inline void nv_prep_weights(const Params& p, long gtid, long gsz) {
    GS_LOOP(it, (long)4 * WP * D) {
        const int k = it % D, c = (it / D) % WP, i = it / ((long)D * WP);
        const int li = i >> 1;
        float w = 0.f;
        if ((i & 1) == 0) w = p.w_in_a[((size_t)li * D + k) * 3072 + c];
        else if (c < W_IN_B) w = p.w_in_b[((size_t)li * D + k) * W_IN_B + c];
        p.wt_in[it] = f2bf(w * p.norm_pre[i * D + k]);
    }
    GS_LOOP(it, (long)4 * D * 1024) {
        const int i = it / ((long)D * 1024); const long rem = it % ((long)D * 1024);
        const int li = i >> 1;
        if ((i & 1) == 0) {
            if (rem < (long)D * 512) { const int k = rem % 512, c = rem / 512; p.wt_out[it] = f2bf(p.w_out_a[((size_t)li * 512 + k) * D + c]); }
        } else { const int k = rem % 1024, c = rem / 1024; p.wt_out[it] = f2bf(p.w_out_b[((size_t)li * 1024 + k) * D + c]); }
    }
    GS_LOOP(it, (long)4 * 512 * D) {
        const int k = it % D, c = (it / D) % 512, i = it / ((long)D * 512);
        p.wt_mem[it] = f2bf(p.w_mem_kv[((size_t)i * D + k) * 512 + c] * p.norm_mem[i * D + k]);
    }
    GS_LOOP(it, (long)4 * 128 * 2048) {
        const int k = it % 2048, j = (it / 2048) % 128, lt = it / (2048 * 128);
        p.w1t[it] = f2bf(p.cmp_w1[((size_t)lt * 2048 + k) * 128 + j]);
    }
    GS_LOOP(it, (long)4 * 64 * 128) {
        const int j = it % 128, e = (it / 128) % 64, lt = it / (128 * 64);
        p.w2t[it] = f2bf(p.cmp_w2[((size_t)lt * 128 + j) * 64 + e]);
    }
    GS_LOOP(it, (long)4 * 128) {
        const int j = it % 128, lt = it / 128;
        float a = 0.f;
        for (int k = 0; k < 2048; ++k) a += p.cmp_pos[(size_t)lt * 2048 + k] * p.cmp_w1[((size_t)lt * 2048 + k) * 128 + j];
        p.cb[it] = a;
    }
}

__device__ inline void nv_prep_x(const Params& p, long gtid, long gsz) {
    GS_LOOP(r, M) {
        const float* src = r < MP ? p.x_prompt + (size_t)r * D : p.x_sample + (size_t)(r - MP) * D;
        float* dst = r < MP ? p.o_y + (size_t)r * D : p.o_ys + (size_t)(r - MP) * D;
        float ss = 0.f;
        for (int k = 0; k < D; ++k) { const float v = src[k]; dst[k] = v; p.xb[(size_t)r * D + k] = f2bf(v); ss += v * v; }
        p.rstd[r] = 1.0f / sqrtf(ss / D + RMS_EPS);
    }
    GS_LOOP(r, NB * NM) {
        float ss = 0.f;
        for (int k = 0; k < D; ++k) { const float v = p.mem_prompt[(size_t)r * D + k]; ss += v * v; }
        p.mrstd[r] = 1.0f / sqrtf(ss / D + RMS_EPS);
    }
}

__device__ inline void nv_memkv(const Params& p, long gtid, long gsz) {
    GS_LOOP(it, (long)4 * NB * NM * 512) {
        const int c = it % 512, row = (it / 512) % (NB * NM), i = it / ((long)512 * NB * NM);
        const bf16_t* w = p.wt_mem + ((size_t)i * 512 + c) * D;
        const float* a = p.mem_prompt + (size_t)row * D;
        float acc = 0.f;
        for (int k = 0; k < D; ++k) acc += bf2f(f2bf(a[k])) * bf2f(w[k]);
        acc *= p.mrstd[row];
        p.o_mem[it] = acc;
        const int n = row / NM, m = row % NM, kvs = c / 256, h = (c % 256) / 64, e = c % 64;
        if (kvs == 0) p.mkb[((((size_t)i * NB + n) * 4 + h) * NM + m) * 64 + e] = f2bf(acc);
        else p.mvt[((((size_t)i * NB + n) * 4 + h) * 64 + e) * NM + m] = f2bf(acc);
    }
}

__device__ inline void nv_inproj(const Params& p, int i, long gtid, long gsz) {
    GS_LOOP(it, (long)M * (WP / 8)) {
        const int r = it % M, c0 = (it / M) * 8;
        const bf16_t* a = p.xb + (size_t)r * D;
        const bf16_t* w = p.wt_in + ((size_t)i * WP + c0) * D;
        float v[8];
#pragma unroll
        for (int j = 0; j < 8; ++j) v[j] = 0.f;
        for (int k = 0; k < D; k += 8) {
            float x[8]; ld8(a + k, x);
#pragma unroll
            for (int j = 0; j < 8; ++j) { float y[8]; ld8(w + (size_t)j * D + k, y);
#pragma unroll
                for (int q = 0; q < 8; ++q) v[j] += x[q] * y[q]; }
        }
        const float rs = p.rstd[r];
#pragma unroll
        for (int j = 0; j < 8; ++j) v[j] *= rs;
        inproj_store8(p, i, r, c0, v);
    }
}

#define OSM_HEAD(sc) const float _mn = fmaxf(mx, (sc)), _al = expf(mx - _mn), _pe = expf((sc) - _mn); den = den * _al + _pe; mx = _mn;
#define OSM_UPD_T(sc, vt, stride) do { OSM_HEAD(sc) _Pragma("unroll") for (int _e = 0; _e < 64; ++_e) { if ((_e & 15) == 0) asm volatile("" ::: "memory"); o[_e] = o[_e] * _al + _pe * bf2f((vt)[(size_t)_e * (stride)]); } } while (0)
#define OSM_UPD_B(sc, vrow) do { OSM_HEAD(sc) _Pragma("unroll") for (int _e = 0; _e < 64; _e += 8) { float _v[8]; if ((_e & 15) == 0) asm volatile("" ::: "memory"); ld8((vrow) + _e, _v); _Pragma("unroll") for (int _j = 0; _j < 8; ++_j) o[_e + _j] = o[_e + _j] * _al + _pe * _v[_j]; } } while (0)
#define OSM_UPD_F(sc, vrow) do { OSM_HEAD(sc) _Pragma("unroll") for (int _e = 0; _e < 64; _e += 4) { float _v[4]; if ((_e & 15) == 0) asm volatile("" ::: "memory"); ld4f((vrow) + _e, _v); _Pragma("unroll") for (int _j = 0; _j < 4; ++_j) o[_e + _j] = o[_e + _j] * _al + _pe * _v[_j]; } } while (0)

__device__ inline void nv_attn_a(const Params& p, int i, long gtid, long gsz) {
    const int li = i >> 1;
    GS_LOOP(it, (long)M * 4) {
        const int r = it % M, h = it / M;
        const bool samp = r >= MP;
        const int n = samp ? r - MP : r / S, t = samp ? 0 : r % S;
        float o[64]; float mx = -INFINITY, den = 0.f;
#pragma unroll
        for (int e = 0; e < 64; ++e) o[e] = 0.f;
        for (int g = 0; g < 3; ++g) {
            const int d = dil_of(g); const float sl = slope_a(g, h);
            const bf16_t* q = p.proj + (size_t)r * WP + g * 256 + h * 64;
            const float* cache = g == 0 ? p.cache_a0 : (g == 1 ? p.cache_a1 : p.cache_a2);
            const int lb = lb_of(g);
            for (int j = 0; j <= 128; ++j) {
                float sc = 0.f; const float bias = sl * (float)(j * d);
                if (!samp) {
                    const int tk = t - j * d; if (tk < 0) break;
                    const bf16_t* k = p.proj + (size_t)(n * S + tk) * WP + 768 + g * 256 + h * 64;
                    DOTM_B(sc, q, k); sc = sc * SCALE - bias;
                    const bf16_t* vt = p.vta + (((size_t)g * NB + n) * 4 + h) * 64 * S + cpos(tk, d);
                    OSM_UPD_T(sc, vt, S);
                } else {
                    const int idx = lb - j * d; if (idx < 0) break;
                    if (j == 0) {
                        const bf16_t* k = p.proj + (size_t)r * WP + 768 + g * 256 + h * 64;
                        DOTM_B(sc, q, k); sc = sc * SCALE - bias; OSM_UPD_B(sc, k + 768);
                    } else {
                        const float* k = cache + (((size_t)li * NS + n) * lb + idx) * 512 + h * 64;
                        DOTM_F(sc, q, k); sc = sc * SCALE - bias; OSM_UPD_F(sc, k + 256);
                    }
                }
            }
        }
        const bf16_t* gm = p.proj + (size_t)r * WP + 2304 + h * 64;
        bf16_t* z = p.z + (size_t)r * 512 + h * 64;
#pragma unroll
        for (int e = 0; e < 64; ++e) z[e] = f2bf(o[e] / den * silu_f(bf2f(gm[e])));
    }
}

__device__ inline void nv_cross(const Params& p, int i, int zld, int zoff, int qoff, int goff, long gtid, long gsz) {
    GS_LOOP(it, (long)M * 4) {
        const int r = it % M, h = it / M;
        const bool samp = r >= MP;
        const int n = samp ? r - MP : r / S;
        const bf16_t* qp = p.proj + (size_t)r * WP + qoff + h * 64;
        float o[64]; float mx = -INFINITY, den = 0.f;
#pragma unroll
        for (int e = 0; e < 64; ++e) o[e] = 0.f;
        for (int m = 0; m < NM; ++m) {
            float sc = 0.f;
            if (!samp) {
                const bf16_t* k = p.mkb + ((((size_t)i * NB + n) * 4 + h) * NM + m) * 64;
                const bf16_t* vt = p.mvt + (((size_t)i * NB + n) * 4 + h) * 64 * NM + m;
                DOTM_B(sc, qp, k); sc *= SCALE;
                OSM_UPD_T(sc, vt, NM);
            } else {
                const float* k = p.cache_mem_kv + ((((size_t)i * NS + n) * NM + m) * 2) * 256 + h * 64;
                DOTM_F(sc, qp, k); sc *= SCALE; OSM_UPD_F(sc, k + 256);
            }
        }
        const bf16_t* gx = p.proj + (size_t)r * WP + goff + h * 64;
        bf16_t* z = p.z + (size_t)r * zld + zoff + h * 64;
#pragma unroll
        for (int e = 0; e < 64; ++e) z[e] = f2bf(o[e] / den * silu_f(bf2f(gx[e])));
    }
}

__device__ inline void nv_outproj(const Params& p, int i, long gtid, long gsz) {
    const int KO = (i & 1) ? 1024 : 512;
    GS_LOOP(it, (long)M * (D / 8)) {
        const int r = it % M, c0 = (it / M) * 8;
        const bf16_t* a = p.z + (size_t)r * KO;
        const bf16_t* w = p.wt_out + (size_t)i * D * 1024 + (size_t)c0 * KO;
        float v[8];
#pragma unroll
        for (int j = 0; j < 8; ++j) v[j] = 0.f;
        for (int k = 0; k < KO; k += 8) {
            float x[8]; ld8(a + k, x);
#pragma unroll
            for (int j = 0; j < 8; ++j) { float y[8]; ld8(w + (size_t)j * KO + k, y);
#pragma unroll
                for (int q = 0; q < 8; ++q) v[j] += x[q] * y[q]; }
        }
#pragma unroll
        for (int j = 0; j < 8; ++j) p.y[(size_t)r * D + c0 + j] = v[j];
    }
}

__device__ inline void nv_finish(const Params& p, int i, long gtid, long gsz) {
    GS_LOOP(r, M) {
        float* x = r < MP ? p.o_y + (size_t)r * D : p.o_ys + (size_t)(r - MP) * D;
        const float* y = p.y + (size_t)r * D;
        float ss = 0.f;
        for (int k = 0; k < D; ++k) ss += y[k] * y[k];
        const float yr = 1.0f / sqrtf(ss / D + RMS_EPS);
        float s2 = 0.f;
        for (int k = 0; k < D; ++k) { const float v = x[k] + y[k] * yr * p.norm_post[i * D + k]; x[k] = v; p.xb[(size_t)r * D + k] = f2bf(v); s2 += v * v; }
        p.rstd[r] = 1.0f / sqrtf(s2 / D + RMS_EPS);
    }
}

__device__ inline void nv_cmp1_p(const Params& p, int li, long gtid, long gsz) {
    GS_LOOP(it, (long)2 * NB * 2 * NC_P * 128) {
        const int j = it % 128, c = (it / 128) % NC_P, nk = (it / (128 * NC_P)) % (NB * 2), ty = it / ((long)128 * NC_P * NB * 2);
        const bf16_t* a = (ty == 0 ? p.kc : p.vc) + ((size_t)nk * S + 16 * c) * 64;
        const bf16_t* w = p.w1t + ((size_t)(li * 2 + ty) * 128 + j) * 2048;
        const float acc = p.cb[(li * 2 + ty) * 128 + j] + dot_bb(a, w, 2048);
        p.hid[(((size_t)ty * NB * 2 + nk) * CSTR + c) * 128 + j] = silu_f(acc);
    }
}
__device__ inline void nv_cmp1_s(const Params& p, int li, long gtid, long gsz) {
    GS_LOOP(it, (long)2 * NS * 2 * NC_S * 128) {
        const int j = it % 128, c = (it / 128) % NC_S, nk = (it / (128 * NC_S)) % (NS * 2), ty = it / ((long)128 * NC_S * NS * 2);
        const int n = nk / 2, kv = nk % 2;
        const bf16_t* w = p.w1t + ((size_t)(li * 2 + ty) * 128 + j) * 2048;
        float acc = p.cb[(li * 2 + ty) * 128 + j];
        for (int l = 0; l < 32; ++l) {
            const int pos = 16 * c + l;
            const int page = p.page_table[n * NPAGES + pos / 128];
            const float* a = p.cache_b_pages + ((((size_t)page * 128 + pos % 128) * 2 + li) * 4 + ty) * 128 + kv * 64;
            for (int e = 0; e < 64; e += 8) { float x[8], y[8]; ld4f(a + e, x); ld4f(a + e + 4, x + 4); ld8(w + l * 64 + e, y);
#pragma unroll
                for (int q = 0; q < 8; ++q) acc += bf2f(f2bf(x[q])) * y[q]; }
        }
        p.hid_s[((((size_t)li * 2 + ty) * NS * 2 + nk) * CSTR + c) * 128 + j] = silu_f(acc);
    }
}
__device__ inline void nv_cmp2_p(const Params& p, int li, long gtid, long gsz) {
    GS_LOOP(it, (long)2 * NB * 2 * NC_P * 64) {
        const int e = it % 64, c = (it / 64) % NC_P, nk = (it / (64 * NC_P)) % (NB * 2), ty = it / ((long)64 * NC_P * NB * 2);
        const float* hd = p.hid + (((size_t)ty * NB * 2 + nk) * CSTR + c) * 128;
        const bf16_t* w = p.w2t + ((size_t)(li * 2 + ty) * 64 + e) * 128;
        float acc = 0.f;
        for (int j = 0; j < 128; ++j) acc += bf2f(f2bf(hd[j])) * bf2f(w[j]);
        if (ty == 0) p.kcmp[((size_t)nk * CSTR + c) * 64 + e] = f2bf(acc);
        else p.vcmpt[((size_t)nk * 64 + e) * CSTR + c] = f2bf(acc);
    }
}
__device__ inline void nv_cmp2_s(const Params& p, int li, long gtid, long gsz) {
    GS_LOOP(it, (long)2 * NS * 2 * NC_S * 64) {
        const int e = it % 64, c = (it / 64) % NC_S, nk = (it / (64 * NC_S)) % (NS * 2), ty = it / ((long)64 * NC_S * NS * 2);
        const float* hd = p.hid_s + ((((size_t)li * 2 + ty) * NS * 2 + nk) * CSTR + c) * 128;
        const bf16_t* w = p.w2t + ((size_t)(li * 2 + ty) * 64 + e) * 128;
        float acc = 0.f;
        for (int j = 0; j < 128; ++j) acc += bf2f(f2bf(hd[j])) * bf2f(w[j]);
        if (ty == 0) p.kcmp_s[(((size_t)li * NS * 2 + nk) * CSTR + c) * 64 + e] = f2bf(acc);
        else p.vcmpt_s[(((size_t)li * NS * 2 + nk) * 64 + e) * CSTR + c] = f2bf(acc);
    }
}

__device__ inline void nv_nsa_cmp(const Params& p, int i, long gtid, long gsz) {
    const int li = i >> 1;
    GS_LOOP(it, (long)M * 12) {
        const int r = it % M, hd = it / M, kv = hd / 6;
        const bool samp = r >= MP;
        const int n = samp ? r - MP : r / S, tq = samp ? PL : r % S;
        const int nc = samp ? NC_S : NC_P;
        const bf16_t* kb = samp ? p.kcmp_s + ((size_t)li * NS * 2 + n * 2 + kv) * CSTR * 64 : p.kcmp + ((size_t)n * 2 + kv) * CSTR * 64;
        const bf16_t* vb = samp ? p.vcmpt_s + ((size_t)li * NS * 2 + n * 2 + kv) * 64 * CSTR : p.vcmpt + ((size_t)n * 2 + kv) * 64 * CSTR;
        float q[64], o[64];
        LD64_B(q, p.proj + (size_t)r * WP + hd * 64);
        const float sl = slope_b(hd);
        float* pc = p.pc + ((size_t)r * 12 + hd) * CSTR;
        float mx = -INFINITY;
        for (int c = 0; c < nc; ++c) {
            const int ce = 16 * c + 31; if (ce > tq) break;
            float sc = 0.f;
            DOT64_B(sc, q, kb + c * 64);
            sc = sc * SCALE - sl * (float)(tq - ce);
            pc[c] = sc; mx = fmaxf(mx, sc);
        }
        float den = 0.f;
        for (int c = 0; c < nc; ++c) { const int ce = 16 * c + 31; if (ce > tq) break; den += expf(pc[c] - mx); }
        den = fmaxf(den, 1e-30f);
#pragma unroll
        for (int e = 0; e < 64; ++e) o[e] = 0.f;
        for (int c = 0; c < CSTR; ++c) {
            const int ce = 16 * c + 31;
            if (c < nc && ce <= tq) {
                const float pe = expf(pc[c] - mx) / den; pc[c] = pe;
#pragma unroll
                for (int e = 0; e < 64; ++e) o[e] += pe * bf2f(vb[(size_t)e * CSTR + c]);
            } else pc[c] = 0.f;
        }
        float* oc = p.oc + ((size_t)r * 12 + hd) * 64;
#pragma unroll
        for (int e = 0; e < 64; ++e) oc[e] = o[e];
    }
}
__device__ inline void nv_nsa_imp(const Params& p, long gtid, long gsz) {
    GS_LOOP(it, (long)M * 2 * IMPSTR) {
        const int b = it % IMPSTR, kv = (it / IMPSTR) % 2, r = it / (2 * IMPSTR);
        const bool samp = r >= MP;
        const int tq = samp ? PL : r % S, nsel = samp ? NSEL_S : NSEL_P;
        float v = -INFINITY;
        if (b < nsel) {
            float a = 0.f;
            for (int g = 0; g < 6; ++g) {
                const float* pc = p.pc + ((size_t)r * 12 + kv * 6 + g) * CSTR;
                for (int ii = 4 * b; ii < 4 * b + 4; ++ii) {
                    if (ii < CSTR) a += pc[ii];
                    if (ii - 1 >= 0 && ii - 1 < CSTR) a += pc[ii - 1];
                }
            }
            const int cur = tq / 64;
            const bool forced = (b == 0) || (b == cur) || (b == cur - 1);
            v = (b * 64 > tq) ? -INFINITY : (forced ? 1e4f : a);
        }
        p.imp[it] = v;
    }
}
__device__ inline void nv_nsa_topk(const Params& p, long gtid, long gsz) {
    GS_LOOP(it, (long)M * 2 * IMPSTR) {
        const int b = it % IMPSTR, r = it / (2 * IMPSTR);
        const int nsel = r >= MP ? NSEL_S : NSEL_P;
        const float* im = p.imp + (it - b);
        int sel = 0;
        if (b < nsel) {
            const float v = im[b]; int rank = 0;
            for (int b2 = 0; b2 < nsel; ++b2) { const float w = im[b2]; rank += (w > v || (w == v && b2 < b)) ? 1 : 0; }
            sel = rank < 16 ? 1 : 0;
        }
        p.selb[it] = sel;
    }
}
__device__ inline void nv_nsa_main(const Params& p, int i, long gtid, long gsz) {
    const int li = i >> 1;
    GS_LOOP(it, (long)M * 12) {
        const int r = it % M, hd = it / M, kv = hd / 6;
        const bool samp = r >= MP;
        const int n = samp ? r - MP : r / S, tq = samp ? PL : r % S;
        const int nsel = samp ? NSEL_S : NSEL_P;
        const float sl = slope_b(hd);
        const int* selb = p.selb + ((size_t)r * 2 + kv) * IMPSTR;
        float o[64]; float mx = -INFINITY, den = 0.f;
        const bf16_t* q = p.proj + (size_t)r * WP + hd * 64;
#pragma unroll
        for (int e = 0; e < 64; ++e) o[e] = 0.f;
        for (int b = 0; b < nsel; ++b) {
            if (!selb[b]) continue;
            for (int s = 0; s < 64; ++s) {
                const int kp = b * 64 + s; if (kp > tq) break;
                float sc = 0.f; const float bias = sl * (float)(tq - kp);
                if (!samp) {
                    const bf16_t* k = p.proj + (size_t)(n * S + kp) * WP + 768 + 2 * 128 + kv * 64;
                    const bf16_t* vt = p.vts + ((size_t)n * 2 + kv) * 64 * S + kp;
                    DOTM_B(sc, q, k); sc = sc * SCALE - bias; OSM_UPD_T(sc, vt, S);
                } else if (kp < PL) {
                    const int page = p.page_table[n * NPAGES + kp / 128];
                    const float* k = p.cache_b_pages + ((((size_t)page * 128 + kp % 128) * 2 + li) * 4 + 2) * 128 + kv * 64;
                    DOTM_F(sc, q, k); sc = sc * SCALE - bias; OSM_UPD_F(sc, k + 128);
                } else {
                    const bf16_t* k = p.proj + (size_t)r * WP + 768 + 2 * 128 + kv * 64;
                    DOTM_B(sc, q, k); sc = sc * SCALE - bias; OSM_UPD_B(sc, k + 128);
                }
            }
        }
        const float g0 = sigmoid_f(bf2f(p.proj[(size_t)r * WP + 1536 + hd * 3 + 0]));
        const float g1 = sigmoid_f(bf2f(p.proj[(size_t)r * WP + 1536 + hd * 3 + 1]));
        const float g2 = sigmoid_f(bf2f(p.proj[(size_t)r * WP + 1536 + hd * 3 + 2]));
        float* oc = p.oc + ((size_t)r * 12 + hd) * 64;
        const float inv_s = den > 0.f ? 1.0f / den : 0.f;
#pragma unroll
        for (int e = 0; e < 64; ++e) oc[e] = g0 * oc[e] + g1 * o[e] * inv_s;
        mx = -INFINITY; den = 0.f;
#pragma unroll
        for (int e = 0; e < 64; ++e) o[e] = 0.f;
        for (int dw = 512; dw >= 0; --dw) {
            const int kp = tq - dw; if (kp < 0) continue;
            float sc = 0.f; const float bias = sl * (float)dw;
            if (!samp) {
                const bf16_t* k = p.proj + (size_t)(n * S + kp) * WP + 768 + 4 * 128 + kv * 64;
                const bf16_t* vt = p.vtw + ((size_t)n * 2 + kv) * 64 * S + kp;
                DOTM_B(sc, q, k); sc = sc * SCALE - bias; OSM_UPD_T(sc, vt, S);
            } else if (dw > 0) {
                const int idx = LBW - dw; if (idx < 0) continue;
                const float* k = p.cache_b_win + ((((size_t)li * NS + n) * LBW + idx) * 2) * 128 + kv * 64;
                DOTM_F(sc, q, k); sc = sc * SCALE - bias; OSM_UPD_F(sc, k + 128);
            } else {
                const bf16_t* k = p.proj + (size_t)r * WP + 768 + 4 * 128 + kv * 64;
                DOTM_B(sc, q, k); sc = sc * SCALE - bias; OSM_UPD_B(sc, k + 128);
            }
        }
        const float inv_w = den > 0.f ? 1.0f / den : 0.f;
        const bf16_t* gm = p.proj + (size_t)r * WP + 1572 + hd * 64;
        bf16_t* z = p.z + (size_t)r * 1024 + hd * 64;
#pragma unroll
        for (int e = 0; e < 64; ++e) z[e] = f2bf((oc[e] + g2 * o[e] * inv_w) * silu_f(bf2f(gm[e])));
    }
}

#define XB_TMO      128
#define XB_XCNT(j)  (256  + 64 * (j))
#define XB_XSUB(j)  (1280 + 64 * (j))
#define XB_XGEN(j)  (2304 + 64 * (j))
#define XB_TOP      3328
#define XB_TOPGEN   3392
#define XCD_BAR_WORDS 3456
#define XB_SPIN_CAP (1u << 26)
#define LAS __attribute__((address_space(3)))

__device__ __forceinline__ unsigned xb_ld(unsigned* p)              { return __hip_atomic_load(p, __ATOMIC_RELAXED, __HIP_MEMORY_SCOPE_AGENT); }
__device__ __forceinline__ unsigned xb_add(unsigned* p, unsigned v) { return __hip_atomic_fetch_add(p, v, __ATOMIC_RELAXED, __HIP_MEMORY_SCOPE_AGENT); }
__device__ __forceinline__ unsigned xb_xcc_id() { return (unsigned)__builtin_amdgcn_s_getreg((3 << 11) | 20) & 0xFu; }
#define XB_SPIN(cond, bar) do { unsigned _sp = 0; while (cond) { __builtin_amdgcn_s_sleep(1); \
    if ((++_sp & 255u) == 0u) { if (xb_ld(&(bar)[XB_TMO])) break; if (_sp > XB_SPIN_CAP) { atomicAdd(&(bar)[XB_TMO], 1u); break; } } } } while (0)

struct XcdBarrier {
    unsigned* bar; unsigned x;
    volatile LAS unsigned* st;
};

__device__ __forceinline__ XcdBarrier xcd_barrier_post(unsigned* bar, volatile LAS unsigned* st) {
    XcdBarrier b; b.bar = bar; b.x = xb_xcc_id(); b.st = st;
    if (threadIdx.x == 0) (void)xb_add(&bar[XB_XCNT(b.x)], 1u);
    return b;
}
__device__ __forceinline__ void xcd_barrier_complete(unsigned* bar, unsigned x, unsigned& nloc, unsigned& nx) {
    const unsigned G = gridDim.x * gridDim.y * gridDim.z;
    unsigned sum, cnt, mine, sp = 0u;
    for (;;) {
        sum = 0u; cnt = 0u; mine = 0u;
#pragma unroll
        for (unsigned j = 0; j < 16; ++j) { const unsigned c = xb_ld(&bar[XB_XCNT(j)]); sum += c; cnt += (c > 0u) ? 1u : 0u; mine = (j == x) ? c : mine; }
        if (sum == G) break;
        __builtin_amdgcn_s_sleep(1);
        if ((++sp & 255u) == 0u) { if (xb_ld(&bar[XB_TMO])) break; if (sp > XB_SPIN_CAP) { atomicAdd(&bar[XB_TMO], 1u); break; } }
    }
    nloc = mine > 0u ? mine : 1u; nx = cnt > 0u ? cnt : 1u;
}

__device__ __forceinline__ void xcd_barrier(const XcdBarrier& b) {
    asm volatile("s_waitcnt vmcnt(0)" ::: "memory");
    __syncthreads();
    if (threadIdx.x == 0) {
        unsigned* bar = b.bar;
        __builtin_amdgcn_s_waitcnt(0);
        unsigned nloc = b.st[0], nx = b.st[1];
        if (nloc == 0u) { xcd_barrier_complete(bar, b.x, nloc, nx); b.st[0] = nloc; b.st[1] = nx; }
        const unsigned old = xb_add(&bar[XB_XSUB(b.x)], 1u);
        const unsigned gen = old / nloc;
        if (old + 1u == (gen + 1u) * nloc) {
            __builtin_amdgcn_fence(__ATOMIC_RELEASE, "agent");
            asm volatile("s_waitcnt vmcnt(0)" ::: "memory");
            const unsigned og = xb_add(&bar[XB_TOP], 1u);
            const unsigned tg = og / nx;
            if (og + 1u == (tg + 1u) * nx) xb_add(&bar[XB_TOPGEN], 1u);
            else XB_SPIN(xb_ld(&bar[XB_TOPGEN]) == tg, bar);
            __builtin_amdgcn_fence(__ATOMIC_ACQUIRE, "agent");
            xb_add(&bar[XB_XGEN(b.x)], 1u);
            asm volatile("s_waitcnt vmcnt(0)" ::: "memory");
        } else {
            XB_SPIN(xb_ld(&bar[XB_XGEN(b.x)]) == gen, bar);
            __builtin_amdgcn_fence(__ATOMIC_ACQUIRE, "agent");
            asm volatile("s_waitcnt vmcnt(0)" ::: "memory");
        }
    }
    __syncthreads();
}


struct WsAlloc {
    char* base; size_t off;
    template <class T> T* get(size_t n) { T* r = (T*)(base + off); off += (n * sizeof(T) + 255) & ~(size_t)255; return r; }
};

static void fill_params(Params& p, void* const* d_in, void* d_out, void* d_ws) {
    memset(&p, 0, sizeof(p));
    p.x_prompt = (const float*)d_in[0]; p.x_sample = (const float*)d_in[1]; p.cache_mem_kv = (const float*)d_in[2];
    p.cache_a0 = (const float*)d_in[3]; p.cache_a1 = (const float*)d_in[4]; p.cache_a2 = (const float*)d_in[5];
    p.cache_b_pages = (const float*)d_in[6]; p.cache_b_win = (const float*)d_in[7]; p.page_table = (const int*)d_in[8];
    p.mem_prompt = (const float*)d_in[9]; p.norm_pre = (const float*)d_in[10]; p.norm_post = (const float*)d_in[11]; p.norm_mem = (const float*)d_in[12];
    p.w_mem_kv = (const float*)d_in[13]; p.w_in_a = (const float*)d_in[14]; p.w_out_a = (const float*)d_in[15]; p.w_in_b = (const float*)d_in[16];
    p.w_out_b = (const float*)d_in[17]; p.cmp_pos = (const float*)d_in[18]; p.cmp_w1 = (const float*)d_in[19]; p.cmp_w2 = (const float*)d_in[20];
    const size_t osz[13] = {(size_t)NB * S * D, (size_t)NS * D, (size_t)4 * NB * NM * 512, (size_t)2 * NB * WROWS0 * 512, (size_t)2 * NB * WROWS1 * 512, (size_t)2 * NB * WROWS2 * 512,
                            (size_t)NB * S * 1024, (size_t)2 * NB * WROWS1 * 256, (size_t)2 * NS * 512, (size_t)2 * NS * 512, (size_t)2 * NS * 512, (size_t)NS * 1024, (size_t)2 * NS * 256};
    float* o = (float*)d_out; float* outs[13];
    for (int i = 0; i < 13; ++i) { outs[i] = o; o += osz[i]; }
    p.o_y = outs[0]; p.o_ys = outs[1]; p.o_mem = outs[2]; p.o_pa0 = outs[3]; p.o_pa1 = outs[4]; p.o_pa2 = outs[5]; p.o_pb = outs[6]; p.o_pbw = outs[7];
    p.o_sa0 = outs[8]; p.o_sa1 = outs[9]; p.o_sa2 = outs[10]; p.o_sb = outs[11]; p.o_sbw = outs[12];
    WsAlloc a{(char*)d_ws, 0};
    p.bar = a.get<unsigned>(4096);
    p.wt_in = a.get<bf16_t>((size_t)4 * WP * D); p.wt_out = a.get<bf16_t>((size_t)4 * D * 1024); p.wt_mem = a.get<bf16_t>((size_t)4 * 512 * D);
    p.w1t = a.get<bf16_t>((size_t)4 * 128 * 2048); p.w2t = a.get<bf16_t>((size_t)4 * 64 * 128); p.cb = a.get<float>(4 * 128);
    p.xb = a.get<bf16_t>((size_t)MPAD * D); p.rstd = a.get<float>(MPAD); p.mrstd = a.get<float>(NB * NM);
    p.proj = a.get<bf16_t>((size_t)MPAD * WP); p.vta = a.get<bf16_t>((size_t)3 * NB * 4 * 64 * S);
    p.vts = a.get<bf16_t>((size_t)NB * 2 * 64 * S); p.vtw = a.get<bf16_t>((size_t)NB * 2 * 64 * S);
    p.kc = a.get<bf16_t>((size_t)NB * 2 * S * 64); p.vc = a.get<bf16_t>((size_t)NB * 2 * S * 64);
    p.mkb = a.get<bf16_t>((size_t)4 * NB * 4 * NM * 64); p.mvt = a.get<bf16_t>((size_t)4 * NB * 4 * 64 * NM);
    p.hid = a.get<float>((size_t)2 * NB * 2 * CSTR * 128); p.hid_s = a.get<float>((size_t)2 * 2 * NS * 2 * CSTR * 128);
    p.kcmp = a.get<bf16_t>((size_t)NB * 2 * CSTR * 64); p.vcmpt = a.get<bf16_t>((size_t)NB * 2 * 64 * CSTR);
    p.kcmp_s = a.get<bf16_t>((size_t)2 * NS * 2 * CSTR * 64); p.vcmpt_s = a.get<bf16_t>((size_t)2 * NS * 2 * 64 * CSTR);
    p.z = a.get<bf16_t>((size_t)MPAD * 1024); p.y = a.get<float>((size_t)MPAD * D);
    p.pc = a.get<float>((size_t)M * 12 * CSTR); p.oc = a.get<float>((size_t)M * 12 * 64);
    p.imp = a.get<float>((size_t)M * 2 * IMPSTR); p.selb = a.get<int>((size_t)M * 2 * IMPSTR);
}


constexpr int NTHREADS = 512;
constexpr int LDS_STAGE = 131072;
constexpr int LDS_BYTES = LDS_STAGE + 16;

__global__ void __launch_bounds__(NTHREADS, 2) mega(Params p) {
    extern __shared__ __attribute__((aligned(16))) unsigned char smem[];
    LAS unsigned char* lds = (LAS unsigned char*)smem;
    volatile LAS unsigned* xbw = (volatile LAS unsigned*)(lds + LDS_STAGE);
    if (threadIdx.x == 0) { xbw[0] = 0u; xbw[1] = 0u; xbw[2] = 0u; xbw[3] = 0u; }
    __syncthreads();
    XcdBarrier bar = xcd_barrier_post(p.bar, xbw);
    const long gtid = (long)blockIdx.x * blockDim.x + threadIdx.x, gsz = (long)gridDim.x * blockDim.x;
#define BAR() xcd_barrier(bar)
    nv_prep_weights(p, gtid, gsz); nv_prep_x(p, gtid, gsz); BAR();
    nv_memkv(p, gtid, gsz);
    for (int i = 0; i < 4; ++i) {
        const int li = i >> 1;
        nv_inproj(p, i, gtid, gsz); BAR();
        if ((i & 1) == 0) { nv_attn_a(p, i, gtid, gsz); nv_cross(p, i, 512, 256, 2560, 2816, gtid, gsz); BAR(); }
        else {
            nv_cmp1_p(p, li, gtid, gsz); nv_cmp1_s(p, li, gtid, gsz); BAR();
            nv_cmp2_p(p, li, gtid, gsz); nv_cmp2_s(p, li, gtid, gsz); BAR();
            nv_nsa_cmp(p, i, gtid, gsz); BAR();
            nv_nsa_imp(p, gtid, gsz); BAR();
            nv_nsa_topk(p, gtid, gsz); BAR();
            nv_nsa_main(p, i, gtid, gsz); nv_cross(p, i, 1024, 768, 2340, 2596, gtid, gsz); BAR();
        }
        nv_outproj(p, i, gtid, gsz); BAR();
        nv_finish(p, i, gtid, gsz); BAR();
    }
}

extern "C" void kernel_launch(void* const* d_in, const int* in_sizes, int n_in,
                              void* d_out, int out_size, void* d_ws, size_t ws_size,
                              hipStream_t stream) {
    static int grid = 0;
    if (grid == 0) {
        int dev = 0, cus = 0, per_cu = 0;
        if (hipGetDevice(&dev) != hipSuccess || hipDeviceGetAttribute(&cus, hipDeviceAttributeMultiprocessorCount, dev) != hipSuccess) { grid = -1; return; }
        if (hipFuncSetAttribute((const void*)mega, hipFuncAttributeMaxDynamicSharedMemorySize, LDS_BYTES) != hipSuccess) { grid = -1; return; }
        if (hipOccupancyMaxActiveBlocksPerMultiprocessor(&per_cu, (const void*)mega, NTHREADS, LDS_BYTES) != hipSuccess || per_cu < 1) { (void)hipGetLastError(); }
        grid = cus;
    }
    if (grid < 0) return;
    Params p; fill_params(p, d_in, d_out, d_ws);
    (void)hipMemsetAsync(p.bar, 0, XCD_BAR_WORDS * sizeof(unsigned), stream);
    hipLaunchKernelGGL(mega, dim3(grid), dim3(NTHREADS), LDS_BYTES, stream, p);
}
```

```cpp
#include <hip/hip_runtime.h>
#include <cstring>
#include <cmath>

#ifdef SMALL
constexpr int D = 128, NB = 1, S = 2048, NS = 2, PL = 2048, NM = 32;
#else
constexpr int D = 1024, NB = 2, S = 8192, NS = 32, PL = 8192, NM = 256;
#endif
constexpr int MP = NB * S, M = MP + NS;
constexpr int MPAD = ((M + 255) / 256) * 256;
constexpr int WP = 3072;
constexpr int W_IN_B = 2852;
constexpr int NPAGES = PL / 128;
constexpr int NC_P = (S - 32) / 16 + 1;
constexpr int NC_S = (PL + 1 - 32) / 16 + 1;
constexpr int NSEL_P = (S + 63) / 64, NSEL_S = (PL + 1 + 63) / 64;
constexpr int HB_P = S / 16, HB_S = PL / 16;
constexpr int CSTR = 512;
constexpr int IMPSTR = 160;
constexpr float SCALE = 0.125f, RMS_EPS = 1e-6f;
constexpr int WROWS0 = (128 < S ? 128 : S), WROWS1 = (512 < S ? 512 : S), WROWS2 = (2048 < S ? 2048 : S);
constexpr int LB0 = (128 < PL ? 128 : PL), LB1 = (512 < PL ? 512 : PL), LB2 = (2048 < PL ? 2048 : PL);
constexpr int LBW = (512 < PL ? 512 : PL);
static_assert(NC_P <= CSTR && NC_S <= CSTR, "cmp stride");
static_assert(NSEL_S <= IMPSTR, "imp stride");

typedef unsigned short bf16_t;
constexpr int WQ_BASE = 3584;
constexpr int NTHREADS = 512;
constexpr int LDS_STAGE = 152832;
constexpr int LDS_PARAMS = LDS_STAGE + 16;
constexpr int LDS_BYTES = LDS_PARAMS + 1024;

#define PARAM_FIELDS(X) \
    X(const float*, x_prompt) X(const float*, x_sample) X(const float*, cache_mem_kv) X(const float*, cache_a0) X(const float*, cache_a1) X(const float*, cache_a2) \
    X(const float*, cache_b_pages) X(const float*, cache_b_win) X(const int*, page_table) X(const float*, mem_prompt) X(const float*, norm_pre) X(const float*, norm_post) \
    X(const float*, norm_mem) X(const float*, w_mem_kv) X(const float*, w_in_a) X(const float*, w_out_a) X(const float*, w_in_b) X(const float*, w_out_b) \
    X(const float*, cmp_pos) X(const float*, cmp_w1) X(const float*, cmp_w2) \
      \
    X(float*, o_y) X(float*, o_ys) X(float*, o_mem) X(float*, o_pa0) X(float*, o_pa1) X(float*, o_pa2) X(float*, o_pb) X(float*, o_pbw) \
    X(float*, o_sa0) X(float*, o_sa1) X(float*, o_sa2) X(float*, o_sb) X(float*, o_sbw) \
      \
    X(bf16_t*, wt_in)      \
    X(bf16_t*, wt_out)     \
    X(bf16_t*, wt_mem)     \
    X(bf16_t*, w1t)        \
    X(bf16_t*, w2t)        \
    X(float*, cb)          \
    X(bf16_t*, xb)         \
    X(float*, rstd)        \
    X(float*, mrstd)       \
    X(bf16_t*, proj)       \
    X(bf16_t*, vta)        \
    X(bf16_t*, vts) X(bf16_t*, vtw)     \
    X(bf16_t*, kta)        \
    X(bf16_t*, kts) X(bf16_t*, ktw)     \
    X(bf16_t*, kc) X(bf16_t*, vc)       \
    X(bf16_t*, mkb)        \
    X(bf16_t*, mvt)        \
    X(float*, hid)         \
    X(float*, hid_s)       \
    X(bf16_t*, kcmp)       \
    X(bf16_t*, vcmpt)      \
    X(bf16_t*, kcmp_s)     \
    X(bf16_t*, vcmpt_s)    \
    X(bf16_t*, z)          \
    X(float*, y)           \
    X(bf16_t*, yb)         \
    X(float*, pc)          \
    X(float*, oc)          \
    X(float*, imp)         \
    X(int*, selb)          \
    X(bf16_t*, w1pq)       \
    X(bf16_t*, cachec)     \
    X(bf16_t*, pq_s)       \
    X(bf16_t*, pq_p)       \
    X(bf16_t*, memb)       \
    X(unsigned*, bar)
struct Params {
#define X(t, n) t n;
    PARAM_FIELDS(X)
#undef X
};

__device__ __host__ inline bf16_t f2bf(float f) {
    union { float f; unsigned u; } v; v.f = f;
    unsigned u = v.u;
    u += 0x7FFFu + ((u >> 16) & 1u);
    return (bf16_t)(u >> 16);
}
__device__ __host__ inline float bf2f(bf16_t b) {
    union { float f; unsigned u; } v; v.u = ((unsigned)b) << 16; return v.f;
}
__device__ __host__ inline float silu_f(float x) { return x / (1.0f + expf(-x)); }
__device__ __host__ inline float sigmoid_f(float x) { return 1.0f / (1.0f + expf(-x)); }
__device__ __host__ inline float slope_a(int g, int h) { return exp2f(-8.0f * (float)(g * 4 + h + 1) / 12.0f); }
__device__ __host__ inline float slope_b(int hd) { return exp2f(-8.0f * (float)(hd + 1) / 12.0f); }
__device__ __host__ inline int dil_of(int g) { return g == 0 ? 1 : (g == 1 ? 4 : 16); }
__device__ __host__ inline int wrows_of(int g) { return g == 0 ? WROWS0 : (g == 1 ? WROWS1 : WROWS2); }
__device__ __host__ inline int lb_of(int g) { return g == 0 ? LB0 : (g == 1 ? LB1 : LB2); }
constexpr int VT_LD = 32;
__device__ __host__ inline size_t vt_pos(int pos) { return (size_t)(pos >> 5) * 2048 + (size_t)(pos & 31); }
__device__ __host__ inline size_t kt_pos(int pos, int e0) { return (size_t)(pos >> 5) * 2048 + (size_t)(e0 >> 5) * 1024 + (size_t)(pos & 31) * 32 + (size_t)(e0 & 31); }
__device__ __host__ inline int cpos(int t, int d) { return (t % d) * (S / d) + t / d; }

__device__ __host__ inline unsigned pack_bf2(float lo, float hi) { return (unsigned)f2bf(lo) | ((unsigned)f2bf(hi) << 16); }
__device__ __host__ inline void st8_bf(bf16_t* dst, const float* v) {
    uint4 u; u.x = pack_bf2(v[0], v[1]); u.y = pack_bf2(v[2], v[3]); u.z = pack_bf2(v[4], v[5]); u.w = pack_bf2(v[6], v[7]);
    *(uint4*)dst = u;
}
__device__ __host__ inline void st8_f(float* dst, const float* v) {
    float4 a, b; a.x = v[0]; a.y = v[1]; a.z = v[2]; a.w = v[3]; b.x = v[4]; b.y = v[5]; b.z = v[6]; b.w = v[7];
    *(float4*)dst = a; *(float4*)(dst + 4) = b;
}
__device__ __host__ __forceinline__ void inproj_extra8(const Params& p, int i, int r, int c0, const float* v, bool compact_copies = true) {
    const int li = i >> 1;
    const bool samp = r >= MP;
    const int n = samp ? r - MP : r / S, t = samp ? 0 : r % S;
    if ((i & 1) == 0) {
        if (c0 >= 768 && c0 < 2304) {
            const int s = c0 / 768, g = (c0 % 768) / 256, h = (c0 % 256) / 64, e0 = c0 % 64;
            float* ob = samp ? (g == 0 ? +p.o_sa0 : (g == 1 ? +p.o_sa1 : +p.o_sa2)) : (g == 0 ? +p.o_pa0 : (g == 1 ? +p.o_pa1 : +p.o_pa2));
            if (samp) {
                st8_f(ob + (size_t)(li * NS + n) * 512 + (s - 1) * 256 + h * 64 + e0, v);
            } else {
                const int wr = wrows_of(g);
                if (t >= S - wr) st8_f(ob + ((size_t)(li * NB + n) * wr + (t - (S - wr))) * 512 + (s - 1) * 256 + h * 64 + e0, v);
                if (s == 1) {
                    const int d = dil_of(g);
                    st8_bf(p.kta + (((size_t)g * NB + n) * 4 + h) * 64 * S + kt_pos(cpos(t, d), e0), v);
                } else {
                    const int d = dil_of(g);
                    bf16_t* vt = p.vta + (((size_t)g * NB + n) * 4 + h) * 64 * S + vt_pos(cpos(t, d)) + e0 * VT_LD;
                    for (int j = 0; j < 8; ++j) vt[j * VT_LD] = f2bf(v[j]);
                }
            }
        }
    } else {
        if (c0 >= 768 && c0 < 1536) {
            const int cc = c0 - 768, ty = cc / 128, kv = (cc % 128) / 64, e0 = cc % 64;
            if (ty < 4) {
                st8_f(samp ? +p.o_sb + (size_t)(n * 2 + li) * 512 + cc : +p.o_pb + ((size_t)(n * S + t) * 2 + li) * 512 + cc, v);
            } else {
                if (samp) st8_f(p.o_sbw + (size_t)(li * NS + n) * 256 + (cc - 512), v);
                else if (t >= S - WROWS1) st8_f(p.o_pbw + ((size_t)(li * NB + n) * WROWS1 + (t - (S - WROWS1))) * 256 + (cc - 512), v);
            }
            if (!samp) {
                if ((ty == 0 || ty == 1) && compact_copies) {
                    st8_bf((ty == 0 ? +p.kc : +p.vc) + (((size_t)n * 2 + kv) * S + t) * 64 + e0, v);
                } else if (ty == 2 || ty == 4) {
                    st8_bf((ty == 2 ? +p.kts : +p.ktw) + ((size_t)n * 2 + kv) * 64 * S + kt_pos(t, e0), v);
                } else if (ty == 3 || ty == 5) {
                    bf16_t* o = (ty == 3 ? +p.vts : +p.vtw) + ((size_t)n * 2 + kv) * 64 * S + vt_pos(t) + e0 * VT_LD;
                    for (int j = 0; j < 8; ++j) o[j * VT_LD] = f2bf(v[j]);
                }
            }
        }
    }
}


#define GS_LOOP(it, n) for (long it = gtid; it < (long)(n); it += gsz)

__device__ inline void ld8(const bf16_t* p, float* f) {
    const uint4 u = *(const uint4*)p;
    f[0] = __uint_as_float(u.x << 16); f[1] = __uint_as_float(u.x & 0xffff0000u);
    f[2] = __uint_as_float(u.y << 16); f[3] = __uint_as_float(u.y & 0xffff0000u);
    f[4] = __uint_as_float(u.z << 16); f[5] = __uint_as_float(u.z & 0xffff0000u);
    f[6] = __uint_as_float(u.w << 16); f[7] = __uint_as_float(u.w & 0xffff0000u);
}
__device__ inline void ld4f(const float* p, float* f) { const float4 u = *(const float4*)p; f[0] = u.x; f[1] = u.y; f[2] = u.z; f[3] = u.w; }
__device__ inline float dot_bb(const bf16_t* a, const bf16_t* b, int n) {
    float acc = 0.f;
    for (int k = 0; k < n; k += 8) { float x[8], y[8]; ld8(a + k, x); ld8(b + k, y);
#pragma unroll
        for (int j = 0; j < 8; ++j) acc += x[j] * y[j]; }
    return acc;
}
#define DOT64_B(acc, qf, kptr) do { _Pragma("unroll") for (int _k = 0; _k < 64; _k += 8) { float _y[8]; ld8((kptr) + _k, _y); _Pragma("unroll") for (int _j = 0; _j < 8; ++_j) acc += qf[_k + _j] * _y[_j]; } } while (0)
#define DOT64_F(acc, qf, kptr) do { _Pragma("unroll") for (int _k = 0; _k < 64; _k += 4) { float _y[4]; ld4f((kptr) + _k, _y); _Pragma("unroll") for (int _j = 0; _j < 4; ++_j) acc += qf[_k + _j] * _y[_j]; } } while (0)
#define LD64_B(dst, ptr) do { _Pragma("unroll") for (int _k = 0; _k < 64; _k += 8) ld8((ptr) + _k, (dst) + _k); } while (0)
#define LD64_F(dst, ptr) do { _Pragma("unroll") for (int _k = 0; _k < 64; _k += 4) ld4f((ptr) + _k, (dst) + _k); } while (0)

#define DOTM_B(acc, qp, kptr) do { _Pragma("unroll") for (int _k = 0; _k < 64; _k += 8) { float _x[8], _y[8]; ld8((qp) + _k, _x); ld8((kptr) + _k, _y); _Pragma("unroll") for (int _j = 0; _j < 8; ++_j) acc += _x[_j] * _y[_j]; } } while (0)
#define DOTM_F(acc, qp, kptr) do { _Pragma("unroll") for (int _k = 0; _k < 64; _k += 8) { float _x[8], _y[8]; ld8((qp) + _k, _x); ld4f((kptr) + _k, _y); ld4f((kptr) + _k + 4, _y + 4); _Pragma("unroll") for (int _j = 0; _j < 8; ++_j) acc += _x[_j] * _y[_j]; } } while (0)

__device__ __forceinline__ void nv_prep_weights(const Params& p, long gtid, long gsz) {
    GS_LOOP(it, (long)4 * WP * D) {
        const int k = it % D, c = (it / D) % WP, i = it / ((long)D * WP);
        const int li = i >> 1;
        float w = 0.f;
        if ((i & 1) == 0) w = p.w_in_a[((size_t)li * D + k) * 3072 + c];
        else if (c < W_IN_B) w = p.w_in_b[((size_t)li * D + k) * W_IN_B + c];
        p.wt_in[it] = f2bf(w * p.norm_pre[i * D + k]);
    }
    GS_LOOP(it, (long)4 * D * 1024) {
        const int i = it / ((long)D * 1024); const long rem = it % ((long)D * 1024);
        const int li = i >> 1;
        if ((i & 1) == 0) {
            if (rem < (long)D * 512) { const int k = rem % 512, c = rem / 512; p.wt_out[it] = f2bf(p.w_out_a[((size_t)li * 512 + k) * D + c]); }
        } else { const int k = rem % 1024, c = rem / 1024; p.wt_out[it] = f2bf(p.w_out_b[((size_t)li * 1024 + k) * D + c]); }
    }
    GS_LOOP(it, (long)4 * 512 * D) {
        const int k = it % D, c = (it / D) % 512, i = it / ((long)D * 512);
        p.wt_mem[it] = f2bf(p.w_mem_kv[((size_t)i * D + k) * 512 + c] * p.norm_mem[i * D + k]);
    }
    GS_LOOP(it, (long)4 * 128 * 2048) {
        const int k = it % 2048, j = (it / 2048) % 128, lt = it / (2048 * 128);
        p.w1t[it] = f2bf(p.cmp_w1[((size_t)lt * 2048 + k) * 128 + j]);
    }
    GS_LOOP(it, (long)4 * 256 * 1024) {
        const int k = it % 1024, jj = (it / 1024) % 256, lt = it / (1024 * 256);
        p.w1pq[it] = f2bf(p.cmp_w1[((size_t)lt * 2048 + (jj < 128 ? k : 1024 + k)) * 128 + (jj & 127)]);
    }
    GS_LOOP(it, (long)4 * 64 * 128) {
        const int j = it % 128, e = (it / 128) % 64, lt = it / (128 * 64);
        p.w2t[it] = f2bf(p.cmp_w2[((size_t)lt * 128 + j) * 64 + e]);
    }
    GS_LOOP(it, (long)4 * 128) {
        const int j = it % 128, lt = it / 128;
        float a = 0.f;
        for (int k = 0; k < 2048; ++k) a += p.cmp_pos[(size_t)lt * 2048 + k] * p.cmp_w1[((size_t)lt * 2048 + k) * 128 + j];
        p.cb[it] = a;
    }
}

__device__ __forceinline__ void nv_prep_x(const Params& p, long gtid, long gsz) {
    GS_LOOP(r, M) {
        const float* src = r < MP ? p.x_prompt + (size_t)r * D : p.x_sample + (size_t)(r - MP) * D;
        float* dst = r < MP ? p.o_y + (size_t)r * D : p.o_ys + (size_t)(r - MP) * D;
        float ss = 0.f;
        for (int k = 0; k < D; ++k) { const float v = src[k]; dst[k] = v; p.xb[(size_t)r * D + k] = f2bf(v); ss += v * v; }
        p.rstd[r] = 1.0f / sqrtf(ss / D + RMS_EPS);
    }
    GS_LOOP(r, NB * NM) {
        float ss = 0.f;
        for (int k = 0; k < D; ++k) { const float v = p.mem_prompt[(size_t)r * D + k]; ss += v * v; }
        p.mrstd[r] = 1.0f / sqrtf(ss / D + RMS_EPS);
    }
}

__device__ __forceinline__ void nv_memkv(const Params& p, long gtid, long gsz) {
    GS_LOOP(it, (long)4 * NB * NM * 512) {
        const int c = it % 512, row = (it / 512) % (NB * NM), i = it / ((long)512 * NB * NM);
        const bf16_t* w = p.wt_mem + ((size_t)i * 512 + c) * D;
        const float* a = p.mem_prompt + (size_t)row * D;
        float acc = 0.f;
        for (int k = 0; k < D; ++k) acc += bf2f(f2bf(a[k])) * bf2f(w[k]);
        acc *= p.mrstd[row];
        p.o_mem[it] = acc;
        const int n = row / NM, m = row % NM, kvs = c / 256, h = (c % 256) / 64, e = c % 64;
        if (kvs == 0) p.mkb[((((size_t)i * NB + n) * 4 + h) * NM + m) * 64 + e] = f2bf(acc);
        else p.mvt[((((size_t)i * NB + n) * 4 + h) * 64 + e) * NM + m] = f2bf(acc);
    }
}

__device__ __forceinline__ void nv_inproj(const Params& p, int i, long gtid, long gsz) {
    GS_LOOP(it, (long)M * (WP / 8)) {
        const int r = it % M, c0 = (it / M) * 8;
        const bf16_t* a = p.xb + (size_t)r * D;
        const bf16_t* w = p.wt_in + ((size_t)i * WP + c0) * D;
        float v[8];
#pragma unroll
        for (int j = 0; j < 8; ++j) v[j] = 0.f;
        for (int k = 0; k < D; k += 8) {
            float x[8]; ld8(a + k, x);
#pragma unroll
            for (int j = 0; j < 8; ++j) { float y[8]; ld8(w + (size_t)j * D + k, y);
#pragma unroll
                for (int q = 0; q < 8; ++q) v[j] += x[q] * y[q]; }
        }
        const float rs = p.rstd[r];
#pragma unroll
        for (int j = 0; j < 8; ++j) v[j] *= rs;
        st8_bf(p.proj + (size_t)r * WP + c0, v);
    }
}
__device__ __forceinline__ void nv_post(const Params& p, int i, long gtid, long gsz) {
    const int nc8 = ((i & 1) ? 768 : 1536) / 8;
    GS_LOOP(it, (long)M * nc8) {
        const int r = it % M, c0 = 768 + (it / M) * 8;
        float v[8]; ld8(p.proj + (size_t)r * WP + c0, v);
        inproj_extra8(p, i, r, c0, v);
    }
}

#define OSM_HEAD(sc) const float _mn = fmaxf(mx, (sc)), _al = expf(mx - _mn), _pe = expf((sc) - _mn); den = den * _al + _pe; mx = _mn;
#define OSM_UPD_T(sc, vt, stride) do { OSM_HEAD(sc) _Pragma("unroll") for (int _e = 0; _e < 64; ++_e) { if ((_e & 15) == 0) asm volatile("" ::: "memory"); o[_e] = o[_e] * _al + _pe * bf2f((vt)[(size_t)_e * (stride)]); } } while (0)
#define OSM_UPD_B(sc, vrow) do { OSM_HEAD(sc) _Pragma("unroll") for (int _e = 0; _e < 64; _e += 8) { float _v[8]; if ((_e & 15) == 0) asm volatile("" ::: "memory"); ld8((vrow) + _e, _v); _Pragma("unroll") for (int _j = 0; _j < 8; ++_j) o[_e + _j] = o[_e + _j] * _al + _pe * _v[_j]; } } while (0)
#define OSM_UPD_F(sc, vrow) do { OSM_HEAD(sc) _Pragma("unroll") for (int _e = 0; _e < 64; _e += 4) { float _v[4]; if ((_e & 15) == 0) asm volatile("" ::: "memory"); ld4f((vrow) + _e, _v); _Pragma("unroll") for (int _j = 0; _j < 4; ++_j) o[_e + _j] = o[_e + _j] * _al + _pe * _v[_j]; } } while (0)

__device__ __forceinline__ void nv_attn_a(const Params& p, int i, int r0, long gtid, long gsz) {
    const int li = i >> 1;
    GS_LOOP(it, (long)(M - r0) * 4) {
        const int r = r0 + it % (M - r0), h = it / (M - r0);
        const bool samp = r >= MP;
        const int n = samp ? r - MP : r / S, t = samp ? 0 : r % S;
        float o[64]; float mx = -INFINITY, den = 0.f;
#pragma unroll
        for (int e = 0; e < 64; ++e) o[e] = 0.f;
        for (int g = 0; g < 3; ++g) {
            const int d = dil_of(g); const float sl = slope_a(g, h);
            const bf16_t* q = p.proj + (size_t)r * WP + g * 256 + h * 64;
            const float* cache = g == 0 ? +p.cache_a0 : (g == 1 ? +p.cache_a1 : +p.cache_a2);
            const int lb = lb_of(g);
            for (int j = 0; j <= 128; ++j) {
                float sc = 0.f; const float bias = sl * (float)(j * d);
                if (!samp) {
                    const int tk = t - j * d; if (tk < 0) break;
                    const bf16_t* k = p.proj + (size_t)(n * S + tk) * WP + 768 + g * 256 + h * 64;
                    DOTM_B(sc, q, k); sc = sc * SCALE - bias;
                    const bf16_t* vt = p.vta + (((size_t)g * NB + n) * 4 + h) * 64 * S + vt_pos(cpos(tk, d));
                    OSM_UPD_T(sc, vt, VT_LD);
                } else {
                    const int idx = lb - j * d; if (idx < 0) break;
                    if (j == 0) {
                        const bf16_t* k = p.proj + (size_t)r * WP + 768 + g * 256 + h * 64;
                        DOTM_B(sc, q, k); sc = sc * SCALE - bias; OSM_UPD_B(sc, k + 768);
                    } else {
                        const float* k = cache + (((size_t)li * NS + n) * lb + idx) * 512 + h * 64;
                        DOTM_F(sc, q, k); sc = sc * SCALE - bias; OSM_UPD_F(sc, k + 256);
                    }
                }
            }
        }
        const bf16_t* gm = p.proj + (size_t)r * WP + 2304 + h * 64;
        bf16_t* z = p.z + (size_t)r * 512 + h * 64;
#pragma unroll
        for (int e = 0; e < 64; ++e) z[e] = f2bf(o[e] / den * silu_f(bf2f(gm[e])));
    }
}

__device__ __forceinline__ void nv_cross(const Params& p, int i, int zld, int zoff, int qoff, int goff, int r0, long gtid, long gsz) {
    GS_LOOP(it, (long)(M - r0) * 4) {
        const int r = r0 + it % (M - r0), h = it / (M - r0);
        const bool samp = r >= MP;
        const int n = samp ? r - MP : r / S;
        const bf16_t* qp = p.proj + (size_t)r * WP + qoff + h * 64;
        float o[64]; float mx = -INFINITY, den = 0.f;
#pragma unroll
        for (int e = 0; e < 64; ++e) o[e] = 0.f;
        for (int m = 0; m < NM; ++m) {
            float sc = 0.f;
            if (!samp) {
                const bf16_t* k = p.mkb + ((((size_t)i * NB + n) * 4 + h) * NM + m) * 64;
                const bf16_t* vt = p.mvt + (((size_t)i * NB + n) * 4 + h) * 64 * NM + m;
                DOTM_B(sc, qp, k); sc *= SCALE;
                OSM_UPD_T(sc, vt, NM);
            } else {
                const float* k = p.cache_mem_kv + ((((size_t)i * NS + n) * NM + m) * 2) * 256 + h * 64;
                DOTM_F(sc, qp, k); sc *= SCALE; OSM_UPD_F(sc, k + 256);
            }
        }
        const bf16_t* gx = p.proj + (size_t)r * WP + goff + h * 64;
        bf16_t* z = p.z + (size_t)r * zld + zoff + h * 64;
#pragma unroll
        for (int e = 0; e < 64; ++e) z[e] = f2bf(o[e] / den * silu_f(bf2f(gx[e])));
    }
}

__device__ __forceinline__ void nv_outproj(const Params& p, int i, long gtid, long gsz) {
    const int KO = (i & 1) ? 1024 : 512;
    GS_LOOP(it, (long)M * (D / 8)) {
        const int r = it % M, c0 = (it / M) * 8;
        const bf16_t* a = p.z + (size_t)r * KO;
        const bf16_t* w = p.wt_out + (size_t)i * D * 1024 + (size_t)c0 * KO;
        float v[8];
#pragma unroll
        for (int j = 0; j < 8; ++j) v[j] = 0.f;
        for (int k = 0; k < KO; k += 8) {
            float x[8]; ld8(a + k, x);
#pragma unroll
            for (int j = 0; j < 8; ++j) { float y[8]; ld8(w + (size_t)j * KO + k, y);
#pragma unroll
                for (int q = 0; q < 8; ++q) v[j] += x[q] * y[q]; }
        }
#pragma unroll
        for (int j = 0; j < 8; ++j) p.y[(size_t)r * D + c0 + j] = v[j];
    }
}

__device__ __forceinline__ void nv_finish(const Params& p, int i, long gtid, long gsz) {
    GS_LOOP(r, M) {
        float* x = r < MP ? p.o_y + (size_t)r * D : p.o_ys + (size_t)(r - MP) * D;
        const float* y = p.y + (size_t)r * D;
        float ss = 0.f;
        for (int k = 0; k < D; ++k) ss += y[k] * y[k];
        const float yr = 1.0f / sqrtf(ss / D + RMS_EPS);
        float s2 = 0.f;
        for (int k = 0; k < D; ++k) { const float v = x[k] + y[k] * yr * p.norm_post[i * D + k]; x[k] = v; p.xb[(size_t)r * D + k] = f2bf(v); s2 += v * v; }
        p.rstd[r] = 1.0f / sqrtf(s2 / D + RMS_EPS);
    }
}

__device__ __forceinline__ void nv_cmp1_p(const Params& p, int li, long gtid, long gsz) {
    GS_LOOP(it, (long)2 * NB * 2 * NC_P * 128) {
        const int j = it % 128, c = (it / 128) % NC_P, nk = (it / (128 * NC_P)) % (NB * 2), ty = it / ((long)128 * NC_P * NB * 2);
        const bf16_t* a = (ty == 0 ? +p.kc : +p.vc) + ((size_t)nk * S + 16 * c) * 64;
        const bf16_t* w = p.w1t + ((size_t)(li * 2 + ty) * 128 + j) * 2048;
        const float acc = p.cb[(li * 2 + ty) * 128 + j] + dot_bb(a, w, 2048);
        p.hid[(((size_t)ty * NB * 2 + nk) * CSTR + c) * 128 + j] = silu_f(acc);
    }
}
__device__ __forceinline__ void nv_cmp1_s(const Params& p, int li, long gtid, long gsz) {
    GS_LOOP(it, (long)2 * NS * 2 * NC_S * 128) {
        const int j = it % 128, c = (it / 128) % NC_S, nk = (it / (128 * NC_S)) % (NS * 2), ty = it / ((long)128 * NC_S * NS * 2);
        const int n = nk / 2, kv = nk % 2;
        const bf16_t* w = p.w1t + ((size_t)(li * 2 + ty) * 128 + j) * 2048;
        float acc = p.cb[(li * 2 + ty) * 128 + j];
        for (int l = 0; l < 32; ++l) {
            const int pos = 16 * c + l;
            const int page = p.page_table[n * NPAGES + pos / 128];
            const float* a = p.cache_b_pages + ((((size_t)page * 128 + pos % 128) * 2 + li) * 4 + ty) * 128 + kv * 64;
            for (int e = 0; e < 64; e += 8) { float x[8], y[8]; ld4f(a + e, x); ld4f(a + e + 4, x + 4); ld8(w + l * 64 + e, y);
#pragma unroll
                for (int q = 0; q < 8; ++q) acc += bf2f(f2bf(x[q])) * y[q]; }
        }
        p.hid_s[((((size_t)li * 2 + ty) * NS * 2 + nk) * CSTR + c) * 128 + j] = silu_f(acc);
    }
}
__device__ __forceinline__ void nv_cmp2_p(const Params& p, int li, long gtid, long gsz) {
    GS_LOOP(it, (long)2 * NB * 2 * NC_P * 64) {
        const int e = it % 64, c = (it / 64) % NC_P, nk = (it / (64 * NC_P)) % (NB * 2), ty = it / ((long)64 * NC_P * NB * 2);
        const float* hd = p.hid + (((size_t)ty * NB * 2 + nk) * CSTR + c) * 128;
        const bf16_t* w = p.w2t + ((size_t)(li * 2 + ty) * 64 + e) * 128;
        float acc = 0.f;
        for (int j = 0; j < 128; ++j) acc += bf2f(f2bf(hd[j])) * bf2f(w[j]);
        if (ty == 0) p.kcmp[((size_t)nk * CSTR + c) * 64 + e] = f2bf(acc);
        else p.vcmpt[((size_t)nk * 64 + e) * CSTR + c] = f2bf(acc);
    }
}
__device__ __forceinline__ void nv_cmp2_s(const Params& p, int li, long gtid, long gsz) {
    GS_LOOP(it, (long)2 * NS * 2 * NC_S * 64) {
        const int e = it % 64, c = (it / 64) % NC_S, nk = (it / (64 * NC_S)) % (NS * 2), ty = it / ((long)64 * NC_S * NS * 2);
        const float* hd = p.hid_s + ((((size_t)li * 2 + ty) * NS * 2 + nk) * CSTR + c) * 128;
        const bf16_t* w = p.w2t + ((size_t)(li * 2 + ty) * 64 + e) * 128;
        float acc = 0.f;
        for (int j = 0; j < 128; ++j) acc += bf2f(f2bf(hd[j])) * bf2f(w[j]);
        if (ty == 0) p.kcmp_s[(((size_t)li * NS * 2 + nk) * CSTR + c) * 64 + e] = f2bf(acc);
        else p.vcmpt_s[(((size_t)li * NS * 2 + nk) * 64 + e) * CSTR + c] = f2bf(acc);
    }
}

__device__ __forceinline__ void nv_nsa_cmp(const Params& p, int i, int r0, long gtid, long gsz) {
    const int li = i >> 1;
    GS_LOOP(it, (long)(M - r0) * 12) {
        const int r = r0 + it % (M - r0), hd = it / (M - r0), kv = hd / 6;
        const bool samp = r >= MP;
        const int n = samp ? r - MP : r / S, tq = samp ? PL : r % S;
        const int nc = samp ? NC_S : NC_P;
        const bf16_t* kb = samp ? p.kcmp_s + ((size_t)li * NS * 2 + n * 2 + kv) * CSTR * 64 : p.kcmp + ((size_t)n * 2 + kv) * CSTR * 64;
        const bf16_t* vb = samp ? p.vcmpt_s + ((size_t)li * NS * 2 + n * 2 + kv) * 64 * CSTR : p.vcmpt + ((size_t)n * 2 + kv) * 64 * CSTR;
        float q[64], o[64];
        LD64_B(q, p.proj + (size_t)r * WP + hd * 64);
        const float sl = slope_b(hd);
        float* pc = p.pc + ((size_t)r * 12 + hd) * CSTR;
        float mx = -INFINITY;
        for (int c = 0; c < nc; ++c) {
            const int ce = 16 * c + 31; if (ce > tq) break;
            float sc = 0.f;
            DOT64_B(sc, q, kb + c * 64);
            sc = sc * SCALE - sl * (float)(tq - ce);
            pc[c] = sc; mx = fmaxf(mx, sc);
        }
        float den = 0.f;
        for (int c = 0; c < nc; ++c) { const int ce = 16 * c + 31; if (ce > tq) break; den += expf(pc[c] - mx); }
        den = fmaxf(den, 1e-30f);
#pragma unroll
        for (int e = 0; e < 64; ++e) o[e] = 0.f;
        for (int c = 0; c < CSTR; ++c) {
            const int ce = 16 * c + 31;
            if (c < nc && ce <= tq) {
                const float pe = expf(pc[c] - mx) / den; pc[c] = pe;
#pragma unroll
                for (int e = 0; e < 64; ++e) o[e] += pe * bf2f(vb[(size_t)e * CSTR + c]);
            } else pc[c] = 0.f;
        }
        float* oc = p.oc + ((size_t)r * 12 + hd) * 64;
#pragma unroll
        for (int e = 0; e < 64; ++e) oc[e] = o[e];
    }
}
__device__ __forceinline__ void nv_nsa_imp(const Params& p, int r0, long gtid, long gsz) {
    GS_LOOP(it0, (long)(M - r0) * 2 * IMPSTR) {
        const long it = it0 + (long)r0 * 2 * IMPSTR;
        const int b = it % IMPSTR, kv = (it / IMPSTR) % 2, r = it / (2 * IMPSTR);
        const bool samp = r >= MP;
        const int tq = samp ? PL : r % S, nsel = samp ? NSEL_S : NSEL_P;
        float v = -INFINITY;
        if (b < nsel) {
            float a = 0.f;
            for (int g = 0; g < 6; ++g) {
                const float* pc = p.pc + ((size_t)r * 12 + kv * 6 + g) * CSTR;
                for (int ii = 4 * b; ii < 4 * b + 4; ++ii) {
                    if (ii < CSTR) a += pc[ii];
                    if (ii - 1 >= 0 && ii - 1 < CSTR) a += pc[ii - 1];
                }
            }
            const int cur = tq / 64;
            const bool forced = (b == 0) || (b == cur) || (b == cur - 1);
            v = (b * 64 > tq) ? -INFINITY : (forced ? 1e4f : a);
        }
        p.imp[it] = v;
    }
}
__device__ __forceinline__ void nv_nsa_topk(const Params& p, int r0, long gtid, long gsz) {
    GS_LOOP(it0, (long)(M - r0) * 2 * IMPSTR) {
        const long it = it0 + (long)r0 * 2 * IMPSTR;
        const int b = it % IMPSTR, r = it / (2 * IMPSTR);
        const int nsel = r >= MP ? NSEL_S : NSEL_P;
        const float* im = p.imp + (it - b);
        int sel = 0;
        if (b < nsel) {
            const float v = im[b]; int rank = 0;
            for (int b2 = 0; b2 < nsel; ++b2) { const float w = im[b2]; rank += (w > v || (w == v && b2 < b)) ? 1 : 0; }
            sel = rank < 16 ? 1 : 0;
        }
        p.selb[it] = sel;
    }
}
__device__ __forceinline__ void nv_nsa_main(const Params& p, int i, int r0, long gtid, long gsz) {
    const int li = i >> 1;
    GS_LOOP(it, (long)(M - r0) * 12) {
        const int r = r0 + it % (M - r0), hd = it / (M - r0), kv = hd / 6;
        const bool samp = r >= MP;
        const int n = samp ? r - MP : r / S, tq = samp ? PL : r % S;
        const int nsel = samp ? NSEL_S : NSEL_P;
        const float sl = slope_b(hd);
        const int* selb = p.selb + ((size_t)r * 2 + kv) * IMPSTR;
        float o[64]; float mx = -INFINITY, den = 0.f;
        const bf16_t* q = p.proj + (size_t)r * WP + hd * 64;
#pragma unroll
        for (int e = 0; e < 64; ++e) o[e] = 0.f;
        for (int b = 0; b < nsel; ++b) {
            if (!selb[b]) continue;
            for (int s = 0; s < 64; ++s) {
                const int kp = b * 64 + s; if (kp > tq) break;
                float sc = 0.f; const float bias = sl * (float)(tq - kp);
                if (!samp) {
                    const bf16_t* k = p.proj + (size_t)(n * S + kp) * WP + 768 + 2 * 128 + kv * 64;
                    const bf16_t* vt = p.vts + ((size_t)n * 2 + kv) * 64 * S + vt_pos(kp);
                    DOTM_B(sc, q, k); sc = sc * SCALE - bias; OSM_UPD_T(sc, vt, VT_LD);
                } else if (kp < PL) {
                    const int page = p.page_table[n * NPAGES + kp / 128];
                    const float* k = p.cache_b_pages + ((((size_t)page * 128 + kp % 128) * 2 + li) * 4 + 2) * 128 + kv * 64;
                    DOTM_F(sc, q, k); sc = sc * SCALE - bias; OSM_UPD_F(sc, k + 128);
                } else {
                    const bf16_t* k = p.proj + (size_t)r * WP + 768 + 2 * 128 + kv * 64;
                    DOTM_B(sc, q, k); sc = sc * SCALE - bias; OSM_UPD_B(sc, k + 128);
                }
            }
        }
        const float g0 = sigmoid_f(bf2f(p.proj[(size_t)r * WP + 1536 + hd * 3 + 0]));
        const float g1 = sigmoid_f(bf2f(p.proj[(size_t)r * WP + 1536 + hd * 3 + 1]));
        const float g2 = sigmoid_f(bf2f(p.proj[(size_t)r * WP + 1536 + hd * 3 + 2]));
        float* oc = p.oc + ((size_t)r * 12 + hd) * 64;
        const float inv_s = den > 0.f ? 1.0f / den : 0.f;
#pragma unroll
        for (int e = 0; e < 64; ++e) oc[e] = g0 * oc[e] + g1 * o[e] * inv_s;
        mx = -INFINITY; den = 0.f;
#pragma unroll
        for (int e = 0; e < 64; ++e) o[e] = 0.f;
        for (int dw = 512; dw >= 0; --dw) {
            const int kp = tq - dw; if (kp < 0) continue;
            float sc = 0.f; const float bias = sl * (float)dw;
            if (!samp) {
                const bf16_t* k = p.proj + (size_t)(n * S + kp) * WP + 768 + 4 * 128 + kv * 64;
                const bf16_t* vt = p.vtw + ((size_t)n * 2 + kv) * 64 * S + vt_pos(kp);
                DOTM_B(sc, q, k); sc = sc * SCALE - bias; OSM_UPD_T(sc, vt, VT_LD);
            } else if (dw > 0) {
                const int idx = LBW - dw; if (idx < 0) continue;
                const float* k = p.cache_b_win + ((((size_t)li * NS + n) * LBW + idx) * 2) * 128 + kv * 64;
                DOTM_F(sc, q, k); sc = sc * SCALE - bias; OSM_UPD_F(sc, k + 128);
            } else {
                const bf16_t* k = p.proj + (size_t)r * WP + 768 + 4 * 128 + kv * 64;
                DOTM_B(sc, q, k); sc = sc * SCALE - bias; OSM_UPD_B(sc, k + 128);
            }
        }
        const float inv_w = den > 0.f ? 1.0f / den : 0.f;
        const bf16_t* gm = p.proj + (size_t)r * WP + 1572 + hd * 64;
        bf16_t* z = p.z + (size_t)r * 1024 + hd * 64;
#pragma unroll
        for (int e = 0; e < 64; ++e) z[e] = f2bf((oc[e] + g2 * o[e] * inv_w) * silu_f(bf2f(gm[e])));
    }
}

__device__ __forceinline__ void nv_conv_cache(const Params& p, long gtid, long gsz) {
    GS_LOOP(it, (long)NS * PL * 2 * 32) {
        const int e8 = it % 8, kv = (it / 8) % 2, ty = (it / 16) % 2, li = (it / 32) % 2; const long np = it / 64;
        const int pos = np % PL, n = np / PL;
        const int page = p.page_table[n * NPAGES + pos / 128];
        const float* a = p.cache_b_pages + ((((size_t)page * 128 + pos % 128) * 2 + li) * 4 + ty) * 128 + kv * 64 + e8 * 8;
        float v[8]; ld4f(a, v); ld4f(a + 4, v + 4);
        st8_bf(p.cachec + (((((size_t)li * 2 + ty) * NS + n) * 2 + kv) * PL + pos) * 64 + e8 * 8, v);
    }
}
__device__ __forceinline__ void nv_pq_s(const Params& p, long gtid, long gsz) {
    GS_LOOP(it, (long)4 * NS * 2 * HB_S * 256) {
        const int jj = it % 256; const long row = it / 256; const int lt = row / (NS * 2 * HB_S);
        p.pq_s[it] = f2bf(dot_bb(p.cachec + (size_t)row * 1024, p.w1pq + ((size_t)lt * 256 + jj) * 1024, 1024));
    }
}
__device__ __forceinline__ void nv_pq_p(const Params& p, int li, long gtid, long gsz) {
    GS_LOOP(it, (long)2 * NB * 2 * HB_P * 256) {
        const int jj = it % 256; const long row = it / 256; const int ty = row / (NB * 2 * HB_P); const long rr = row % (NB * 2 * HB_P);
        p.pq_p[it] = f2bf(dot_bb((ty == 0 ? +p.kc : +p.vc) + (size_t)rr * 1024, p.w1pq + ((size_t)(li * 2 + ty) * 256 + jj) * 1024, 1024));
    }
}
__device__ __forceinline__ void cmpc_one(const bf16_t* pq, const float* cb, const bf16_t* w2t, int c, int e, float& out) {
    const bf16_t* w = w2t + (size_t)e * 128;
    float acc = 0.f;
    for (int j = 0; j < 128; ++j) {
        const float pre = bf2f(pq[(size_t)c * 256 + j]) + bf2f(pq[(size_t)(c + 1) * 256 + 128 + j]) + cb[j];
        acc += bf2f(f2bf(silu_f(pre))) * bf2f(w[j]);
    }
    out = acc;
}
__device__ __forceinline__ void nv_cmpc_s(const Params& p, long gtid, long gsz) {
    GS_LOOP(it, (long)4 * NS * 2 * NC_S * 64) {
        const int e = it % 64, c = (it / 64) % NC_S, nk = (it / (64 * NC_S)) % (NS * 2), lt = it / ((long)64 * NC_S * NS * 2);
        const int li = lt >> 1, ty = lt & 1;
        float acc; cmpc_one(p.pq_s + ((size_t)lt * NS * 2 + nk) * HB_S * 256, p.cb + lt * 128, p.w2t + (size_t)lt * 64 * 128, c, e, acc);
        if (ty == 0) p.kcmp_s[(((size_t)li * NS * 2 + nk) * CSTR + c) * 64 + e] = f2bf(acc);
        else p.vcmpt_s[(((size_t)li * NS * 2 + nk) * 64 + e) * CSTR + c] = f2bf(acc);
    }
}
__device__ __forceinline__ void nv_cmpc_p(const Params& p, int li, long gtid, long gsz) {
    GS_LOOP(it, (long)2 * NB * 2 * NC_P * 64) {
        const int e = it % 64, c = (it / 64) % NC_P, nk = (it / (64 * NC_P)) % (NB * 2), ty = it / ((long)64 * NC_P * NB * 2);
        const int lt = li * 2 + ty;
        float acc; cmpc_one(p.pq_p + ((size_t)ty * NB * 2 + nk) * HB_P * 256, p.cb + lt * 128, p.w2t + (size_t)lt * 64 * 128, c, e, acc);
        if (ty == 0) p.kcmp[((size_t)nk * CSTR + c) * 64 + e] = f2bf(acc);
        else p.vcmpt[((size_t)nk * 64 + e) * CSTR + c] = f2bf(acc);
    }
}

#define XB_TMO      128
#define XB_XCNT(j)  (256  + 64 * (j))
#define XB_XSUB(j)  (1280 + 64 * (j))
#define XB_XGEN(j)  (2304 + 64 * (j))
#define XB_TOP      3328
#define XB_TOPGEN   3392
#define XCD_BAR_WORDS 3456
#define XB_SPIN_CAP (1u << 22)
#define LAS __attribute__((address_space(3)))

__device__ __forceinline__ unsigned xb_ld(unsigned* p)              { return __hip_atomic_load(p, __ATOMIC_RELAXED, __HIP_MEMORY_SCOPE_AGENT); }
__device__ __forceinline__ unsigned xb_add(unsigned* p, unsigned v) { return __hip_atomic_fetch_add(p, v, __ATOMIC_RELAXED, __HIP_MEMORY_SCOPE_AGENT); }
__device__ __forceinline__ unsigned xb_xcc_id() { return (unsigned)__builtin_amdgcn_readfirstlane((int)((unsigned)__builtin_amdgcn_s_getreg((3 << 11) | 20) & 0xFu)); }
#define XB_SPIN(cond, bar) do { unsigned _sp = 0; while (cond) { __builtin_amdgcn_s_sleep(1); \
    if ((++_sp & 255u) == 0u) { if (xb_ld(&(bar)[XB_TMO])) break; if (_sp > XB_SPIN_CAP) { atomicAdd(&(bar)[XB_TMO], 1u); break; } } } } while (0)

struct XcdBarrier {
    unsigned* bar; unsigned x;
    volatile LAS unsigned* st;
};

__device__ __forceinline__ XcdBarrier xcd_barrier_post(unsigned* bar, volatile LAS unsigned* st) {
    XcdBarrier b; b.bar = bar; b.x = xb_xcc_id(); b.st = st;
    if (threadIdx.x == 0) (void)xb_add(&bar[XB_XCNT(b.x)], 1u);
    return b;
}
__device__ __forceinline__ void xcd_barrier_complete(unsigned* bar, unsigned x, unsigned& nloc, unsigned& nx) {
    const unsigned G = gridDim.x * gridDim.y * gridDim.z;
    unsigned sum, cnt, mine, sp = 0u;
    for (;;) {
        sum = 0u; cnt = 0u; mine = 0u;
#pragma unroll
        for (unsigned j = 0; j < 16; ++j) { const unsigned c = xb_ld(&bar[XB_XCNT(j)]); sum += c; cnt += (c > 0u) ? 1u : 0u; mine = (j == x) ? c : mine; }
        if (sum == G) break;
        __builtin_amdgcn_s_sleep(1);
        if ((++sp & 255u) == 0u) { if (xb_ld(&bar[XB_TMO])) break; if (sp > XB_SPIN_CAP) { atomicAdd(&bar[XB_TMO], 1u); break; } }
    }
    nloc = mine > 0u ? mine : 1u; nx = cnt > 0u ? cnt : 1u;
}

__device__ __forceinline__ void xcd_barrier(const XcdBarrier& b) {
    asm volatile("s_waitcnt vmcnt(0)" ::: "memory");
    __syncthreads();
    if (threadIdx.x == 0) {
        unsigned* bar = b.bar; asm volatile("" : "+s"(bar)); unsigned bx = b.x; asm volatile("" : "+s"(bx));
        __builtin_amdgcn_s_waitcnt(0);
        unsigned nloc = b.st[0], nx = b.st[1];
        if (nloc == 0u) { xcd_barrier_complete(bar, bx, nloc, nx); b.st[0] = nloc; b.st[1] = nx; }
        const unsigned old = xb_add(&bar[XB_XSUB(bx)], 1u);
        const unsigned gen = old / nloc;
        if (old + 1u == (gen + 1u) * nloc) {
            __builtin_amdgcn_fence(__ATOMIC_RELEASE, "agent");
            asm volatile("s_waitcnt vmcnt(0)" ::: "memory");
            const unsigned og = xb_add(&bar[XB_TOP], 1u);
            const unsigned tg = og / nx;
            if (og + 1u == (tg + 1u) * nx) xb_add(&bar[XB_TOPGEN], 1u);
            else XB_SPIN(xb_ld(&bar[XB_TOPGEN]) == tg, bar);
            __builtin_amdgcn_fence(__ATOMIC_ACQUIRE, "agent");
            xb_add(&bar[XB_XGEN(bx)], 1u);
            asm volatile("s_waitcnt vmcnt(0)" ::: "memory");
        } else {
            XB_SPIN(xb_ld(&bar[XB_XGEN(bx)]) == gen, bar);
            __builtin_amdgcn_fence(__ATOMIC_ACQUIRE, "agent");
            asm volatile("s_waitcnt vmcnt(0)" ::: "memory");
        }
    }
    __syncthreads();
}


namespace pg8 {
#define PG8_LAS __attribute__((address_space(3)))
typedef unsigned short bf16_t;
typedef short bf16x8 __attribute__((ext_vector_type(8)));
typedef float f32x4 __attribute__((ext_vector_type(4)));
typedef unsigned u32x4 __attribute__((ext_vector_type(4)));
constexpr int BM = 256, BK = 64, HALF = 128, HTB = HALF * BK * 2  , STAGE_BYTES = 8 * HTB, NXCD = 8, WGM = 8;

__host__ __device__ __forceinline__ int lds_byte(int r, int c) { const int st = (r >> 4) * 2 + (c >> 5), rr = r & 15, cc = c & 31, ob = rr * 64 + cc * 2; return st * 1024 + (ob ^ (((ob >> 9) & 1) << 5)); }
__host__ __device__ __forceinline__ void stage_rc(int b, int& R, int& C) { const int st = b / 1024, sb = b % 1024, swz = sb ^ (((sb >> 9) & 1) << 5); R = (st >> 1) * 16 + swz / 64; C = (st & 1) * 32 + (swz % 64) / 2; }
__host__ __device__ __forceinline__ int perm32(int rho) { const int n = rho >> 4, i = rho & 15; return 8 * (i >> 2) + 4 * n + (i & 3); }

struct Unit { int pm, pn; };
struct Gemm { const bf16_t* A; const bf16_t* Bt; int M, N, K; };

struct StaticOrder {
    int nM, nN, nwg, G, c;
    __host__ __device__ void init(int M, int N, int G_, int c_) { nM = M / BM; nN = N / BM; nwg = nM * nN; G = G_; c = c_; }
    __host__ __device__ bool next(int i, Unit& u) const {
        const long L = (long)i * G + c; if (L >= nwg) return false;
        int wgid = (int)L; { const int q = nwg / NXCD, r = nwg % NXCD, xcd = wgid % NXCD, off = wgid / NXCD; wgid = (xcd < r ? xcd * (q + 1) : r * (q + 1) + (xcd - r) * q) + off; }
        const int nig = WGM * nN, gid = wgid / nig, fm = gid * WGM, gsz = (nM - fm) < WGM ? (nM - fm) : WGM;
        u.pm = fm + ((wgid % nig) % gsz); u.pn = (wgid % nig) / gsz; return true;
    }
    __device__ __forceinline__ void a_ready(const Unit&) const {}
    __device__ __forceinline__ void done(const Unit&) const {}
};
struct CountedOrder : StaticOrder {
    const unsigned* ready; unsigned need; unsigned* tmo;
    __device__ __forceinline__ void a_ready(const Unit& u) const {
        if (threadIdx.x < 64) {
            const unsigned long long t0 = __builtin_amdgcn_s_memrealtime(); unsigned polls = 0;
            while ((unsigned)__builtin_amdgcn_readfirstlane(__hip_atomic_load(ready + 64 * u.pm, __ATOMIC_RELAXED, __HIP_MEMORY_SCOPE_AGENT)) < need) {
                if ((++polls & 255u) == 0u && __builtin_amdgcn_readfirstlane(__hip_atomic_load(tmo, __ATOMIC_RELAXED, __HIP_MEMORY_SCOPE_AGENT)) != 0u) break;
                if (__builtin_amdgcn_s_memrealtime() - t0 > 2000000ull) {
                    if (threadIdx.x == 0) { unsigned expect = 0u; __hip_atomic_compare_exchange_strong(tmo + 1, &expect, 0x600u | (unsigned)(u.pm & 0xff), __ATOMIC_RELAXED, __ATOMIC_RELAXED, __HIP_MEMORY_SCOPE_AGENT); __hip_atomic_store(tmo, 1u, __ATOMIC_RELAXED, __HIP_MEMORY_SCOPE_AGENT); }
                    break; }
                __builtin_amdgcn_s_sleep(2); }
            __builtin_amdgcn_fence(__ATOMIC_ACQUIRE, "agent");
            asm volatile("s_waitcnt vmcnt(0)" ::: "memory");
        }
#if !defined(BROKEN_HOOK_NO_BARRIER)
        asm volatile("" ::: "memory"); __builtin_amdgcn_s_barrier(); asm volatile("" ::: "memory");
#endif
    }
};

__device__ __forceinline__ unsigned cvt_pk_bf16(float lo, float hi) { unsigned r; asm volatile("v_cvt_pk_bf16_f32 %0, %1, %2" : "=v"(r) : "v"(lo), "v"(hi)); return r; }
typedef float f32x2 __attribute__((ext_vector_type(2)));
__device__ __forceinline__ f32x2 gelu_pk(f32x2 v) {
    const f32x2 av = __builtin_elementwise_abs(v), d = av * 0.2316418882f + 1.0f;
    f32x2 t; t.x = __builtin_amdgcn_rcpf(d.x); t.y = __builtin_amdgcn_rcpf(d.y);
    f32x2 q = t * 0.5307027145f + (-0.7265760135f); q = q * t + 0.7107068705f; q = q * t + (-0.142248368f); q = q * t + 0.127414796f; q = q * t;
    const f32x2 s = (v * v) * (-0.72134752044f);
    f32x2 e; e.x = __builtin_amdgcn_exp2f(s.x); e.y = __builtin_amdgcn_exp2f(s.y);
    const f32x2 m = v * (q * e), r = v - m;
    f32x2 o; o.x = v.x < 0.f ? m.x : r.x; o.y = v.y < 0.f ? m.y : r.y; return o;
}

struct EpiF32 {
    static constexpr bool PERM = false, AFTER_DRAIN = false;
    float* C; int ldc; const float* bias;
    __device__ __forceinline__ void operator()(const f32x4 (&acc)[2][2][4][2], const Unit& u, int wr, int wc, int fr, int fq) const {
        const int row0 = u.pm * BM + wr * 64 + fr, col0 = u.pn * BM + wc * 32 + 4 * fq;
        f32x4 bv[2][2];
#pragma unroll
        for (int bj = 0; bj < 2; ++bj)
#pragma unroll
            for (int n = 0; n < 2; ++n) bv[bj][n] = bias ? *(const f32x4*)(bias + col0 + bj * HALF + n * 16) : (f32x4){0.f, 0.f, 0.f, 0.f};
#pragma unroll
        for (int ai = 0; ai < 2; ++ai)
#pragma unroll
            for (int m = 0; m < 4; ++m) { float* rowp = C + (size_t)(row0 + ai * HALF + m * 16) * ldc + col0;
#pragma unroll
                for (int bj = 0; bj < 2; ++bj)
#pragma unroll
                    for (int n = 0; n < 2; ++n) *(f32x4*)(rowp + bj * HALF + n * 16) = acc[ai][bj][m][n] + bv[bj][n]; }
    }
};
template <int ACT  > struct EpiBf16 {
    static constexpr bool PERM = true, AFTER_DRAIN = false;
    bf16_t* O; int ldc; const float* bias; int split_cols; size_t split_stride;
    __device__ __forceinline__ void operator()(const f32x4 (&acc)[2][2][4][2], const Unit& u, int wr, int wc, int fr, int fq) const {
        const int row0 = u.pm * BM + wr * 64 + fr; int colt = u.pn * BM; bf16_t* base = O;
        if (split_cols) { const int t = colt / split_cols; base += (size_t)t * split_stride; colt -= t * split_cols; }
        const int col0 = colt + wc * 32 + 8 * fq, bcol0 = u.pn * BM + wc * 32 + 8 * fq;
        f32x4 bv[2][2];
#pragma unroll
        for (int bj = 0; bj < 2; ++bj)
#pragma unroll
            for (int n = 0; n < 2; ++n) bv[bj][n] = bias ? *(const f32x4*)(bias + bcol0 + bj * HALF + 4 * n) : (f32x4){0.f, 0.f, 0.f, 0.f};
#pragma unroll
        for (int ai = 0; ai < 2; ++ai)
#pragma unroll
            for (int m = 0; m < 4; ++m) { bf16_t* rowp = base + (size_t)(row0 + ai * HALF + m * 16) * ldc + col0;
#pragma unroll
                for (int bj = 0; bj < 2; ++bj) { f32x4 v0 = acc[ai][bj][m][0] + bv[bj][0], v1 = acc[ai][bj][m][1] + bv[bj][1];
                    if (ACT == 1) { f32x2 a = gelu_pk((f32x2){v0[0], v0[1]}), b = gelu_pk((f32x2){v0[2], v0[3]}), c = gelu_pk((f32x2){v1[0], v1[1]}), d = gelu_pk((f32x2){v1[2], v1[3]});
                        v0 = (f32x4){a.x, a.y, b.x, b.y}; v1 = (f32x4){c.x, c.y, d.x, d.y}; }
                    if (ACT == 2) {
#pragma unroll
                        for (int j = 0; j < 4; ++j) { v0[j] = 0.5f * v0[j] * (1.0f + erff(v0[j] * 0.70710678f)); v1[j] = 0.5f * v1[j] * (1.0f + erff(v1[j] * 0.70710678f)); } }
                    u32x4 w; w.x = cvt_pk_bf16(v0[0], v0[1]); w.y = cvt_pk_bf16(v0[2], v0[3]); w.z = cvt_pk_bf16(v1[0], v1[1]); w.w = cvt_pk_bf16(v1[2], v1[3]);
                    *(u32x4*)(rowp + bj * HALF) = w; } }
    }
};

struct PanelStats {
    unsigned* xbuf;
    unsigned* cnt;
    unsigned* tmo;
    int ntn; float eps;
    unsigned code;
    __device__ __forceinline__ bool run(const f32x4 (&v)[2][2][4][2], const Unit& u, int wr, int wc, int fr, int fq, PG8_LAS unsigned char* lds, int wid, int lane) const {
        typedef float f32x2v __attribute__((ext_vector_type(2)));
        PG8_LAS f32x2v* P = (PG8_LAS f32x2v*)lds;
        PG8_LAS f32x2v* S = (PG8_LAS f32x2v*)(lds + 8192);
        PG8_LAS unsigned* flag = (PG8_LAS unsigned*)(lds + 8192 + 2048);
#pragma unroll
        for (int ai = 0; ai < 2; ++ai)
#pragma unroll
            for (int m = 0; m < 4; ++m) {
                float s = 0.f;
#pragma unroll
                for (int bj = 0; bj < 2; ++bj)
#pragma unroll
                    for (int n = 0; n < 2; ++n) { const f32x4 x = v[ai][bj][m][n]; s += (x[0] + x[1]) + (x[2] + x[3]); }
                s += __shfl_xor(s, 16); s += __shfl_xor(s, 32);
                const float mw = s * (1.0f / 64.0f); float q = 0.f;
#pragma unroll
                for (int bj = 0; bj < 2; ++bj)
#pragma unroll
                    for (int n = 0; n < 2; ++n) { const f32x4 d = v[ai][bj][m][n] - mw; q += (d[0] * d[0] + d[1] * d[1]) + (d[2] * d[2] + d[3] * d[3]); }
                q += __shfl_xor(q, 16); q += __shfl_xor(q, 32);
                if (fq == 0) P[(ai * HALF + wr * 64 + m * 16 + fr) * 4 + wc] = (f32x2v){mw, q};
            }
        asm volatile("s_waitcnt lgkmcnt(0)" ::: "memory"); __builtin_amdgcn_s_barrier(); asm volatile("" ::: "memory");
#if defined(BROKEN_NO_WAIT)
        if (blockIdx.x >= 64) { const long long t0 = clock64(); while (clock64() - t0 < 60000) __builtin_amdgcn_s_sleep(8); }
#endif
        const int row = wid * 32 + (lane & 31);
        if (lane < 32) {
            const f32x2v a = P[row * 4 + 0], b = P[row * 4 + 1], c = P[row * 4 + 2], d = P[row * 4 + 3];
            const float mt = (a.x + b.x + c.x + d.x) * 0.25f;
            const float da = a.x - mt, db = b.x - mt, dc = c.x - mt, dd = d.x - mt;
            const float m2 = (a.y + b.y) + (c.y + d.y) + 64.0f * ((da * da + db * db) + (dc * dc + dd * dd));
            unsigned long long* slot = (unsigned long long*)xbuf + ((size_t)(u.pm * BM + row) * 4 + u.pn);
            __hip_atomic_store(slot, ((unsigned long long)__float_as_uint(m2) << 32) | __float_as_uint(mt), __ATOMIC_RELAXED, __HIP_MEMORY_SCOPE_AGENT);
        }
        asm volatile("s_waitcnt vmcnt(0)" ::: "memory");
        if (lane == 0) __hip_atomic_fetch_add(cnt + 64 * u.pm, 1u, __ATOMIC_RELAXED, __HIP_MEMORY_SCOPE_AGENT);
        if (wid == 0) {
            bool dead = false; const unsigned long long t0 = __builtin_amdgcn_s_memrealtime(); const unsigned want = 8u * (unsigned)ntn;
            for (;;) {
#if defined(BROKEN_NO_WAIT)
                break;
#endif
                if ((unsigned)__builtin_amdgcn_readfirstlane(__hip_atomic_load(cnt + 64 * u.pm, __ATOMIC_RELAXED, __HIP_MEMORY_SCOPE_AGENT)) >= want) break;
                if (__builtin_amdgcn_s_memrealtime() - t0 > 2000000ull) {
                    if (lane == 0) { unsigned expect = 0u; __hip_atomic_compare_exchange_strong(tmo + 1, &expect, code | (unsigned)(u.pm & 0xff), __ATOMIC_RELAXED, __ATOMIC_RELAXED, __HIP_MEMORY_SCOPE_AGENT);
                                     __hip_atomic_store(tmo, 1u, __ATOMIC_RELAXED, __HIP_MEMORY_SCOPE_AGENT); }
                    dead = true; break; }
                __builtin_amdgcn_s_sleep(2);
            }
            __builtin_amdgcn_fence(__ATOMIC_ACQUIRE, "agent");
            if (lane == 0) flag[0] = dead ? 1u : 0u;
        }
        asm volatile("s_waitcnt vmcnt(0) lgkmcnt(0)" ::: "memory"); __builtin_amdgcn_s_barrier(); asm volatile("" ::: "memory");
        const bool bad = flag[0] != 0u;
        if (lane < 32) {
            const unsigned long long* slot = (const unsigned long long*)xbuf + (size_t)(u.pm * BM + row) * 4; float mt[4], m2[4]; float ms = 0.f;
#pragma unroll
            for (int t = 0; t < 4; ++t) { if (t < ntn) { const unsigned long long w = __hip_atomic_load(slot + t, __ATOMIC_RELAXED, __HIP_MEMORY_SCOPE_AGENT); mt[t] = __uint_as_float((unsigned)w); m2[t] = __uint_as_float((unsigned)(w >> 32)); } else { mt[t] = 0.f; m2[t] = 0.f; } ms += mt[t]; }
            const float mean = ms / (float)ntn; float q = 0.f;
#pragma unroll
            for (int t = 0; t < 4; ++t) if (t < ntn) { const float dm = mt[t] - mean; q += m2[t] + 256.0f * dm * dm; }
            S[row] = (f32x2v){mean, 1.0f / sqrtf(q / (256.0f * (float)ntn) + eps)};
        }
        asm volatile("s_waitcnt lgkmcnt(0)" ::: "memory"); __builtin_amdgcn_s_barrier(); asm volatile("" ::: "memory");
        return bad;
    }
};
struct EpiLnRes {
    static constexpr bool PERM = false, AFTER_DRAIN = true;
    const float* base; float* out; int ldc; const float* bias; PanelStats st; unsigned poison;
    __device__ __forceinline__ void refuse(size_t i0, size_t stride, int M, int N) const { const float q = __builtin_nanf(""); for (size_t i = i0; i < (size_t)M * N; i += stride) out[(i / N) * ldc + i % N] = q;
        if (i0 == 0) { unsigned expect = 0u; __hip_atomic_compare_exchange_strong(st.tmo + 1, &expect, 0x7f0u, __ATOMIC_RELAXED, __ATOMIC_RELAXED, __HIP_MEMORY_SCOPE_AGENT); __hip_atomic_store(st.tmo, 1u, __ATOMIC_RELAXED, __HIP_MEMORY_SCOPE_AGENT); } }
    __device__ __forceinline__ void fused(f32x4 (&acc)[2][2][4][2], const Unit& u, int wr, int wc, int fr, int fq, PG8_LAS unsigned char* lds, int wid, int lane) const {
        typedef float f32x2v __attribute__((ext_vector_type(2)));
        const PG8_LAS f32x2v* S = (const PG8_LAS f32x2v*)(lds + 8192);
        const int col0 = u.pn * BM + wc * 32 + 4 * fq;
#pragma unroll
        for (int bj = 0; bj < 2; ++bj)
#pragma unroll
            for (int n = 0; n < 2; ++n) { const f32x4 bv = bias ? *(const f32x4*)(bias + col0 + bj * HALF + n * 16) : (f32x4){0.f, 0.f, 0.f, 0.f};
#pragma unroll
                for (int ai = 0; ai < 2; ++ai)
#pragma unroll
                    for (int m = 0; m < 4; ++m) acc[ai][bj][m][n] += bv; }
        const bool bad = st.run(acc, u, wr, wc, fr, fq, lds, wid, lane) || poison != 0u;
        const float qnan = __builtin_nanf("");
#pragma unroll
        for (int ai = 0; ai < 2; ++ai)
#pragma unroll
            for (int m = 0; m < 4; ++m) { const int r = ai * HALF + wr * 64 + m * 16 + fr; const f32x2v sr = S[r]; const size_t off = (size_t)(u.pm * BM + r) * ldc + col0;
#pragma unroll
                for (int bj = 0; bj < 2; ++bj)
#pragma unroll
                    for (int n = 0; n < 2; ++n) { const f32x4 bs = *(const f32x4*)(base + off + bj * HALF + n * 16); f32x4 o = bs + (acc[ai][bj][m][n] - sr.x) * sr.y;
                        if (bad) o = (f32x4){qnan, qnan, qnan, qnan}; *(f32x4*)(out + off + bj * HALF + n * 16) = o; }
                asm volatile("" ::: "memory"); }
    }
};
struct EpiLnResLn {
    static constexpr bool PERM = false, AFTER_DRAIN = true;
    const float* base; float* out; bf16_t* xn; int ldc; const float* bias; PanelStats st1, st2; unsigned poison;
    __device__ __forceinline__ void refuse(size_t i0, size_t stride, int M, int N) const { const float q = __builtin_nanf(""); for (size_t i = i0; i < (size_t)M * N; i += stride) { const size_t o = (i / N) * ldc + i % N; out[o] = q; xn[o] = (bf16_t)0x7fc0u; }
        if (i0 == 0) { unsigned expect = 0u; __hip_atomic_compare_exchange_strong(st1.tmo + 1, &expect, 0x7f0u, __ATOMIC_RELAXED, __ATOMIC_RELAXED, __HIP_MEMORY_SCOPE_AGENT); __hip_atomic_store(st1.tmo, 1u, __ATOMIC_RELAXED, __HIP_MEMORY_SCOPE_AGENT); } }
    __device__ __forceinline__ void fused(f32x4 (&acc)[2][2][4][2], const Unit& u, int wr, int wc, int fr, int fq, PG8_LAS unsigned char* lds, int wid, int lane) const {
        typedef float f32x2v __attribute__((ext_vector_type(2))); typedef unsigned u32x2v __attribute__((ext_vector_type(2)));
        const PG8_LAS f32x2v* S = (const PG8_LAS f32x2v*)(lds + 8192);
        const int col0 = u.pn * BM + wc * 32 + 4 * fq;
#pragma unroll
        for (int bj = 0; bj < 2; ++bj)
#pragma unroll
            for (int n = 0; n < 2; ++n) { const f32x4 bv = bias ? *(const f32x4*)(bias + col0 + bj * HALF + n * 16) : (f32x4){0.f, 0.f, 0.f, 0.f};
#pragma unroll
                for (int ai = 0; ai < 2; ++ai)
#pragma unroll
                    for (int m = 0; m < 4; ++m) acc[ai][bj][m][n] += bv; }
        bool bad = st1.run(acc, u, wr, wc, fr, fq, lds, wid, lane) || poison != 0u;
        const float qnan = __builtin_nanf("");
#pragma unroll
        for (int ai = 0; ai < 2; ++ai)
#pragma unroll
            for (int m = 0; m < 4; ++m) { const int r = ai * HALF + wr * 64 + m * 16 + fr; const f32x2v sr = S[r]; const size_t off = (size_t)(u.pm * BM + r) * ldc + col0;
#pragma unroll
                for (int bj = 0; bj < 2; ++bj)
#pragma unroll
                    for (int n = 0; n < 2; ++n) { const f32x4 bs = *(const f32x4*)(base + off + bj * HALF + n * 16); acc[ai][bj][m][n] = bs + (acc[ai][bj][m][n] - sr.x) * sr.y; }
                asm volatile("" : "+v"(acc[ai][0][m][0]), "+v"(acc[ai][0][m][1]), "+v"(acc[ai][1][m][0]), "+v"(acc[ai][1][m][1]));
                if (m & 1) asm volatile("" ::: "memory"); }
        const bool bad1 = bad;
        bad = st2.run(acc, u, wr, wc, fr, fq, lds, wid, lane) || bad;
#pragma unroll
        for (int ai = 0; ai < 2; ++ai)
#pragma unroll
            for (int m = 0; m < 4; ++m) { const int r = ai * HALF + wr * 64 + m * 16 + fr; const f32x2v sr = S[r]; const size_t off = (size_t)(u.pm * BM + r) * ldc + col0;
#pragma unroll
                for (int bj = 0; bj < 2; ++bj)
#pragma unroll
                    for (int n = 0; n < 2; ++n) { const f32x4 x1 = acc[ai][bj][m][n]; *(f32x4*)(out + off + bj * HALF + n * 16) = bad1 ? (f32x4){qnan, qnan, qnan, qnan} : x1;
                        const f32x4 o = (x1 - sr.x) * sr.y; u32x2v w; w.x = cvt_pk_bf16(o[0], o[1]); w.y = cvt_pk_bf16(o[2], o[3]);
                        if (bad) { w.x = 0x7fc07fc0u; w.y = 0x7fc07fc0u; } *(u32x2v*)(xn + off + bj * HALF + n * 16) = w; }
                asm volatile("" ::: "memory"); }
    }
};

template <class Epi, class Sched, bool STAMP = false>
__device__ __forceinline__ void gemm_phase(PG8_LAS unsigned char* lds, const Gemm g, const Sched& S, const Epi& E, unsigned long long* stamps) {
    int tid_l = threadIdx.x; asm volatile("" : "+v"(tid_l));
    const int tid = tid_l, wid = __builtin_amdgcn_readfirstlane(tid >> 6), lane = tid & 63, wr = wid >> 2, wc = wid & 3, fr = lane & 15, fq = lane >> 4;
    const int K = g.K, nt = K / BK;
    int ts_lo = 0, ts_hi = 0, nts = 0; const unsigned long long rt_entry = STAMP ? (unsigned long long)wall_clock64() : 0ull;
#define PG8_STAMP() do { if (STAMP && wid == 0 && nts < 64) { const unsigned long long _c = (unsigned long long)clock64(); \
        ts_lo = (lane == nts) ? (int)(unsigned)_c : ts_lo; ts_hi = (lane == nts) ? (int)(unsigned)(_c >> 32) : ts_hi; ++nts; } } while (0)
    PG8_STAMP();
    unsigned voffA[2], voffB[2];
#pragma unroll
    for (int i = 0; i < 2; ++i) { int R, C; stage_rc(tid * 16 + i * 8192, R, C); const int Rb = Epi::PERM ? ((R & ~31) + perm32(R & 31)) : R;
        voffA[i] = (unsigned)(R * K + C) * 2u; voffB[i] = (unsigned)(Rb * K + C) * 2u; }
    const size_t kstep = (size_t)(BK * 2);
    const size_t hstep = (size_t)HALF * K * 2;
    const size_t tstep = 2 * hstep;
    const unsigned ldsw = (unsigned)wid * 1024u;
    const int aoff = lds_byte(wr * 64 + fr, fq * 8), boff = lds_byte(wc * 32 + fr, fq * 8);
#define PG8_SA(b, h) (((b) * 2 + (h)) * HTB)
#define PG8_SB(b, h) ((4 + (b) * 2 + (h)) * HTB)
#define PG8_STAGE(bufoff, gbase, voff) do { _Pragma("unroll") for (int _i = 0; _i < 2; ++_i) \
        __builtin_amdgcn_global_load_lds((const unsigned*)((const char*)(gbase) + (voff)[_i]), (PG8_LAS unsigned*)(lds + (bufoff) + ldsw + _i * 8192), 16, 0, 0); } while (0)
#define PG8_LDA(dst, b, h) do { _Pragma("unroll") for (int m = 0; m < 4; ++m) _Pragma("unroll") for (int k = 0; k < 2; ++k) dst[m][k] = *(const PG8_LAS bf16x8*)(lds + PG8_SA(b, h) + aoff + m * 2048 + k * 1024); } while (0)
#define PG8_LDB(dst, b, h) do { _Pragma("unroll") for (int n = 0; n < 2; ++n) _Pragma("unroll") for (int k = 0; k < 2; ++k) dst[n][k] = *(const PG8_LAS bf16x8*)(lds + PG8_SB(b, h) + boff + n * 2048 + k * 1024); } while (0)
#define PG8_MMA(ai, bj, At, Bt) do { __builtin_amdgcn_s_setprio(1); _Pragma("unroll") for (int m = 0; m < 4; ++m) _Pragma("unroll") for (int n = 0; n < 2; ++n) _Pragma("unroll") for (int k = 0; k < 2; ++k) \
        acc[ai][bj][m][n] = __builtin_amdgcn_mfma_f32_16x16x32_bf16(Bt[n][k], At[m][k], acc[ai][bj][m][n], 0, 0, 0); __builtin_amdgcn_s_setprio(0); } while (0)
#define PG8_WAIT_V(n) asm volatile("s_waitcnt vmcnt(" #n ")" ::: "memory")
#define PG8_WAIT_L(n) asm volatile("s_waitcnt lgkmcnt(" #n ")" ::: "memory")
#define PG8_BAR __builtin_amdgcn_s_barrier()
#define PG8_SCHED __builtin_amdgcn_sched_barrier(0)
    Unit cur, nxt; int ui = 0;
    if (!S.next(0, cur)) return;
    f32x4 acc[2][2][4][2];
#pragma unroll
    for (int a = 0; a < 2; ++a)
#pragma unroll
        for (int b = 0; b < 2; ++b)
#pragma unroll
            for (int m = 0; m < 4; ++m)
#pragma unroll
                for (int n = 0; n < 2; ++n) acc[a][b][m][n] = (f32x4){0.f, 0.f, 0.f, 0.f};
    bf16x8 At[4][2], B0[2][2], B1[2][2];
    const char* cA = (const char*)g.A + (size_t)cur.pm * tstep; const char* cB = (const char*)g.Bt + (size_t)cur.pn * tstep;
    S.a_ready(cur);
    PG8_STAGE(PG8_SB(0, 0), cB, voffB); PG8_STAGE(PG8_SA(0, 0), cA, voffA); PG8_STAGE(PG8_SB(0, 1), cB + hstep, voffB); PG8_STAGE(PG8_SA(0, 1), cA + hstep, voffA);
    if (wr == 1) PG8_BAR;
    PG8_WAIT_V(4); PG8_BAR;
    PG8_STAGE(PG8_SB(1, 0), cB + kstep, voffB); PG8_STAGE(PG8_SA(1, 0), cA + kstep, voffA); PG8_STAGE(PG8_SB(1, 1), cB + hstep + kstep, voffB);
    PG8_WAIT_V(6); PG8_BAR;
    PG8_STAMP();
    for (;;) {
        const bool has_next = S.next(ui + 1, nxt);
        const char* nA = has_next ? (const char*)g.A + (size_t)nxt.pm * tstep : cA; const char* nB = has_next ? (const char*)g.Bt + (size_t)nxt.pn * tstep : cB;
        for (int t = 0; t < nt; t += 2) {
            const bool last = (t == nt - 2);
            const char* a1 = cA + (size_t)(t + 1) * kstep;
            const char* a2 = last ? nA : cA + (size_t)(t + 2) * kstep; const char* b2 = last ? nB : cB + (size_t)(t + 2) * kstep;
            const char* a3 = a2 + kstep; const char* b3 = b2 + kstep;
            if (last && has_next) S.a_ready(nxt);
            PG8_LDB(B0, 0, 0); PG8_SCHED; PG8_LDA(At, 0, 0); PG8_STAGE(PG8_SA(1, 1), a1 + hstep, voffA);
            PG8_WAIT_L(8); PG8_BAR; PG8_WAIT_L(0); PG8_MMA(0, 0, At, B0); PG8_BAR; PG8_SCHED;
            PG8_LDB(B1, 0, 1); PG8_STAGE(PG8_SB(0, 0), b2, voffB);
            PG8_BAR; PG8_WAIT_L(0); PG8_MMA(0, 1, At, B1); PG8_BAR;
            PG8_LDA(At, 0, 1); PG8_STAGE(PG8_SA(0, 0), a2, voffA);
            PG8_BAR; PG8_WAIT_L(0); PG8_MMA(1, 0, At, B0); PG8_BAR; PG8_SCHED;
            PG8_STAGE(PG8_SB(0, 1), b2 + hstep, voffB);
            PG8_WAIT_V(6); PG8_BAR; PG8_MMA(1, 1, At, B1); PG8_BAR;
            PG8_LDB(B0, 1, 0); PG8_SCHED; PG8_LDA(At, 1, 0); PG8_STAGE(PG8_SA(0, 1), a2 + hstep, voffA);
            PG8_WAIT_L(8); PG8_BAR; PG8_WAIT_L(0); PG8_MMA(0, 0, At, B0); PG8_BAR; PG8_SCHED;
            PG8_LDB(B1, 1, 1); PG8_STAGE(PG8_SB(1, 0), b3, voffB);
            PG8_BAR; PG8_WAIT_L(0); PG8_MMA(0, 1, At, B1); PG8_BAR;
            PG8_LDA(At, 1, 1); PG8_STAGE(PG8_SA(1, 0), a3, voffA);
            PG8_BAR; PG8_WAIT_L(0); PG8_MMA(1, 0, At, B0); PG8_BAR; PG8_SCHED;
            PG8_STAGE(PG8_SB(1, 1), b3 + hstep, voffB);
            PG8_WAIT_V(6); PG8_BAR; PG8_MMA(1, 1, At, B1); PG8_BAR;
        }
        PG8_STAMP();
        if constexpr (!Epi::AFTER_DRAIN) { E(acc, cur, wr, wc, fr, fq); S.done(cur); }
        PG8_STAMP();
        if (!has_next) break;
#pragma unroll
        for (int a = 0; a < 2; ++a)
#pragma unroll
            for (int b = 0; b < 2; ++b)
#pragma unroll
                for (int m = 0; m < 4; ++m)
#pragma unroll
                    for (int n = 0; n < 2; ++n) acc[a][b][m][n] = (f32x4){0.f, 0.f, 0.f, 0.f};
        cur = nxt; cA = nA; cB = nB; ++ui;
    }
    PG8_WAIT_V(0);
    if (wr == 0) PG8_BAR;
    PG8_BAR;
    if constexpr (Epi::AFTER_DRAIN) { E.fused(acc, cur, wr, wc, fr, fq, lds, wid, lane); S.done(cur); }
    PG8_STAMP();
    if (STAMP && wid == 0) { stamps[lane] = lane < nts ? (((unsigned long long)(unsigned)ts_hi << 32) | (unsigned)ts_lo) : 0ull;
        if (lane == 62) stamps[62] = rt_entry; if (lane == 63) stamps[63] = (unsigned long long)wall_clock64(); }
#undef PG8_STAMP
#undef PG8_SA
#undef PG8_SB
#undef PG8_STAGE
#undef PG8_LDA
#undef PG8_LDB
#undef PG8_MMA
#undef PG8_WAIT_V
#undef PG8_WAIT_L
#undef PG8_BAR
#undef PG8_SCHED
}
}

struct WsAlloc {
    char* base; size_t off;
    template <class T> T* get(size_t n) { T* r = (T*)(base + off); off += (n * sizeof(T) + 255) & ~(size_t)255; return r; }
};

static void fill_params(Params& p, void* const* d_in, void* d_out, void* d_ws) {
    memset(&p, 0, sizeof(p));
    p.x_prompt = (const float*)d_in[0]; p.x_sample = (const float*)d_in[1]; p.cache_mem_kv = (const float*)d_in[2];
    p.cache_a0 = (const float*)d_in[3]; p.cache_a1 = (const float*)d_in[4]; p.cache_a2 = (const float*)d_in[5];
    p.cache_b_pages = (const float*)d_in[6]; p.cache_b_win = (const float*)d_in[7]; p.page_table = (const int*)d_in[8];
    p.mem_prompt = (const float*)d_in[9]; p.norm_pre = (const float*)d_in[10]; p.norm_post = (const float*)d_in[11]; p.norm_mem = (const float*)d_in[12];
    p.w_mem_kv = (const float*)d_in[13]; p.w_in_a = (const float*)d_in[14]; p.w_out_a = (const float*)d_in[15]; p.w_in_b = (const float*)d_in[16];
    p.w_out_b = (const float*)d_in[17]; p.cmp_pos = (const float*)d_in[18]; p.cmp_w1 = (const float*)d_in[19]; p.cmp_w2 = (const float*)d_in[20];
    const size_t osz[13] = {(size_t)NB * S * D, (size_t)NS * D, (size_t)4 * NB * NM * 512, (size_t)2 * NB * WROWS0 * 512, (size_t)2 * NB * WROWS1 * 512, (size_t)2 * NB * WROWS2 * 512,
                            (size_t)NB * S * 1024, (size_t)2 * NB * WROWS1 * 256, (size_t)2 * NS * 512, (size_t)2 * NS * 512, (size_t)2 * NS * 512, (size_t)NS * 1024, (size_t)2 * NS * 256};
    float* o = (float*)d_out; float* outs[13];
    for (int i = 0; i < 13; ++i) { outs[i] = o; o += osz[i]; }
    p.o_y = outs[0]; p.o_ys = outs[1]; p.o_mem = outs[2]; p.o_pa0 = outs[3]; p.o_pa1 = outs[4]; p.o_pa2 = outs[5]; p.o_pb = outs[6]; p.o_pbw = outs[7];
    p.o_sa0 = outs[8]; p.o_sa1 = outs[9]; p.o_sa2 = outs[10]; p.o_sb = outs[11]; p.o_sbw = outs[12];
    WsAlloc a{(char*)d_ws, 0};
    p.bar = a.get<unsigned>(4096);
    p.wt_in = a.get<bf16_t>((size_t)4 * WP * D); p.wt_out = a.get<bf16_t>((size_t)4 * D * 1024); p.wt_mem = a.get<bf16_t>((size_t)4 * 512 * D);
    p.w1t = a.get<bf16_t>((size_t)4 * 128 * 2048); p.w2t = a.get<bf16_t>((size_t)4 * 64 * 128); p.cb = a.get<float>(4 * 128);
    p.xb = a.get<bf16_t>((size_t)MPAD * D); p.rstd = a.get<float>(MPAD); p.mrstd = a.get<float>(NB * NM);
    p.proj = a.get<bf16_t>((size_t)MPAD * WP); p.vta = a.get<bf16_t>((size_t)3 * NB * 4 * 64 * S);
    p.vts = a.get<bf16_t>((size_t)NB * 2 * 64 * S); p.vtw = a.get<bf16_t>((size_t)NB * 2 * 64 * S);
    p.kta = a.get<bf16_t>((size_t)3 * NB * 4 * 64 * S); p.kts = a.get<bf16_t>((size_t)NB * 2 * 64 * S); p.ktw = a.get<bf16_t>((size_t)NB * 2 * 64 * S);
    p.kc = a.get<bf16_t>((size_t)NB * 2 * S * 64); p.vc = a.get<bf16_t>((size_t)NB * 2 * S * 64);
    p.mkb = a.get<bf16_t>((size_t)4 * NB * 4 * NM * 64); p.mvt = a.get<bf16_t>((size_t)4 * NB * 4 * 64 * NM);
    p.hid = a.get<float>((size_t)2 * NB * 2 * CSTR * 128); p.hid_s = a.get<float>((size_t)2 * 2 * NS * 2 * CSTR * 128);
    p.kcmp = a.get<bf16_t>((size_t)NB * 2 * CSTR * 64); p.vcmpt = a.get<bf16_t>((size_t)NB * 2 * 64 * CSTR);
    p.kcmp_s = a.get<bf16_t>((size_t)2 * NS * 2 * CSTR * 64); p.vcmpt_s = a.get<bf16_t>((size_t)2 * NS * 2 * 64 * CSTR);
    p.z = a.get<bf16_t>((size_t)MPAD * 1024); p.y = a.get<float>((size_t)MPAD * D);
    p.pc = a.get<float>((size_t)M * 12 * CSTR); p.oc = a.get<float>((size_t)M * 12 * 64);
    p.imp = a.get<float>((size_t)M * 2 * IMPSTR); p.selb = a.get<int>((size_t)M * 2 * IMPSTR);
    p.memb = a.get<bf16_t>((size_t)NB * NM * D); p.yb = a.get<bf16_t>((size_t)MPAD * D);
    p.w1pq = a.get<bf16_t>((size_t)4 * 256 * 1024); p.cachec = a.get<bf16_t>((size_t)4 * NS * 2 * PL * 64);
    p.pq_s = a.get<bf16_t>((size_t)4 * NS * 2 * HB_S * 256 + 256 * 256); p.pq_p = a.get<bf16_t>((size_t)2 * NB * 2 * HB_P * 256 + 256 * 256);
}


typedef short bf16x8_t __attribute__((ext_vector_type(8)));
typedef float f32x4_t __attribute__((ext_vector_type(4)));
#define MFMA16(a, b, c) __builtin_amdgcn_mfma_f32_16x16x32_bf16((a), (b), (c), 0, 0, 0)

struct EpiProj {
    static constexpr bool PERM = true, AFTER_DRAIN = false;
    bf16_t* O; const float* rstd; int ldo;
    __device__ __forceinline__ void operator()(const pg8::f32x4 (&acc)[2][2][4][2], const pg8::Unit& u, int wr, int wc, int fr, int fq) const {
        const int row0 = u.pm * 256 + wr * 64 + fr, col0 = u.pn * 256 + wc * 32 + 8 * fq;
#pragma unroll
        for (int ai = 0; ai < 2; ++ai)
#pragma unroll
            for (int m = 0; m < 4; ++m) {
                const int row = row0 + ai * 128 + m * 16;
                const float rs = rstd ? rstd[row] : 1.0f;
                bf16_t* rowp = O + (size_t)row * ldo + col0;
#pragma unroll
                for (int bj = 0; bj < 2; ++bj) {
                    const pg8::f32x4 v0 = acc[ai][bj][m][0] * rs, v1 = acc[ai][bj][m][1] * rs;
                    pg8::u32x4 w; w.x = pg8::cvt_pk_bf16(v0[0], v0[1]); w.y = pg8::cvt_pk_bf16(v0[2], v0[3]); w.z = pg8::cvt_pk_bf16(v1[0], v1[1]); w.w = pg8::cvt_pk_bf16(v1[2], v1[3]);
                    *(pg8::u32x4*)(rowp + bj * 128) = w;
                }
            }
    }
};

__device__ __forceinline__ void wave_tile_32x16(const bf16_t* A, size_t lda, const bf16_t* Wt, int ldw, int r0, int c0, int K, float* out, int lane, size_t seg = 64) {
    const int l15 = lane & 15, g = lane >> 4;
    const bf16_t* ap = A + (size_t)(r0 + l15) * lda + 8 * g;
    const bf16_t* w0 = Wt + (size_t)(c0 + 8 * (l15 >> 2) + (l15 & 3)) * ldw + 8 * g;
    const bf16_t* w1 = w0 + (size_t)4 * ldw;
    f32x4_t d0 = {0.f, 0.f, 0.f, 0.f}, d1 = {0.f, 0.f, 0.f, 0.f};
#pragma unroll 8
    for (int k = 0; k < K; k += 32) {
        const bf16x8_t a = *(const bf16x8_t*)(ap + (size_t)(k >> 6) * seg + (k & 63));
        const bf16x8_t b0 = *(const bf16x8_t*)(w0 + k);
        const bf16x8_t b1 = *(const bf16x8_t*)(w1 + k);
        d0 = MFMA16(b0, a, d0);
        d1 = MFMA16(b1, a, d1);
    }
#pragma unroll
    for (int j = 0; j < 4; ++j) { out[j] = d0[j]; out[4 + j] = d1[j]; }
}


__device__ __forceinline__ void wg_tile_32x16(const bf16_t* A, size_t lda, const bf16_t* Wt, int ldw, int r0, int c0, int K, float* out, int lane, int wid, LAS float* red) {
    const int l15 = lane & 15, g = lane >> 4, kw = K / 8;
    const bf16_t* ap = A + (size_t)(r0 + l15) * lda + 8 * g + wid * kw;
    const bf16_t* w0 = Wt + (size_t)(c0 + 8 * (l15 >> 2) + (l15 & 3)) * ldw + 8 * g + wid * kw;
    const bf16_t* w1 = w0 + (size_t)4 * ldw;
    f32x4_t d0 = {0.f, 0.f, 0.f, 0.f}, d1 = {0.f, 0.f, 0.f, 0.f};
#pragma unroll 4
    for (int k = 0; k < kw; k += 32) {
        const bf16x8_t a = *(const bf16x8_t*)(ap + k);
        const bf16x8_t b0 = *(const bf16x8_t*)(w0 + k);
        const bf16x8_t b1 = *(const bf16x8_t*)(w1 + k);
        d0 = MFMA16(b0, a, d0);
        d1 = MFMA16(b1, a, d1);
    }
    __syncthreads();
#pragma unroll
    for (int j = 0; j < 4; ++j) { red[(wid * 8 + j) * 64 + lane] = d0[j]; red[(wid * 8 + 4 + j) * 64 + lane] = d1[j]; }
    __syncthreads();
#pragma unroll
    for (int j = 0; j < 8; ++j) {
        float s = 0.f;
#pragma unroll
        for (int w = 0; w < 8; ++w) s += red[(w * 8 + j) * 64 + lane];
        out[j] = s;
    }
}

__device__ __forceinline__ void fast_inproj(const Params& p, int i, LAS unsigned char* lds) {
    pg8::Gemm g; g.A = p.xb; g.Bt = p.wt_in + (size_t)i * WP * D; g.M = MP; g.N = WP; g.K = D;
    pg8::StaticOrder so; so.init(MP, WP, gridDim.x, blockIdx.x);
    EpiProj E; E.O = p.proj; E.rstd = p.rstd; E.ldo = WP;
    pg8::gemm_phase<EpiProj, pg8::StaticOrder, false>(lds, g, so, E, nullptr);
    int tid_l = threadIdx.x; asm volatile("" : "+v"(tid_l));
    const int lane = tid_l & 63, wid = __builtin_amdgcn_readfirstlane(tid_l >> 6);
    for (int u = blockIdx.x; u < (NS / 16) * (WP / 32); u += gridDim.x) {
        const int rt = u % (NS / 16), cg = u / (NS / 16);
        float v[8];
        wg_tile_32x16(p.xb, D, p.wt_in + (size_t)i * WP * D, D, MP + rt * 16, cg * 32, D, v, lane, wid, (LAS float*)lds);
        if (wid == 0) {
            const int row = MP + rt * 16 + (lane & 15);
            const float rs = p.rstd[row];
#pragma unroll
            for (int j = 0; j < 8; ++j) v[j] *= rs;
            st8_bf(p.proj + (size_t)row * WP + cg * 32 + 8 * (lane >> 4), v);
        }
    }
}

__device__ __forceinline__ void fast_outproj(const Params& p, int i, LAS unsigned char* lds) {
    const int KO = (i & 1) ? 1024 : 512;
    const bf16_t* wt = p.wt_out + (size_t)i * D * 1024;
    pg8::Gemm g; g.A = p.z; g.Bt = wt; g.M = MP; g.N = D; g.K = KO;
    pg8::StaticOrder so; so.init(MP, D, gridDim.x, blockIdx.x);
    EpiProj E; E.O = p.yb; E.rstd = nullptr; E.ldo = D;
    pg8::gemm_phase<EpiProj, pg8::StaticOrder, false>(lds, g, so, E, nullptr);
    int tid_l = threadIdx.x; asm volatile("" : "+v"(tid_l));
    const int lane = tid_l & 63, wid = __builtin_amdgcn_readfirstlane(tid_l >> 6);
    for (int u = blockIdx.x; u < (NS / 16) * (D / 32); u += gridDim.x) {
        const int rt = u % (NS / 16), cg = u / (NS / 16);
        float v[8];
        wg_tile_32x16(p.z, KO, wt, KO, MP + rt * 16, cg * 32, KO, v, lane, wid, (LAS float*)lds);
        if (wid == 0) st8_bf(p.yb + (size_t)(MP + rt * 16 + (lane & 15)) * D + cg * 32 + 8 * (lane >> 4), v);
    }
}


static_assert(D % 256 == 0, "row stages assume D a multiple of 256");
__device__ __forceinline__ float wave_sum(float v) {
#pragma unroll
    for (int o = 32; o > 0; o >>= 1) v += __shfl_xor(v, o);
    return v;
}
struct TrArgs { const float* src; int ldsrc, csrc, k0, c0; bf16_t* dst; int lddst; const float* scale; };
__device__ __forceinline__ void tr_load(const TrArgs& a, float4 (&v)[2], float (&sc)[2], int tid) {
#pragma unroll
    for (int h = 0; h < 2; ++h) {
        const int r = (tid >> 4) + 32 * h, c4 = (tid & 15) * 4;
        v[h] = make_float4(0.f, 0.f, 0.f, 0.f);
        if (a.c0 + c4 < a.csrc) v[h] = *(const float4*)(a.src + (size_t)(a.k0 + r) * a.ldsrc + a.c0 + c4);
        sc[h] = a.scale ? a.scale[a.k0 + r] : 1.0f;
    }
}
__device__ __forceinline__ void tr_to_lds(LAS float* tile, const float4 (&v)[2], const float (&sc)[2], int tid) {
#pragma unroll
    for (int h = 0; h < 2; ++h) {
        const int r = (tid >> 4) + 32 * h, c4 = (tid & 15) * 4;
        tile[r * 65 + c4 + 0] = v[h].x * sc[h]; tile[r * 65 + c4 + 1] = v[h].y * sc[h]; tile[r * 65 + c4 + 2] = v[h].z * sc[h]; tile[r * 65 + c4 + 3] = v[h].w * sc[h];
    }
}
__device__ __forceinline__ void tr_from_lds(const TrArgs& a, const LAS float* tile, int tid) {
    const int c = tid >> 3, k8 = (tid & 7) * 8;
    float v[8];
#pragma unroll
    for (int j = 0; j < 8; ++j) v[j] = tile[(k8 + j) * 65 + c];
    st8_bf(a.dst + (size_t)(a.c0 + c) * a.lddst + a.k0 + k8, v);
}
__device__ __forceinline__ TrArgs tr_job(const Params& p, int job) {
    constexpr int T_IN = (D / 64) * (WP / 64), T_OA = 8 * (D / 64), T_OB = 16 * (D / 64), T_MEM = (D / 64) * 8, T_W1 = 16 * 2, T_W2 = 2;
    constexpr int N_IN = 4 * T_IN, N_OUT = 2 * T_OA + 2 * T_OB, N_MEM = 4 * T_MEM, N_W1 = 8 * T_W1;
    TrArgs t; int j = job;
    if (j < N_IN) {
        const int i = j / T_IN, tt = j % T_IN, li = i >> 1, kt = tt % (D / 64), ct = tt / (D / 64);
        const bool isb = i & 1;
        t.src = isb ? p.w_in_b + (size_t)li * D * W_IN_B : p.w_in_a + (size_t)li * D * 3072; t.ldsrc = isb ? W_IN_B : 3072; t.csrc = t.ldsrc; t.k0 = kt * 64; t.c0 = ct * 64;
        t.dst = p.wt_in + (size_t)i * WP * D; t.lddst = D; t.scale = p.norm_pre + i * D; return t;
    }
    j -= N_IN;
    if (j < N_OUT) {
        int i, tt, KO;
        if (j < 2 * T_OA) { i = 2 * (j / T_OA); tt = j % T_OA; KO = 512; } else { j -= 2 * T_OA; i = 2 * (j / T_OB) + 1; tt = j % T_OB; KO = 1024; }
        const int li = i >> 1, kt = tt % (KO / 64), ct = tt / (KO / 64);
        t.src = KO == 512 ? p.w_out_a + (size_t)li * 512 * D : p.w_out_b + (size_t)li * 1024 * D; t.ldsrc = D; t.csrc = D; t.k0 = kt * 64; t.c0 = ct * 64;
        t.dst = p.wt_out + (size_t)i * D * 1024; t.lddst = KO; t.scale = nullptr; return t;
    }
    j -= N_OUT;
    if (j < N_MEM) {
        const int i = j / T_MEM, tt = j % T_MEM, kt = tt % (D / 64), ct = tt / (D / 64);
        t.src = p.w_mem_kv + (size_t)i * D * 512; t.ldsrc = 512; t.csrc = 512; t.k0 = kt * 64; t.c0 = ct * 64; t.dst = p.wt_mem + (size_t)i * 512 * D; t.lddst = D; t.scale = p.norm_mem + i * D; return t;
    }
    j -= N_MEM;
    if (j < N_W1) {
        const int lt = j / (2 * T_W1), hf = (j / T_W1) & 1, tt = j % T_W1, kt = tt % 16, ct = tt / 16;
        t.src = p.cmp_w1 + ((size_t)lt * 2048 + hf * 1024) * 128; t.ldsrc = 128; t.csrc = 128; t.k0 = kt * 64; t.c0 = ct * 64; t.dst = p.w1pq + ((size_t)lt * 256 + hf * 128) * 1024; t.lddst = 1024; t.scale = nullptr; return t;
    }
    j -= N_W1;
    { const int lt = j / T_W2, kt = j % T_W2; t.src = p.cmp_w2 + (size_t)lt * 128 * 64; t.ldsrc = 64; t.csrc = 64; t.k0 = kt * 64; t.c0 = 0; t.dst = p.w2t + (size_t)lt * 64 * 128; t.lddst = 128; t.scale = nullptr; return t; }
}
__device__ __forceinline__ void fast_prep_weights(const Params& p, LAS unsigned char* lds) {
    int tid = threadIdx.x; asm volatile("" : "+v"(tid));
    LAS float* tile = (LAS float*)lds;
    constexpr int N_ALL = 4 * (D / 64) * (WP / 64) + 2 * 8 * (D / 64) + 2 * 16 * (D / 64) + 4 * (D / 64) * 8 + 8 * 32 + 4 * 2;
    for (int job = 2 * blockIdx.x; job < N_ALL; job += 2 * gridDim.x) {
        const bool two = job + 1 < N_ALL;
        const TrArgs a0 = tr_job(p, job), a1 = tr_job(p, two ? job + 1 : job);
        float4 v0[2], v1[2]; float s0[2], s1[2];
        tr_load(a0, v0, s0, tid); tr_load(a1, v1, s1, tid);
        tr_to_lds(tile, v0, s0, tid); tr_to_lds(tile + 64 * 65, v1, s1, tid);
        __syncthreads();
        tr_from_lds(a0, tile, tid); if (two) tr_from_lds(a1, tile + 64 * 65, tid);
        __syncthreads();
    }
    {
        const int lane = tid & 63, wid = __builtin_amdgcn_readfirstlane(tid >> 6);
        for (int job = blockIdx.x * (NTHREADS / 64) + wid; job < 4 * 128; job += gridDim.x * (NTHREADS / 64)) {
            const int lt = job >> 7, jj = job & 127;
            const float* w = p.cmp_w1 + (size_t)lt * 2048 * 128 + jj; const float* ps = p.cmp_pos + (size_t)lt * 2048;
            float a = 0.f;
#pragma unroll 8
            for (int k = lane; k < 2048; k += 64) a += ps[k] * w[(size_t)k * 128];
            a = wave_sum(a);
            if (lane == 0) p.cb[job] = a;
        }
    }
}
__device__ __forceinline__ void prep_rows2(const float* src0, const float* src1, bf16_t* dst0, bf16_t* dst1, float* rs0, float* rs1, bool two, int lane) {
    constexpr int Q = D / 256;
    float4 v0[Q], v1[Q];
#pragma unroll
    for (int q = 0; q < Q; ++q) { v0[q] = *(const float4*)(src0 + q * 256 + lane * 4); v1[q] = *(const float4*)(src1 + q * 256 + lane * 4); }
    float s0 = 0.f, s1 = 0.f;
#pragma unroll
    for (int q = 0; q < Q; ++q) {
        s0 += v0[q].x * v0[q].x + v0[q].y * v0[q].y + v0[q].z * v0[q].z + v0[q].w * v0[q].w;
        s1 += v1[q].x * v1[q].x + v1[q].y * v1[q].y + v1[q].z * v1[q].z + v1[q].w * v1[q].w;
        uint2 o; o.x = pack_bf2(v0[q].x, v0[q].y); o.y = pack_bf2(v0[q].z, v0[q].w);
        *(uint2*)(dst0 + q * 256 + lane * 4) = o;
        if (two) { uint2 o1; o1.x = pack_bf2(v1[q].x, v1[q].y); o1.y = pack_bf2(v1[q].z, v1[q].w); *(uint2*)(dst1 + q * 256 + lane * 4) = o1; }
    }
    s0 = wave_sum(s0); s1 = wave_sum(s1);
    if (lane == 0) { *rs0 = 1.0f / sqrtf(s0 / D + RMS_EPS); if (two) *rs1 = 1.0f / sqrtf(s1 / D + RMS_EPS); }
}
__device__ __forceinline__ void fast_prep_x(const Params& p) {
    int tid_l = threadIdx.x; asm volatile("" : "+v"(tid_l));
    const int lane = tid_l & 63, wid = __builtin_amdgcn_readfirstlane(tid_l >> 6);
    const int gw = blockIdx.x * (NTHREADS / 64) + wid, nw = gridDim.x * (NTHREADS / 64);
    static_assert(MP % 2 == 0 && NS % 2 == 0 && (NB * NM) % 2 == 0, "row pairs");
    for (int r = 2 * gw; r < MP; r += 2 * nw) prep_rows2(p.x_prompt + (size_t)r * D, p.x_prompt + (size_t)(r + 1) * D, p.xb + (size_t)r * D, p.xb + (size_t)(r + 1) * D, p.rstd + r, p.rstd + r + 1, true, lane);
    for (int r = 2 * gw; r < NS; r += 2 * nw) prep_rows2(p.x_sample + (size_t)r * D, p.x_sample + (size_t)(r + 1) * D, p.xb + (size_t)(MP + r) * D, p.xb + (size_t)(MP + r + 1) * D, p.rstd + MP + r, p.rstd + MP + r + 1, true, lane);
    for (int r = 2 * gw; r < NB * NM; r += 2 * nw) prep_rows2(p.mem_prompt + (size_t)r * D, p.mem_prompt + (size_t)(r + 1) * D, p.memb + (size_t)r * D, p.memb + (size_t)(r + 1) * D, p.mrstd + r, p.mrstd + r + 1, true, lane);
}
__device__ __forceinline__ void fast_finish(const Params& p, int i) {
    int tid_l = threadIdx.x; asm volatile("" : "+v"(tid_l));
    const int lane = tid_l & 63, wid = __builtin_amdgcn_readfirstlane(tid_l >> 6);
    const int gw = blockIdx.x * (NTHREADS / 64) + wid, nw = gridDim.x * (NTHREADS / 64);
    constexpr int Q = D / 256;
    for (int r0 = 2 * gw; r0 < M; r0 += 2 * nw) {
        float4 yv[2][Q], xv[2][Q], gv[Q];
#pragma unroll
        for (int k = 0; k < 2; ++k) {
            const int r = (r0 + k < M) ? r0 + k : r0;
            const bf16_t* y = p.yb + (size_t)r * D; const bf16_t* xi = p.xb + (size_t)r * D;
#pragma unroll
            for (int q = 0; q < Q; ++q) {
                const uint2 u = *(const uint2*)(y + q * 256 + lane * 4), w = *(const uint2*)(xi + q * 256 + lane * 4);
                yv[k][q] = make_float4(__uint_as_float(u.x << 16), __uint_as_float(u.x & 0xffff0000u), __uint_as_float(u.y << 16), __uint_as_float(u.y & 0xffff0000u));
                xv[k][q] = make_float4(__uint_as_float(w.x << 16), __uint_as_float(w.x & 0xffff0000u), __uint_as_float(w.y << 16), __uint_as_float(w.y & 0xffff0000u));
            }
        }
#pragma unroll
        for (int q = 0; q < Q; ++q) gv[q] = *(const float4*)(p.norm_post + i * D + q * 256 + lane * 4);
#pragma unroll
        for (int k = 0; k < 2; ++k) {
            if (r0 + k >= M) break;
            const int r = r0 + k;
            float ss = 0.f;
#pragma unroll
            for (int q = 0; q < Q; ++q) ss += yv[k][q].x * yv[k][q].x + yv[k][q].y * yv[k][q].y + yv[k][q].z * yv[k][q].z + yv[k][q].w * yv[k][q].w;
            const float yr = 1.0f / sqrtf(wave_sum(ss) / D + RMS_EPS);
            float s2 = 0.f;
            float* xo = r < MP ? p.o_y + (size_t)r * D : p.o_ys + (size_t)(r - MP) * D;
#pragma unroll
            for (int q = 0; q < Q; ++q) {
                float4 v; v.x = xv[k][q].x + yv[k][q].x * yr * gv[q].x; v.y = xv[k][q].y + yv[k][q].y * yr * gv[q].y; v.z = xv[k][q].z + yv[k][q].z * yr * gv[q].z; v.w = xv[k][q].w + yv[k][q].w * yr * gv[q].w;
                if (i == 3) *(float4*)(xo + q * 256 + lane * 4) = v;
                else {
                    uint2 o; o.x = pack_bf2(v.x, v.y); o.y = pack_bf2(v.z, v.w);
                    *(uint2*)(p.xb + (size_t)r * D + q * 256 + lane * 4) = o;
                    const float a = __uint_as_float(o.x << 16), b = __uint_as_float(o.x & 0xffff0000u), c = __uint_as_float(o.y << 16), d = __uint_as_float(o.y & 0xffff0000u);
                    s2 += a * a + b * b + c * c + d * d;
                }
            }
            if (i < 3) { s2 = wave_sum(s2); if (lane == 0) p.rstd[r] = 1.0f / sqrtf(s2 / D + RMS_EPS); }
        }
    }
}
__device__ __forceinline__ void fast_memkv(const Params& p) {
    int tid_l = threadIdx.x; asm volatile("" : "+v"(tid_l));
    const int lane = tid_l & 63, wid = __builtin_amdgcn_readfirstlane(tid_l >> 6);
    const int gw = blockIdx.x * (NTHREADS / 64) + wid, nw = gridDim.x * (NTHREADS / 64);
    constexpr int RT = NB * NM / 16;
    for (int u = gw; u < 4 * RT * 16; u += nw) {
        const int cg = u % 16, rt = (u / 16) % RT, i = u / (16 * RT);
        float v[8];
        wave_tile_32x16(p.memb, D, p.wt_mem + (size_t)i * 512 * D, D, rt * 16, cg * 32, D, v, lane);
        const int row = rt * 16 + (lane & 15), c0 = cg * 32 + 8 * (lane >> 4);
        const float rs = p.mrstd[row];
#pragma unroll
        for (int j = 0; j < 8; ++j) v[j] *= rs;
        st8_f(p.o_mem + ((size_t)i * NB * NM + row) * 512 + c0, v);
        const int n = row / NM, m = row % NM, h = (c0 % 256) / 64, e0 = c0 % 64;
        if (c0 < 256) st8_bf(p.mkb + (((size_t)i * NB + n) * 4 + h) * NM * 64 + kt_pos(m, e0), v);
        else {
            bf16_t* o = p.mvt + (((size_t)i * NB + n) * 4 + h) * 64 * NM + vt_pos(m) + e0 * VT_LD;
#pragma unroll
            for (int j = 0; j < 8; ++j) o[j * VT_LD] = f2bf(v[j]);
        }
    }
}

__device__ __forceinline__ void fast_conv_cache(const Params& p) {
    int tid = threadIdx.x; asm volatile("" : "+v"(tid));
    constexpr long NITEMS = (long)NS * PL * 64;
    const long gsz = (long)gridDim.x * NTHREADS;
    for (long base = (long)blockIdx.x * NTHREADS + tid; base < NITEMS; base += 8 * gsz) {
        f32x4_t a[8][2]; bf16_t* dst[8];
#pragma unroll
        for (int u = 0; u < 8; ++u) {
            const long it = base + u * gsz;
            dst[u] = nullptr;
            if (it < NITEMS) {
                const int e8 = it & 7, kv = (it >> 3) & 1, ty = (it >> 4) & 1, li = (it >> 5) & 1; const long np = it >> 6;
                const int pos = (int)(np % PL), n = (int)(np / PL);
                const int page = p.page_table[n * NPAGES + (pos >> 7)];
                const float* src = p.cache_b_pages + ((((size_t)page * 128 + (pos & 127)) * 2 + li) * 4 + ty) * 128 + kv * 64 + e8 * 8;
                a[u][0] = __builtin_nontemporal_load((const f32x4_t*)src); a[u][1] = __builtin_nontemporal_load((const f32x4_t*)src + 1);
                dst[u] = p.cachec + (((((size_t)li * 2 + ty) * NS + n) * 2 + kv) * PL + pos) * 64 + e8 * 8;
            }
        }
#pragma unroll
        for (int u = 0; u < 8; ++u)
            if (dst[u]) { uint4 o; o.x = pack_bf2(a[u][0][0], a[u][0][1]); o.y = pack_bf2(a[u][0][2], a[u][0][3]); o.z = pack_bf2(a[u][1][0], a[u][1][1]); o.w = pack_bf2(a[u][1][2], a[u][1][3]); *(uint4*)dst[u] = o; }
    }
}

__device__ __forceinline__ void post_items(const Params& p, int i, int nrows, int c8lo, int nc8, bool window_rows, int tid) {
    const int nitems = nrows * nc8, gsz = (int)gridDim.x * NTHREADS;
    for (int base = (int)blockIdx.x * NTHREADS + tid; base < nitems; base += 4 * gsz) {
        uint4 u[4]; int rr[4];
#pragma unroll
        for (int k = 0; k < 4; ++k) {
            const int it = base + k * gsz;
            int r = it % nrows;
            if (window_rows) r = r < NB * WROWS2 ? (r / WROWS2) * S + (S - WROWS2) + r % WROWS2 : MP + (r - NB * WROWS2);
            rr[k] = r;
            if (it < nitems) u[k] = *(const uint4*)(p.proj + (size_t)r * WP + 768 + (c8lo + it / nrows) * 8);
        }
#pragma unroll
        for (int k = 0; k < 4; ++k) {
            const int it = base + k * gsz;
            if (it < nitems) {
                float v[8];
                v[0] = __uint_as_float(u[k].x << 16); v[1] = __uint_as_float(u[k].x & 0xffff0000u); v[2] = __uint_as_float(u[k].y << 16); v[3] = __uint_as_float(u[k].y & 0xffff0000u);
                v[4] = __uint_as_float(u[k].z << 16); v[5] = __uint_as_float(u[k].z & 0xffff0000u); v[6] = __uint_as_float(u[k].w << 16); v[7] = __uint_as_float(u[k].w & 0xffff0000u);
                inproj_extra8(p, i, rr[k], 768 + (c8lo + it / nrows) * 8, v, false);
            }
        }
    }
}
__device__ __forceinline__ void fast_post(const Params& p, int i) {
    int tid = threadIdx.x; asm volatile("" : "+v"(tid));
    if (i & 1) post_items(p, i, M, 0, 96, false, tid);
    else {
        post_items(p, i, M, 0, 192, false, tid);
    }
}
constexpr long CONV_TOTAL = (long)NS * PL * 64;
constexpr int CONV_NITEMS = 2048;
constexpr long CONV_ITEM = CONV_TOTAL / CONV_NITEMS;
static_assert(CONV_TOTAL < (1l << 31) && CONV_TOTAL % CONV_NITEMS == 0 && CONV_ITEM % (64 * 4) == 0, "conversion items");
__device__ __forceinline__ void conv_item(const Params& p, int c, int lane) {
    for (int base = c * (int)CONV_ITEM + lane; base < (c + 1) * (int)CONV_ITEM; base += 64 * 4) {
        f32x4_t a[4][2]; bf16_t* dst[4];
#pragma unroll
        for (int u = 0; u < 4; ++u) {
            const int it = base + u * 64;
            const int e8 = it & 7, kv = (it >> 3) & 1, ty = (it >> 4) & 1, li = (it >> 5) & 1, np = it >> 6;
            const int pos = np % PL, n = np / PL;
            const int page = p.page_table[n * NPAGES + (pos >> 7)];
            const float* src = p.cache_b_pages + ((((size_t)page * 128 + (pos & 127)) * 2 + li) * 4 + ty) * 128 + kv * 64 + e8 * 8;
            a[u][0] = *(const f32x4_t*)src; a[u][1] = *((const f32x4_t*)src + 1);
            dst[u] = p.cachec + (((((size_t)li * 2 + ty) * NS + n) * 2 + kv) * PL + pos) * 64 + e8 * 8;
        }
#pragma unroll
        for (int u = 0; u < 4; ++u) { uint4 o; o.x = pack_bf2(a[u][0][0], a[u][0][1]); o.y = pack_bf2(a[u][0][2], a[u][0][3]); o.z = pack_bf2(a[u][1][0], a[u][1][1]); o.w = pack_bf2(a[u][1][2], a[u][1][3]); *(uint4*)dst[u] = o; }
    }
}


constexpr float LOG2E = 1.4426950408889634f;
constexpr float C1 = SCALE * LOG2E;

typedef __bf16 bf16v2_t __attribute__((ext_vector_type(2)));
__device__ __forceinline__ unsigned cvt_pk(float lo, float hi) { bf16v2_t v; v.x = (__bf16)lo; v.y = (__bf16)hi; return __builtin_bit_cast(unsigned, v); }
__device__ __forceinline__ float ex2(float x) { return __builtin_amdgcn_exp2f(x); }
__device__ __forceinline__ float xmax4(float v) { v = fmaxf(v, __shfl_xor(v, 16)); return fmaxf(v, __shfl_xor(v, 32)); }
__device__ __forceinline__ float xsum4(float v) { v += __shfl_xor(v, 16); return v + __shfl_xor(v, 32); }

template <int NB_> struct Stream {
    f32x4_t o[NB_][4];
    float m[NB_], l[NB_], thr[NB_];
    __device__ __forceinline__ void reset2() {
#pragma unroll
        for (int b = 0; b < NB_; ++b) { m[b] = 0.f; thr[b] = -INFINITY; l[b] = 0.f;
#pragma unroll
            for (int d = 0; d < 4; ++d) o[b][d] = (f32x4_t){0.f, 0.f, 0.f, 0.f}; }
    }
    __device__ __forceinline__ void reset() {
#pragma unroll
        for (int b = 0; b < NB_; ++b) { m[b] = -INFINITY; l[b] = 0.f;
#pragma unroll
            for (int d = 0; d < 4; ++d) o[b][d] = (f32x4_t){0.f, 0.f, 0.f, 0.f}; }
    }
};

__device__ __forceinline__ void load_k(bf16x8_t (&kf)[2][2], const bf16_t* krow0, size_t ldk, int m, int g) {
    const bf16_t* r0 = krow0 + (size_t)(8 * (m >> 2) + (m & 3)) * ldk + 8 * g;
#pragma unroll
    for (int t = 0; t < 2; ++t)
#pragma unroll
        for (int ks = 0; ks < 2; ++ks) kf[t][ks] = *(const bf16x8_t*)(r0 + (size_t)(4 * t) * ldk + 32 * ks);
}
__device__ __forceinline__ void load_kt(bf16x8_t (&kf)[2][2], const bf16_t* chunk0, int m, int g) {
    const bf16_t* r0 = chunk0 + (8 * (m >> 2) + (m & 3)) * 32 + 8 * g;
#pragma unroll
    for (int t = 0; t < 2; ++t)
#pragma unroll
        for (int ks = 0; ks < 2; ++ks) kf[t][ks] = *(const bf16x8_t*)(r0 + 4 * t * 32 + ks * 1024);
}
__device__ __forceinline__ void load_v(bf16x8_t (&vf)[4], const bf16_t* vt0, size_t ldv, int m, int g) {
#pragma unroll
    for (int d = 0; d < 4; ++d) vf[d] = *(const bf16x8_t*)(vt0 + (size_t)(16 * d + m) * ldv + 8 * g);
}

__device__ __forceinline__ void chunk_scores(float (&x)[8], const bf16x8_t (&kf)[2][2], const bf16x8_t (&q)[2], float sl2, float dist0, float dstep, float maxd, bool ok, bool allv) {
    f32x4_t s0 = {0.f, 0.f, 0.f, 0.f}, s1 = {0.f, 0.f, 0.f, 0.f};
    s0 = MFMA16(kf[0][0], q[0], s0); s0 = MFMA16(kf[0][1], q[1], s0);
    s1 = MFMA16(kf[1][0], q[0], s1); s1 = MFMA16(kf[1][1], q[1], s1);
    const float cb = -sl2 * dist0, cs = sl2 * dstep;
    if (allv) {
#pragma unroll
        for (int j = 0; j < 8; ++j) x[j] = fmaf(j < 4 ? s0[j & 3] : s1[j & 3], C1, fmaf(cs, (float)j, cb));
    } else {
        float dist0o = dist0; asm volatile("" : "+v"(dist0o));
#pragma unroll
        for (int j = 0; j < 8; ++j) {
            const float d = dist0o - dstep * (float)j;
            const float v = fmaf(j < 4 ? s0[j & 3] : s1[j & 3], C1, fmaf(cs, (float)j, cb));
            x[j] = (ok && d >= 0.f && d <= maxd) ? v : -INFINITY;
        }
    }
}
__device__ __forceinline__ float max8(const float (&x)[8]) { return fmaxf(fmaxf(fmaxf(x[0], x[1]), fmaxf(x[2], x[3])), fmaxf(fmaxf(x[4], x[5]), fmaxf(x[6], x[7]))); }
__device__ __forceinline__ float max3q(float a, float b, float c) { float r; asm("v_max3_f32 %0, %1, %2, %3" : "=v"(r) : "v"(a), "v"(b), "v"(c)); return r; }
__device__ __forceinline__ float max8q(const float (&x)[8]) { const float t0 = max3q(x[0], x[1], x[2]), t1 = max3q(x[3], x[4], x[5]); return max3q(x[6], x[7], max3q(t0, t1, t1)); }
constexpr float ZERO_GAP = 150.0f;
constexpr float LAZY_THR = 8.0f;

template <int NB_> __device__ __forceinline__ void chunk_attend(Stream<NB_>& st, const bf16x8_t (&kf)[2][2], const bf16x8_t (&vf)[4], const bf16x8_t (&q)[NB_][2],
                                                                   const float (&sl2)[NB_], float dist0, float dstep, float maxd, bool ok) {
    const bool allv = __all(ok && (dist0 - 7.f * dstep >= 0.f) && (dist0 <= maxd));
#pragma unroll
    for (int b = 0; b < NB_; ++b) {
        float x[8];
        chunk_scores(x, kf, q[b], sl2[b], dist0, dstep, maxd, ok, allv);
        const float lm = max8(x);
        if (__any(lm > st.m[b] + LAZY_THR)) {
            const float mn = fmaxf(st.m[b], xmax4(lm));
            const float ms = mn == -INFINITY ? 0.f : mn;
            const float al = ex2(st.m[b] - ms);
            st.l[b] *= al; st.m[b] = mn;
#pragma unroll
            for (int d = 0; d < 4; ++d) st.o[b][d] *= al;
        }
        const float ms = st.m[b] == -INFINITY ? 0.f : st.m[b];
        if (__all(lm < ms - ZERO_GAP)) continue;
        float pj[8], ps = 0.f;
#pragma unroll
        for (int j = 0; j < 8; ++j) { pj[j] = ex2(x[j] - ms); ps += pj[j]; }
        st.l[b] += ps;
        union { bf16x8_t v; unsigned u[4]; } pk;
#pragma unroll
        for (int j = 0; j < 4; ++j) pk.u[j] = cvt_pk(pj[2 * j], pj[2 * j + 1]);
#pragma unroll
        for (int d = 0; d < 4; ++d) st.o[b][d] = MFMA16(vf[d], pk.v, st.o[b][d]);
    }
}


__device__ __forceinline__ bf16x8_t scale_q(bf16x8_t q) {
    union { bf16x8_t v; unsigned u[4]; } a; a.v = q;
#pragma unroll
    for (int j = 0; j < 4; ++j) a.u[j] = cvt_pk(__uint_as_float(a.u[j] << 16) * C1, __uint_as_float(a.u[j] & 0xffff0000u) * C1);
    return a.v;
}
template <int NB_> __device__ __forceinline__ void qk_folded(float (&x)[NB_][8], const bf16x8_t (&kf)[2][2], const bf16x8_t (&q)[NB_][2], const float (&sl2)[NB_], const float (&m)[NB_], float dist0, float dstep) {
#pragma unroll
    for (int b = 0; b < NB_; ++b) {
        const float base = fmaf(-sl2[b], dist0, -m[b]), cs = sl2[b] * dstep;
        f32x4_t s0 = {base, base + cs, fmaf(cs, 2.f, base), fmaf(cs, 3.f, base)}, s1 = {fmaf(cs, 4.f, base), fmaf(cs, 5.f, base), fmaf(cs, 6.f, base), fmaf(cs, 7.f, base)};
        s0 = MFMA16(kf[0][0], q[b][0], s0); s0 = MFMA16(kf[0][1], q[b][1], s0);
        s1 = MFMA16(kf[1][0], q[b][0], s1); s1 = MFMA16(kf[1][1], q[b][1], s1);
#pragma unroll
        for (int j = 0; j < 8; ++j) x[b][j] = j < 4 ? s0[j & 3] : s1[j & 3];
    }
}
template <int NB_> __device__ __forceinline__ void mask_folded(float (&x)[NB_][8], float dist0, float dstep) {
    float dm = dist0; asm volatile("" : "+v"(dm));
#pragma unroll
    for (int j = 0; j < 8; ++j) {
        const bool v = dm - dstep * (float)j >= 0.f;
#pragma unroll
        for (int b = 0; b < NB_; ++b) x[b][j] = v ? x[b][j] : -INFINITY;
    }
}
template <int NB_> __device__ __forceinline__ void refresh_folded(Stream<NB_>& st, float (&x)[NB_][8]) {
#pragma unroll
    for (int b = 0; b < NB_; ++b) {
        const float lmx = xmax4(max8(x[b]));
        const bool first = st.thr[b] < 0.f, none = lmx == -INFINITY;
        const float up = none ? 0.f : (first ? lmx : fmaxf(lmx, 0.f));
        const float al = first ? 1.f : ex2(-up);
        st.m[b] += up; st.l[b] *= al;
        st.thr[b] = (first && none) ? -INFINITY : LAZY_THR;
#pragma unroll
        for (int d = 0; d < 4; ++d) st.o[b][d] *= al;
#pragma unroll
        for (int j = 0; j < 8; ++j) x[b][j] -= up;
    }
}
template <int NB_, class LoadK> __device__ __forceinline__ void chunk_attend_pf(Stream<NB_>& st, bf16x8_t (&kf)[2][2], const bf16x8_t (&vf)[4], const bf16x8_t (&q)[NB_][2],
                                                                                  const float (&sl2)[NB_], float dist0, float dstep, float maxd, bool ok, bool has_next, LoadK load_next_k) {
    float x[NB_][8];
#pragma unroll
    for (int b = 0; b < NB_; ++b) {
        const float base = fmaf(-sl2[b], dist0, -st.m[b]), cs = sl2[b] * dstep;
        f32x4_t s0 = {base, base + cs, fmaf(cs, 2.f, base), fmaf(cs, 3.f, base)}, s1 = {fmaf(cs, 4.f, base), fmaf(cs, 5.f, base), fmaf(cs, 6.f, base), fmaf(cs, 7.f, base)};
        s0 = MFMA16(kf[0][0], q[b][0], s0); s0 = MFMA16(kf[0][1], q[b][1], s0);
        s1 = MFMA16(kf[1][0], q[b][0], s1); s1 = MFMA16(kf[1][1], q[b][1], s1);
#pragma unroll
        for (int j = 0; j < 8; ++j) x[b][j] = j < 4 ? s0[j & 3] : s1[j & 3];
    }
    if (has_next) load_next_k(kf);
    if (!__all(ok && (dist0 - 7.f * dstep >= 0.f) && (dist0 <= maxd))) {
        float dm = dist0; asm volatile("" : "+v"(dm));
#pragma unroll
        for (int j = 0; j < 8; ++j) {
            const float d = dm - dstep * (float)j;
            const bool v = ok && d >= 0.f && d <= maxd;
#pragma unroll
            for (int b = 0; b < NB_; ++b) x[b][j] = v ? x[b][j] : -INFINITY;
        }
    }
    bool need = false;
#pragma unroll
    for (int b = 0; b < NB_; ++b) need |= (max8q(x[b]) > st.thr[b]);
    if (__any(need)) refresh_folded<NB_>(st, x);
#pragma unroll
    for (int b = 0; b < NB_; ++b) {
        float pj[8];
#pragma unroll
        for (int j = 0; j < 8; ++j) pj[j] = ex2(x[b][j]);
        st.l[b] += ((pj[0] + pj[1]) + (pj[2] + pj[3])) + ((pj[4] + pj[5]) + (pj[6] + pj[7]));
        union { bf16x8_t v; unsigned u[4]; } pk;
#pragma unroll
        for (int j = 0; j < 4; ++j) pk.u[j] = cvt_pk(pj[2 * j], pj[2 * j + 1]);
#pragma unroll
        for (int d = 0; d < 4; ++d) st.o[b][d] = MFMA16(vf[d], pk.v, st.o[b][d]);
    }
}

template <int NB_> __device__ __forceinline__ void chunk_attend_mb(Stream<NB_>& st, const bf16x8_t (&kf)[2][2], const bf16x8_t (&vf)[4], const bf16x8_t (&q)[NB_][2],
                                                                     float sl2, const float (&dist0)[NB_], float maxd) {
    float x[NB_][8];
    bool allv = true;
#pragma unroll
    for (int b = 0; b < NB_; ++b) {
        const float base = fmaf(-sl2, dist0[b], -st.m[b]);
        f32x4_t s0 = {base, base + sl2, fmaf(sl2, 2.f, base), fmaf(sl2, 3.f, base)}, s1 = {fmaf(sl2, 4.f, base), fmaf(sl2, 5.f, base), fmaf(sl2, 6.f, base), fmaf(sl2, 7.f, base)};
        s0 = MFMA16(kf[0][0], q[b][0], s0); s0 = MFMA16(kf[0][1], q[b][1], s0);
        s1 = MFMA16(kf[1][0], q[b][0], s1); s1 = MFMA16(kf[1][1], q[b][1], s1);
#pragma unroll
        for (int j = 0; j < 8; ++j) x[b][j] = j < 4 ? s0[j & 3] : s1[j & 3];
        allv = allv && (dist0[b] - 7.f >= 0.f) && (dist0[b] <= maxd);
    }
    if (!__all(allv)) {
#pragma unroll
        for (int b = 0; b < NB_; ++b) {
            float dm = dist0[b]; asm volatile("" : "+v"(dm));
#pragma unroll
            for (int j = 0; j < 8; ++j) { const float d = dm - (float)j; x[b][j] = (d >= 0.f && d <= maxd) ? x[b][j] : -INFINITY; }
        }
    }
    bool need = false;
#pragma unroll
    for (int b = 0; b < NB_; ++b) need |= (max8q(x[b]) > st.thr[b]);
    if (__any(need)) refresh_folded<NB_>(st, x);
#pragma unroll
    for (int b = 0; b < NB_; ++b) {
        float pj[8];
#pragma unroll
        for (int j = 0; j < 8; ++j) pj[j] = ex2(x[b][j]);
        st.l[b] += ((pj[0] + pj[1]) + (pj[2] + pj[3])) + ((pj[4] + pj[5]) + (pj[6] + pj[7]));
        union { bf16x8_t v; unsigned u[4]; } pk;
#pragma unroll
        for (int j = 0; j < 4; ++j) pk.u[j] = cvt_pk(pj[2 * j], pj[2 * j + 1]);
#pragma unroll
        for (int d = 0; d < 4; ++d) st.o[b][d] = MFMA16(vf[d], pk.v, st.o[b][d]);
    }
}

template <int DEPTH, class LoadF, class AttF> __device__ __forceinline__ void chunk_loop_d(int first, int last, LoadF load, AttF att) {
    if (first < last) return;
    bf16x8_t kfr[DEPTH][2][2], vfr[DEPTH][4];
#pragma unroll
    for (int d = 0; d < DEPTH; ++d) { const int k = first - 32 * d; if (k >= last) load(k, kfr[d], vfr[d]); }
    for (int k0 = first; k0 >= last; k0 -= 32 * DEPTH) {
#pragma unroll
        for (int d = 0; d < DEPTH; ++d) {
            const int k = k0 - 32 * d;
            if (k >= last) {
                att(k, kfr[d], vfr[d]);
                const int kn = k - 32 * DEPTH;
                if (kn >= last) load(kn, kfr[d], vfr[d]);
            }
        }
    }
}
template <class LoadF, class AttF> __device__ __forceinline__ void chunk_loop(int first, int last, LoadF load, AttF att) { chunk_loop_d<3>(first, last, load, att); }

__device__ __forceinline__ int wq_next(unsigned* ctr, int lane) {
    unsigned v = 0u;
    if (lane == 0) v = __hip_atomic_fetch_add(ctr, 1u, __ATOMIC_RELAXED, __HIP_MEMORY_SCOPE_AGENT);
    return (int)__builtin_amdgcn_readfirstlane(v);
}

__device__ __forceinline__ int wq_next8(unsigned* ctr, LAS int* slot, int wid, int lane) {
    __syncthreads();
    if (wid == 0 && lane == 0) *slot = (int)__hip_atomic_fetch_add(ctr, 8u, __ATOMIC_RELAXED, __HIP_MEMORY_SCOPE_AGENT);
    __syncthreads();
    return *slot + wid;
}

__device__ __forceinline__ void fast_nsa_prompt(const Params& p, int i, LAS unsigned char* lds, int cslot = 0) {
    int tid_l = threadIdx.x; asm volatile("" : "+v"(tid_l));
    const int lane = tid_l & 63, wid = __builtin_amdgcn_readfirstlane(tid_l >> 6);
    const int c = lane & 15, g = lane >> 4, tok = c & 7, hsel = c >> 3;
    LAS float* imp = (LAS float*)(lds + wid * 16640);
    LAS unsigned* selm = (LAS unsigned*)(lds + wid * 16640 + 4096);
    LAS float* ofl = (LAS float*)(lds + wid * 16640 + 4224) + lane;
    constexpr int TILES = S / 8, NSEQ = NB * 2, NUNITS = NSEQ * TILES;
    unsigned* ctr0 = p.bar + WQ_BASE + 16 * (16 + (i >> 1) * 4);
    const int xcd = (int)xb_xcc_id();
    int qs = 0, nk = xcd & 3;
    for (;;) {
        int up;
        for (;;) { up = wq_next(ctr0 + 16 * nk, lane); if (up < TILES || ++qs >= NSEQ) break; nk = (xcd + qs) & 3; }
        if (qs >= NSEQ) break;
        const int tile = TILES - 1 - up;
        const int n = nk >> 1, kv = nk & 1, t0 = tile * 8, tq = t0 + tok;
        const size_t rowq = (size_t)(n * S + tq);
        bf16x8_t q[3][2]; float sl2[3];
#pragma unroll
        for (int b = 0; b < 3; ++b) {
            const int hd = kv * 6 + 2 * b + hsel;
            sl2[b] = slope_b(hd) * LOG2E;
#pragma unroll
            for (int ks = 0; ks < 2; ++ks) q[b][ks] = scale_q(*(const bf16x8_t*)(p.proj + rowq * WP + hd * 64 + 32 * ks + 8 * g));
        }
#define GATE(b, br) sigmoid_f(bf2f(p.proj[rowq * WP + 1536 + (kv * 6 + 2 * (b) + hsel) * 3 + (br)]))
#pragma unroll
        for (int k = 0; k < 16; ++k) imp[lane + 64 * k] = 0.f;

        const bf16_t* kcb = p.kcmp + (size_t)nk * CSTR * 64;
        const bf16_t* vcb = p.vcmpt + (size_t)nk * 64 * CSTR;
        const int ncv = (t0 + 7 >= 31) ? ((t0 + 7 - 31) / 16 + 1) : 0;
        const int nch = (ncv + 31) / 32;
        const float dq = (float)(tq - 31);
        float mc[3], il[3];
        {
            Stream<3> s1; s1.reset2();
            bf16x8_t kf[2][2];
            if (nch > 0) load_kt(kf, kcb + (size_t)(32 * (nch - 1)) * 64, c, g);
            for (int ch = nch - 1; ch >= 0; --ch) {
                const float dist0 = dq - 16.f * (float)(32 * ch + 8 * g);
                float x[3][8];
                qk_folded<3>(x, kf, q, sl2, s1.m, dist0, 16.f);
                if (ch > 0) load_kt(kf, kcb + (size_t)(32 * (ch - 1)) * 64, c, g);
                if (!__all(dist0 - 7.f * 16.f >= 0.f)) mask_folded<3>(x, dist0, 16.f);
                bool need = false;
#pragma unroll
                for (int b = 0; b < 3; ++b) need |= (max8q(x[b]) > s1.thr[b]);
                if (__any(need)) refresh_folded<3>(s1, x);
#pragma unroll
                for (int b = 0; b < 3; ++b) {
                    float pj[8];
#pragma unroll
                    for (int j = 0; j < 8; ++j) pj[j] = ex2(x[b][j]);
                    s1.l[b] += ((pj[0] + pj[1]) + (pj[2] + pj[3])) + ((pj[4] + pj[5]) + (pj[6] + pj[7]));
                }
            }
#pragma unroll
            for (int b = 0; b < 3; ++b) { const float lt = xsum4(s1.l[b]); il[b] = 1.0f / fmaxf(lt, 1e-30f); mc[b] = s1.m[b]; }
        }
        {
            Stream<3> st; st.reset();
            for (int ch = nch - 1; ch >= 0; --ch) {
                bf16x8_t kf[2][2], vf[4];
                load_kt(kf, kcb + (size_t)(32 * ch) * 64, c, g);
                load_v(vf, vcb + (size_t)(32 * ch) * 64, VT_LD, c, g);
                const float dist0 = dq - 16.f * (float)(32 * ch + 8 * g);
                float x[3][8];
                qk_folded<3>(x, kf, q, sl2, mc, dist0, 16.f);
                if (!__all(dist0 - 7.f * 16.f >= 0.f)) mask_folded<3>(x, dist0, 16.f);
                float a0 = 0.f, a1 = 0.f, a2 = 0.f;
#pragma unroll
                for (int b = 0; b < 3; ++b) {
                    float pj[8];
#pragma unroll
                    for (int j = 0; j < 8; ++j) pj[j] = ex2(x[b][j]) * il[b];
                    a0 += 2.f * (pj[0] + pj[1] + pj[2]) + pj[3];
                    a1 += pj[3] + 2.f * (pj[4] + pj[5] + pj[6]) + pj[7];
                    a2 += pj[7];
                    union { bf16x8_t v; unsigned u[4]; } pk;
#pragma unroll
                    for (int j = 0; j < 4; ++j) pk.u[j] = cvt_pk(pj[2 * j], pj[2 * j + 1]);
#pragma unroll
                    for (int d = 0; d < 4; ++d) st.o[b][d] = MFMA16(vf[d], pk.v, st.o[b][d]);
                }
                a0 += __shfl_xor(a0, 8); a1 += __shfl_xor(a1, 8); a2 += __shfl_xor(a2, 8);
                if (hsel == 0) {
                    const int b0 = 8 * ch + 2 * g;
                    __hip_atomic_fetch_add(imp + tok * 128 + b0, a0, __ATOMIC_RELAXED, __HIP_MEMORY_SCOPE_WORKGROUP);
                    __hip_atomic_fetch_add(imp + tok * 128 + b0 + 1, a1, __ATOMIC_RELAXED, __HIP_MEMORY_SCOPE_WORKGROUP);
                    if (b0 + 2 < 128) __hip_atomic_fetch_add(imp + tok * 128 + b0 + 2, a2, __ATOMIC_RELAXED, __HIP_MEMORY_SCOPE_WORKGROUP);
                }
            }
#pragma unroll
            for (int b = 0; b < 3; ++b) {
                const float sc = GATE(b, 0);
#pragma unroll
                for (int d = 0; d < 4; ++d)
#pragma unroll
                    for (int j = 0; j < 4; ++j) ofl[64 * ((b * 4 + d) * 4 + j)] = st.o[b][d][j] * sc;
            }
        }
        asm volatile("s_waitcnt lgkmcnt(0)" ::: "memory");

        unsigned long long un0 = 0ull, un1 = 0ull;
        for (int tk = 0; tk < 8; ++tk) {
            const int tqk = t0 + tk, cur = tqk >> 6;
            float v0 = imp[tk * 128 + lane], v1 = imp[tk * 128 + 64 + lane];
            const int b0 = lane, b1 = lane + 64;
            v0 = (b0 * 64 > tqk) ? -INFINITY : ((b0 == 0 || b0 == cur || b0 == cur - 1) ? 1e4f : v0);
            v1 = (b1 * 64 > tqk) ? -INFINITY : ((b1 == cur || b1 == cur - 1) ? 1e4f : v1);
            const unsigned k0 = v0 < 0.f ? 0u : __float_as_uint(v0) + 1u, k1 = v1 < 0.f ? 0u : __float_as_uint(v1) + 1u;
            unsigned T = 0u;
            for (int bit = 31; bit >= 0; --bit) {
                const unsigned cand = T | (1u << bit);
                const int cnt = __popcll(__ballot(k0 >= cand)) + __popcll(__ballot(k1 >= cand));
                if (cnt >= 16) T = cand;
            }
            const unsigned long long gt0 = __ballot(k0 > T), gt1 = __ballot(k1 > T), eq0 = __ballot(k0 == T), eq1 = __ballot(k1 == T);
            const int need = 16 - (__popcll(gt0) + __popcll(gt1));
            const unsigned long long below = (1ull << lane) - 1ull;
            const bool s0 = (k0 > T) || ((k0 == T) && (__popcll(eq0 & below) < need));
            const bool s1 = (k1 > T) || ((k1 == T) && (__popcll(eq0) + __popcll(eq1 & below) < need));
            const unsigned long long m0 = __ballot(s0), m1 = __ballot(s1);
            un0 |= m0; un1 |= m1;
            if (lane == 0) { selm[tk * 4 + 0] = (unsigned)m0; selm[tk * 4 + 1] = (unsigned)(m0 >> 32); selm[tk * 4 + 2] = (unsigned)m1; selm[tk * 4 + 3] = (unsigned)(m1 >> 32); }
        }
        asm volatile("s_waitcnt lgkmcnt(0)" ::: "memory");
        const unsigned sm0 = selm[tok * 4 + 0], sm1 = selm[tok * 4 + 1], sm2 = selm[tok * 4 + 2], sm3 = selm[tok * 4 + 3];

        {
            Stream<3> st; st.reset2();
            const bf16_t* kb = p.kts + (size_t)nk * 64 * S;
            const bf16_t* vb = p.vts + (size_t)nk * 64 * S;
            const int bmax = (t0 + 7) >> 6;
            LAS int* chl = (LAS int*)imp;
            int nchk = 0;
            for (int blk = bmax; blk >= 0; --blk) {
                const bool inun = blk < 64 ? ((un0 >> blk) & 1ull) : ((un1 >> (blk - 64)) & 1ull);
                if (!inun) continue;
                if (blk * 64 + 32 <= t0 + 7) { if (lane == 0) chl[nchk] = blk * 64 + 32; ++nchk; }
                if (lane == 0) chl[nchk] = blk * 64; ++nchk;
            }
            asm volatile("s_waitcnt lgkmcnt(0)" ::: "memory");
            if (nchk > 0) {
                bf16x8_t kf[2][2], vf[4];
                int k0 = __builtin_amdgcn_readfirstlane(chl[0]);
                load_kt(kf, kb + (size_t)k0 * 64, c, g);
                for (int ci = 0; ci < nchk; ++ci) {
                    const int kn = ci + 1 < nchk ? __builtin_amdgcn_readfirstlane(chl[ci + 1]) : 0;
                    load_v(vf, vb + (size_t)k0 * 64, VT_LD, c, g);
                    const int blk = k0 >> 6;
                    const unsigned w = blk < 32 ? sm0 : (blk < 64 ? sm1 : (blk < 96 ? sm2 : sm3));
                    const bool ok = (w >> (blk & 31)) & 1u;
                    chunk_attend_pf<3>(st, kf, vf, q, sl2, (float)(tq - k0 - 8 * g), 1.f, 1e30f, ok, ci + 1 < nchk,
                                       [&](bf16x8_t (&kfn)[2][2]) { load_kt(kfn, kb + (size_t)kn * 64, c, g); });
                    k0 = kn;
                }
            }
#pragma unroll
            for (int b = 0; b < 3; ++b) {
                const float lt = xsum4(st.l[b]); const float sc = lt > 0.f ? GATE(b, 1) / lt : 0.f;
#pragma unroll
                for (int d = 0; d < 4; ++d)
#pragma unroll
                    for (int j = 0; j < 4; ++j) ofl[64 * ((b * 4 + d) * 4 + j)] += st.o[b][d][j] * sc;
            }
        }
        {
            Stream<3> st; st.reset2();
            const bf16_t* kb = p.ktw + (size_t)nk * 64 * S;
            const bf16_t* vb = p.vtw + (size_t)nk * 64 * S;
            const int klo = (t0 - 512 > 0 ? t0 - 512 : 0) & ~31;
            {
                bf16x8_t kf[2][2], vf[4];
                int k0 = (t0 + 7) & ~31;
                load_kt(kf, kb + (size_t)k0 * 64, c, g);
                for (; k0 >= klo; k0 -= 32) {
                    load_v(vf, vb + (size_t)k0 * 64, VT_LD, c, g);
                    const int kn = k0 - 32;
                    chunk_attend_pf<3>(st, kf, vf, q, sl2, (float)(tq - k0 - 8 * g), 1.f, 512.f, true, kn >= klo,
                                       [&](bf16x8_t (&kfn)[2][2]) { load_kt(kfn, kb + (size_t)kn * 64, c, g); });
                }
            }
#pragma unroll
            for (int b = 0; b < 3; ++b) {
                const float lt = xsum4(st.l[b]); const float sc = lt > 0.f ? GATE(b, 2) / lt : 0.f;
                const int hd = kv * 6 + 2 * b + hsel;
#pragma unroll
                for (int d = 0; d < 4; ++d) {
                    float of[4];
#pragma unroll
                    for (int j = 0; j < 4; ++j) of[j] = ofl[64 * ((b * 4 + d) * 4 + j)] + st.o[b][d][j] * sc;
                    const int col = hd * 64 + 16 * d + 4 * g;
                    const uint2 gm = *(const uint2*)(p.proj + rowq * WP + 1572 + col);
                    const float g0 = __uint_as_float(gm.x << 16), g1 = __uint_as_float(gm.x & 0xffff0000u), g2 = __uint_as_float(gm.y << 16), g3 = __uint_as_float(gm.y & 0xffff0000u);
                    uint2 o; o.x = cvt_pk(of[0] * silu_f(g0), of[1] * silu_f(g1)); o.y = cvt_pk(of[2] * silu_f(g2), of[3] * silu_f(g3));
                    *(uint2*)(p.z + rowq * 1024 + col) = o;
                }
            }
        }
        asm volatile("s_waitcnt lgkmcnt(0)" ::: "memory");
#undef GATE
    }
}

constexpr int NXB = 4;
__device__ __forceinline__ void cross_unit(const Params& p, int i, int n, int h, size_t rowq0, int qoff, int goff, int zld, int zoff, int c, int g) {
    bf16x8_t q[NXB][2];
#pragma unroll
    for (int b = 0; b < NXB; ++b)
#pragma unroll
        for (int ks = 0; ks < 2; ++ks) q[b][ks] = scale_q(*(const bf16x8_t*)(p.proj + (rowq0 + 16 * b) * WP + qoff + h * 64 + 32 * ks + 8 * g));
    float sl2[NXB];
#pragma unroll
    for (int b = 0; b < NXB; ++b) sl2[b] = 0.f;
    Stream<NXB> st; st.reset2();
    const bf16_t* kb = p.mkb + (((size_t)i * NB + n) * 4 + h) * NM * 64;
    const bf16_t* vb = p.mvt + (((size_t)i * NB + n) * 4 + h) * 64 * NM;
    {
        bf16x8_t kf[2][2], vf[4];
        load_kt(kf, kb + (size_t)(NM - 32) * 64, c, g);
        for (int k0 = NM - 32; k0 >= 0; k0 -= 32) {
            load_v(vf, vb + (size_t)k0 * 64, VT_LD, c, g);
            const int kn = k0 - 32;
            chunk_attend_pf<NXB>(st, kf, vf, q, sl2, 0.f, 0.f, 1e30f, true, kn >= 0, [&](bf16x8_t (&kfn)[2][2]) { load_kt(kfn, kb + (size_t)kn * 64, c, g); });
        }
    }
#pragma unroll
    for (int b = 0; b < NXB; ++b) {
        const size_t rowq = rowq0 + 16 * b;
        const float lt = xsum4(st.l[b]); const float il = 1.0f / lt;
#pragma unroll
        for (int d = 0; d < 4; ++d) {
            const int col = h * 64 + 16 * d + 4 * g;
            const uint2 gm = *(const uint2*)(p.proj + rowq * WP + goff + col);
            const float g0 = __uint_as_float(gm.x << 16), g1 = __uint_as_float(gm.x & 0xffff0000u), g2 = __uint_as_float(gm.y << 16), g3 = __uint_as_float(gm.y & 0xffff0000u);
            uint2 o; o.x = cvt_pk(st.o[b][d][0] * il * silu_f(g0), st.o[b][d][1] * il * silu_f(g1)); o.y = cvt_pk(st.o[b][d][2] * il * silu_f(g2), st.o[b][d][3] * il * silu_f(g3));
            *(uint2*)(p.z + rowq * zld + zoff + col) = o;
        }
    }
}

__device__ __forceinline__ void fast_cross_q(const Params& p, int i, int qoff, int goff, int zld, int zoff, int cslot = 1) {
    int tid_l = threadIdx.x; asm volatile("" : "+v"(tid_l));
    const int lane = tid_l & 63, wid = __builtin_amdgcn_readfirstlane(tid_l >> 6), c = lane & 15, g = lane >> 4;
    unsigned* ctr = p.bar + WQ_BASE + 16 * (i * 4 + cslot);
    constexpr int XT = S / (16 * NXB);
    for (;;) {
        const int u = wq_next(ctr, lane);
        if (u >= NB * 4 * XT) break;
        const int tile = u % XT, nh = u / XT, n = nh >> 2, h = nh & 3;
        cross_unit(p, i, n, h, (size_t)(n * S + tile * 16 * NXB + c), qoff, goff, zld, zoff, c, g);
    }
}
__device__ __forceinline__ void fast_cross_b(const Params& p, int i, int cslot = 1) { fast_cross_q(p, i, 2340, 2596, 1024, 768, cslot); }
__device__ __forceinline__ void fast_cross_a(const Params& p, int i, int cslot = 1) { fast_cross_q(p, i, 2560, 2816, 512, 256, cslot); }

constexpr int NBA = 2;
static_assert((S / 256) % NBA == 0, "block groups");
static_assert(NB * 4 * (S / 16 / NBA) >= CONV_NITEMS, "attention units vs conversion items");
__device__ __forceinline__ void fast_attn_a(const Params& p, int i, bool with_conv, int cslot = 0) {
    int tid_l = threadIdx.x; asm volatile("" : "+v"(tid_l));
    const int lane = tid_l & 63, wid = __builtin_amdgcn_readfirstlane(tid_l >> 6), c = lane & 15, g = lane >> 4;
    unsigned* ctr = p.bar + WQ_BASE + 16 * (i * 4 + cslot);
    constexpr int CPU_ = S / 16 / NBA, NATT = NB * 4 * CPU_;
    const int nconv = with_conv ? CONV_NITEMS : 0;
    for (;;) {
        const int id = wq_next(ctr, lane);
        if (id >= NATT + nconv) break;
        int u;
        if (id < 2 * nconv) { if ((id & 1) == 0) { conv_item(p, id >> 1, lane); continue; } u = id >> 1; } else u = id - nconv;
        const int cgp = u % CPU_, nh = u / CPU_, n = nh >> 2, h = nh & 3;
        const int bp = cgp >> 4, r16 = cgp & 15;
        const int tq0 = bp * (NBA * 256) + r16 + 16 * c;
        const size_t rowq0 = (size_t)(n * S + tq0);
        Stream<NBA> st; st.reset2();
#pragma unroll 1
        for (int gi = 0; gi < 3; ++gi) {
            const int d = dil_of(gi), r = r16 % d, U = S / d;
            bf16x8_t q[NBA][2];
#pragma unroll
            for (int b = 0; b < NBA; ++b)
#pragma unroll
                for (int ks = 0; ks < 2; ++ks) q[b][ks] = scale_q(*(const bf16x8_t*)(p.proj + (rowq0 + 256 * b) * WP + gi * 256 + h * 64 + 32 * ks + 8 * g));
            const float sl2 = slope_a(gi, h) * (float)d * LOG2E;
            const int uq0 = tq0 / d, ustep = 256 / d;
            const int umin = (bp * (NBA * 256) + r16) / d, umax = (bp * (NBA * 256) + (NBA - 1) * 256 + r16 + 240) / d;
            const int ulo = (umin - 128 > 0 ? umin - 128 : 0) & ~31;
            const bf16_t* kb = p.kta + ((((size_t)gi * NB + n) * 4 + h) * 64) * S + (size_t)r * U * 64;
            const bf16_t* vb = p.vta + ((((size_t)gi * NB + n) * 4 + h) * 64) * S + (size_t)r * U * 64;
            chunk_loop(umax & ~31, ulo,
                [&](int uk0, bf16x8_t (&kf)[2][2], bf16x8_t (&vf)[4]) { load_kt(kf, kb + (size_t)uk0 * 64, c, g); load_v(vf, vb + (size_t)uk0 * 64, VT_LD, c, g); },
                [&](int uk0, const bf16x8_t (&kf)[2][2], const bf16x8_t (&vf)[4]) {
                    float dist0[NBA];
#pragma unroll
                    for (int b = 0; b < NBA; ++b) dist0[b] = (float)(uq0 + b * ustep - uk0 - 8 * g);
                    chunk_attend_mb<NBA>(st, kf, vf, q, sl2, dist0, 128.f);
                });
        }
#pragma unroll
        for (int b = 0; b < NBA; ++b) {
            const size_t rowq = rowq0 + 256 * b;
            const float lt = xsum4(st.l[b]); const float il = 1.0f / lt;
#pragma unroll
            for (int dd = 0; dd < 4; ++dd) {
                const int col = h * 64 + 16 * dd + 4 * g;
                const uint2 gm = *(const uint2*)(p.proj + rowq * WP + 2304 + col);
                const float g0 = __uint_as_float(gm.x << 16), g1 = __uint_as_float(gm.x & 0xffff0000u), g2 = __uint_as_float(gm.y << 16), g3 = __uint_as_float(gm.y & 0xffff0000u);
                uint2 o; o.x = cvt_pk(st.o[b][dd][0] * il * silu_f(g0), st.o[b][dd][1] * il * silu_f(g1)); o.y = cvt_pk(st.o[b][dd][2] * il * silu_f(g2), st.o[b][dd][3] * il * silu_f(g3));
                *(uint2*)(p.z + rowq * 512 + col) = o;
            }
        }
    }
}

constexpr int PB_S = NS * 2 * HB_S / 256;
struct BatchOrder {
    int G, c, L0, L1;
    __device__ __forceinline__ bool next(int i, pg8::Unit& u) const { const int L = L0 + i * G + c; if (L >= L1) return false; u.pm = L; u.pn = L / PB_S; return true; }
    __device__ __forceinline__ void a_ready(const pg8::Unit&) const {}
    __device__ __forceinline__ void done(const pg8::Unit&) const {}
};
struct EpiPQ {
    static constexpr bool PERM = true, AFTER_DRAIN = false;
    bf16_t* O;
    __device__ __forceinline__ void operator()(const pg8::f32x4 (&acc)[2][2][4][2], const pg8::Unit& u, int wr, int wc, int fr, int fq) const {
        const int row0 = u.pm * 256 + wr * 64 + fr, col0 = wc * 32 + 8 * fq;
#pragma unroll
        for (int ai = 0; ai < 2; ++ai)
#pragma unroll
            for (int m = 0; m < 4; ++m) {
                bf16_t* rowp = O + (size_t)(row0 + ai * 128 + m * 16) * 256 + col0;
#pragma unroll
                for (int bj = 0; bj < 2; ++bj) {
                    const pg8::f32x4 v0 = acc[ai][bj][m][0], v1 = acc[ai][bj][m][1];
                    pg8::u32x4 w; w.x = pg8::cvt_pk_bf16(v0[0], v0[1]); w.y = pg8::cvt_pk_bf16(v0[2], v0[3]); w.z = pg8::cvt_pk_bf16(v1[0], v1[1]); w.w = pg8::cvt_pk_bf16(v1[2], v1[3]);
                    *(pg8::u32x4*)(rowp + bj * 128) = w;
                }
            }
    }
};
__device__ __forceinline__ void fast_pq_s(const Params& p, LAS unsigned char* lds, int li) {
    pg8::Gemm g; g.A = p.cachec; g.Bt = p.w1pq; g.M = 4 * PB_S * 256; g.N = 1024; g.K = 1024;
    BatchOrder so; so.G = gridDim.x; so.c = blockIdx.x; so.L0 = li * 2 * PB_S; so.L1 = (li + 1) * 2 * PB_S;
    EpiPQ E; E.O = p.pq_s;
    pg8::gemm_phase<EpiPQ, BatchOrder, false>(lds, g, so, E, nullptr);
}
__device__ __forceinline__ void fast_pq_p(const Params& p, int li) {
    int tid_l = threadIdx.x; asm volatile("" : "+v"(tid_l));
    const int lane = tid_l & 63, wid = __builtin_amdgcn_readfirstlane(tid_l >> 6);
    const int gw = blockIdx.x * (NTHREADS / 64) + wid, nw = gridDim.x * (NTHREADS / 64);
    constexpr int RT = HB_P / 16;
    for (int u = gw; u < 2 * NB * 2 * RT * 8; u += nw) {
        const int cg = u % 8, rt = (u / 8) % RT, nk = (u / (8 * RT)) % (NB * 2), ty = u / (8 * RT * NB * 2), n = nk >> 1, kv = nk & 1;
        float v[8];
        wave_tile_32x16(p.proj + (size_t)(n * S) * WP + 768 + ty * 128 + kv * 64, (size_t)16 * WP, p.w1pq + (size_t)(li * 2 + ty) * 256 * 1024, 1024, rt * 16, cg * 32, 1024, v, lane, WP);
        st8_bf(p.pq_p + (((size_t)ty * NB * 2 + nk) * HB_P + rt * 16 + (lane & 15)) * 256 + cg * 32 + 8 * (lane >> 4), v);
    }
}
template <bool TILED> __device__ __forceinline__ void cmpc_tile(const bf16_t* pq, const float* cb, const bf16_t* w2t, int c0, bool is_v, bf16_t* kout, bf16_t* vout, int lane) {
    const int m = lane & 15, g = lane >> 4;
    bf16x8_t hf[4];
#pragma unroll
    for (int ks = 0; ks < 4; ++ks) {
        const int j0 = 32 * ks + 8 * g;
        float a[8], b[8]; ld8(pq + (size_t)(c0 + m) * 256 + j0, a); ld8(pq + (size_t)(c0 + m + 1) * 256 + 128 + j0, b);
        union { bf16x8_t v; unsigned u[4]; } pk;
#pragma unroll
        for (int j = 0; j < 4; ++j) pk.u[j] = cvt_pk(silu_f(a[2 * j] + b[2 * j] + cb[j0 + 2 * j]), silu_f(a[2 * j + 1] + b[2 * j + 1] + cb[j0 + 2 * j + 1]));
        hf[ks] = pk.v;
    }
#pragma unroll
    for (int eb = 0; eb < 4; ++eb) {
        f32x4_t d = {0.f, 0.f, 0.f, 0.f};
#pragma unroll
        for (int ks = 0; ks < 4; ++ks) {
            const bf16x8_t wf = *(const bf16x8_t*)(w2t + (size_t)(16 * eb + m) * 128 + 32 * ks + 8 * g);
            d = is_v ? MFMA16(hf[ks], wf, d) : MFMA16(wf, hf[ks], d);
        }
        uint2 o; o.x = cvt_pk(d[0], d[1]); o.y = cvt_pk(d[2], d[3]);
        if (TILED) {
            if (is_v) *(uint2*)(vout + vt_pos(c0 + 4 * g) + (16 * eb + m) * VT_LD) = o;
            else *(uint2*)(kout + kt_pos(c0 + m, 16 * eb + 4 * g)) = o;
        } else {
            if (is_v) *(uint2*)(vout + (size_t)(16 * eb + m) * CSTR + c0 + 4 * g) = o;
            else *(uint2*)(kout + (size_t)(c0 + m) * 64 + 16 * eb + 4 * g) = o;
        }
    }
}
__device__ __forceinline__ void fast_cmpc_s(const Params& p, int lsel, unsigned* ctr = nullptr) {
    int tid_l = threadIdx.x; asm volatile("" : "+v"(tid_l));
    const int lane = tid_l & 63, wid = __builtin_amdgcn_readfirstlane(tid_l >> 6);
    const int gw = blockIdx.x * (NTHREADS / 64) + wid, nw = gridDim.x * (NTHREADS / 64);
    constexpr int NU = 2 * NS * 2 * (CSTR / 16);
    for (int u = ctr ? wq_next(ctr, lane) : gw; u < NU; u = ctr ? wq_next(ctr, lane) : u + nw) {
        const int ct = u % (CSTR / 16), nk = (u / (CSTR / 16)) % (NS * 2), lt = lsel * 2 + u / ((CSTR / 16) * NS * 2), li = lt >> 1, ty = lt & 1;
        cmpc_tile<false>(p.pq_s + ((size_t)lt * NS * 2 + nk) * HB_S * 256, p.cb + lt * 128, p.w2t + (size_t)lt * 64 * 128, ct * 16, ty == 1,
                  p.kcmp_s + ((size_t)li * NS * 2 + nk) * CSTR * 64, p.vcmpt_s + ((size_t)li * NS * 2 + nk) * 64 * CSTR, lane);
    }
}
__device__ __forceinline__ void fast_cmpc_p(const Params& p, int li) {
    int tid_l = threadIdx.x; asm volatile("" : "+v"(tid_l));
    const int lane = tid_l & 63, wid = __builtin_amdgcn_readfirstlane(tid_l >> 6);
    const int gw = blockIdx.x * (NTHREADS / 64) + wid, nw = gridDim.x * (NTHREADS / 64);
    for (int u = gw; u < 2 * NB * 2 * (CSTR / 16); u += nw) {
        const int ct = u % (CSTR / 16), nk = (u / (CSTR / 16)) % (NB * 2), ty = u / ((CSTR / 16) * NB * 2), lt = li * 2 + ty;
        cmpc_tile<true>(p.pq_p + ((size_t)ty * NB * 2 + nk) * HB_P * 256, p.cb + lt * 128, p.w2t + (size_t)lt * 64 * 128, ct * 16, ty == 1,
                  p.kcmp + (size_t)nk * CSTR * 64, p.vcmpt + (size_t)nk * 64 * CSTR, lane);
    }
}


__device__ __forceinline__ float wave_max(float v) {
#pragma unroll
    for (int o = 32; o > 0; o >>= 1) v = fmaxf(v, __shfl_xor(v, o));
    return v;
}
__device__ __forceinline__ float dot_qf(const float* k, const float (&q)[64]) { float a = 0.f; DOT64_F(a, q, k); return a; }
__device__ __forceinline__ float dot_qb(const bf16_t* k, const float (&q)[64]) { float a = 0.f; DOT64_B(a, q, k); return a; }
#define LDS_SYNC_WAVE() asm volatile("s_waitcnt lgkmcnt(0)" ::: "memory")


__device__ __forceinline__ void pv4_f32(float4& acc, const float* vb, size_t vstride, const LAS float* pl, int nkeys, int lane) {
    const int kq = lane >> 4, dq = lane & 15;
    const float* v = vb + (size_t)kq * vstride + 4 * dq;
#pragma unroll 16
    for (int k = kq; k < nkeys; k += 4) {
        const float4 x = *(const float4*)v; const float pr = pl[k];
        acc.x += pr * x.x; acc.y += pr * x.y; acc.z += pr * x.z; acc.w += pr * x.w;
        v += 4 * vstride;
    }
}
__device__ __forceinline__ void pv4_reduce(float4& a) {
    a.x = xsum4(a.x); a.y = xsum4(a.y); a.z = xsum4(a.z); a.w = xsum4(a.w);
}
__device__ __forceinline__ void pv4_bf16_row(float4& acc, const bf16_t* vrow, float pr, int lane) {
    if ((lane >> 4) == 0) {
        const uint2 u = *(const uint2*)(vrow + 4 * (lane & 15));
        acc.x += pr * __uint_as_float(u.x << 16); acc.y += pr * __uint_as_float(u.x & 0xffff0000u); acc.z += pr * __uint_as_float(u.y << 16); acc.w += pr * __uint_as_float(u.y & 0xffff0000u);
    }
}
__device__ __forceinline__ void store4_gated(bf16_t* zdst, const bf16_t* gate, const float4& a, float scale, int lane) {
    if ((lane >> 4) == 0) {
        const int dq = lane & 15;
        const uint2 gm = *(const uint2*)(gate + 4 * dq);
        const float g0 = __uint_as_float(gm.x << 16), g1 = __uint_as_float(gm.x & 0xffff0000u), g2 = __uint_as_float(gm.y << 16), g3 = __uint_as_float(gm.y & 0xffff0000u);
        uint2 o; o.x = cvt_pk(a.x * scale * silu_f(g0), a.y * scale * silu_f(g1)); o.y = cvt_pk(a.z * scale * silu_f(g2), a.w * scale * silu_f(g3));
        *(uint2*)(zdst + 4 * dq) = o;
    }
}

__device__ __forceinline__ void dec_cross(const Params& p, int i, int n, int h, int qoff, int goff, int zld, int zoff, LAS float* sb, int lane) {
    const size_t row = (size_t)(MP + n);
    float q[64]; LD64_B(q, p.proj + row * WP + qoff + h * 64);
    const float* kb = p.cache_mem_kv + ((size_t)i * NS + n) * NM * 512 + h * 64;
    float mx = -INFINITY;
    for (int m = lane; m < NM; m += 64) { const float x = dot_qf(kb + (size_t)m * 512, q) * C1; sb[m] = x; mx = fmaxf(mx, x); }
    mx = wave_max(mx);
    LDS_SYNC_WAVE();
    float l = 0.f;
    for (int m = lane; m < NM; m += 64) { const float e = ex2(sb[m] - mx); sb[m] = e; l += e; }
    l = wave_sum(l);
    LDS_SYNC_WAVE();
    float4 o = make_float4(0.f, 0.f, 0.f, 0.f);
    pv4_f32(o, kb + 256, 512, sb, NM, lane);
    pv4_reduce(o);
    LDS_SYNC_WAVE();
    store4_gated(p.z + row * zld + zoff + h * 64, p.proj + row * WP + goff + h * 64, o, 1.0f / l, lane);
}

__device__ __forceinline__ void fast_dec_a(const Params& p, int i, LAS unsigned char* lds) {
    int tid_l = threadIdx.x; asm volatile("" : "+v"(tid_l));
    const int lane = tid_l & 63, wid = __builtin_amdgcn_readfirstlane(tid_l >> 6), li = i >> 1;
    LAS float* sb = (LAS float*)(lds + wid * 16640);
    const int part = wid & 3;
    for (int u = blockIdx.x; u < NS * 2; u += gridDim.x) {
        const int unit = 2 * u + (wid >> 2), n = unit >> 2, h = unit & 3;
        const size_t row = (size_t)(MP + n);
        if (part < 3) {
            const int g = part, d = dil_of(g), lb = lb_of(g);
            const float sl2 = slope_a(g, h) * LOG2E;
            const float* cache = (g == 0 ? +p.cache_a0 : (g == 1 ? +p.cache_a1 : +p.cache_a2)) + ((size_t)li * NS + n) * lb * 512 + h * 64;
            float q[64]; LD64_B(q, p.proj + row * WP + g * 256 + h * 64);
            const float x0 = dot_qb(p.proj + row * WP + 768 + g * 256 + h * 64, q) * C1;
            const int jmax = (lb / d) < 128 ? (lb / d) : 128;
            float x1 = -INFINITY, x2 = -INFINITY;
            { const int j = 1 + lane; if (j <= jmax) x1 = dot_qf(cache + (size_t)(lb - j * d) * 512, q) * C1 - sl2 * (float)(j * d); }
            { const int j = 65 + lane; if (j <= jmax) x2 = dot_qf(cache + (size_t)(lb - j * d) * 512, q) * C1 - sl2 * (float)(j * d); }
            const float mx = wave_max(fmaxf(x0, fmaxf(x1, x2)));
            const float e1 = ex2(x1 - mx), e2 = ex2(x2 - mx), e0 = ex2(x0 - mx);
            sb[lane] = e1; sb[64 + lane] = e2;
            const float l = wave_sum(e1 + e2) + e0;
            LDS_SYNC_WAVE();
            float4 o = make_float4(0.f, 0.f, 0.f, 0.f);
            pv4_bf16_row(o, p.proj + row * WP + 1536 + g * 256 + h * 64, e0, lane);
            pv4_f32(o, cache + 256 + (size_t)(lb - d) * 512, (size_t)0 - (size_t)d * 512, sb, jmax, lane);
            pv4_reduce(o);
            LDS_SYNC_WAVE();
            if ((lane >> 4) == 0) { sb[256 + 4 * (lane & 15) + 0] = o.x; sb[256 + 4 * (lane & 15) + 1] = o.y; sb[256 + 4 * (lane & 15) + 2] = o.z; sb[256 + 4 * (lane & 15) + 3] = o.w; }
            if (lane == 0) { sb[320] = mx; sb[321] = l; }
        } else {
            dec_cross(p, i, n, h, 2560, 2816, 512, 256, sb, lane);
        }
        __syncthreads();
        if (part == 0) {
            const LAS float* s0 = (const LAS float*)(lds + (wid + 0) * 16640), *s1 = (const LAS float*)(lds + (wid + 1) * 16640), *s2 = (const LAS float*)(lds + (wid + 2) * 16640);
            const float m0 = s0[320], m1 = s1[320], m2 = s2[320], mm = fmaxf(m0, fmaxf(m1, m2));
            const float w0 = ex2(m0 - mm), w1 = ex2(m1 - mm), w2 = ex2(m2 - mm);
            const float l = s0[321] * w0 + s1[321] * w1 + s2[321] * w2;
            const float o = s0[256 + lane] * w0 + s1[256 + lane] * w1 + s2[256 + lane] * w2;
            p.z[row * 512 + h * 64 + lane] = f2bf(o / l * silu_f(bf2f(p.proj[row * WP + 2304 + h * 64 + lane])));
        }
        __syncthreads();
    }
}
__device__ __forceinline__ void fast_dec_cross_b(const Params& p, int i, LAS unsigned char* lds) {
    int tid_l = threadIdx.x; asm volatile("" : "+v"(tid_l));
    const int lane = tid_l & 63, wid = __builtin_amdgcn_readfirstlane(tid_l >> 6);
    LAS float* sb = (LAS float*)(lds + wid * 16640);
    const int gw = wid * gridDim.x + (gridDim.x - 1 - blockIdx.x), nw = gridDim.x * (NTHREADS / 64);
    for (int u = gw; u < NS * 4; u += nw) dec_cross(p, i, u >> 2, u & 3, 2340, 2596, 1024, 768, sb, lane);
}

__device__ __forceinline__ void fast_dec_nsa(const Params& p, int i, LAS unsigned char* lds) {
    int tid_l = threadIdx.x; asm volatile("" : "+v"(tid_l));
    const int lane = tid_l & 63, wid = __builtin_amdgcn_readfirstlane(tid_l >> 6), li = i >> 1;
    static_assert(NSEL_S == 129 && NC_S == 511 && PL % 128 == 0 && LBW == 512, "decode NSA is written for PAST_LEN 8192");
    LAS float* sb = (LAS float*)(lds + wid * 16640);
    LAS float* pcw = (LAS float*)(lds + wid * 16640 + 8192);
    LAS int* sel = (LAS int*)(lds + 8 * 16640 - 1024);
    for (int u = blockIdx.x; u < NS * 2; u += gridDim.x) {
        const int n = u >> 1, kv = u & 1, hd = kv * 6 + wid;
        const size_t row = (size_t)(MP + n);
        const bool act = wid < 6;
        const float sl2 = slope_b(act ? hd : 0) * LOG2E;
        float q[64]; LD64_B(q, p.proj + row * WP + (act ? hd : 0) * 64);
        float oacc = 0.f; float4 oacc4 = make_float4(0.f, 0.f, 0.f, 0.f);
        if (act) {
            const bf16_t* kb = p.kcmp_s + ((size_t)li * NS * 2 + n * 2 + kv) * CSTR * 64;
            const bf16_t* vb = p.vcmpt_s + ((size_t)li * NS * 2 + n * 2 + kv) * 64 * CSTR + (size_t)lane * CSTR;
            float mx = -INFINITY;
#pragma unroll 2
            for (int c = lane; c < 512; c += 64) {
                float x = dot_qb(kb + (size_t)c * 64, q) * C1 - sl2 * (float)(PL - (16 * c + 31));
                if (c >= NC_S) x = -INFINITY;
                sb[c] = x; mx = fmaxf(mx, x);
            }
            mx = wave_max(mx);
            LDS_SYNC_WAVE();
            float l = 0.f;
            for (int c = lane; c < 512; c += 64) { const float e = ex2(sb[c] - mx); sb[c] = e; l += e; }
            l = wave_sum(l);
            const float il = 1.0f / l;
            LDS_SYNC_WAVE();
            for (int c = lane; c < 512; c += 64) pcw[c] = sb[c] * il;
            LDS_SYNC_WAVE();
            float o = 0.f;
#pragma unroll 8
            for (int c0 = 0; c0 < 512; c0 += 8) {
                float v[8]; ld8(vb + c0, v);
#pragma unroll
                for (int j = 0; j < 8; ++j) o += pcw[c0 + j] * v[j];
            }
            oacc = o * sigmoid_f(bf2f(p.proj[row * WP + 1536 + hd * 3 + 0]));
            LDS_SYNC_WAVE();
            sb[lane] = oacc;
            LDS_SYNC_WAVE();
            oacc4 = make_float4(sb[4 * (lane & 15)], sb[4 * (lane & 15) + 1], sb[4 * (lane & 15) + 2], sb[4 * (lane & 15) + 3]);
            LDS_SYNC_WAVE();
        }
        __syncthreads();
        if (wid == 6) {
            float v[3]; unsigned k[3];
#pragma unroll
            for (int t = 0; t < 3; ++t) {
                const int b = lane + 64 * t;
                float a = -1.f;
                if (b < NSEL_S) {
                    a = 0.f;
                    for (int w = 0; w < 6; ++w) {
                        const LAS float* pc = (const LAS float*)(lds + w * 16640 + 8192);
#pragma unroll
                        for (int ii = 4 * b; ii < 4 * b + 4; ++ii) { if (ii < 512) a += pc[ii]; if (ii >= 1 && ii - 1 < 512) a += pc[ii - 1]; }
                    }
                    if (b == 0 || b == 128 || b == 127) a = 1e4f;
                }
                v[t] = a; k[t] = a < 0.f ? 0u : __float_as_uint(a) + 1u;
            }
            unsigned T = 0u;
            for (int bit = 31; bit >= 0; --bit) {
                const unsigned cand = T | (1u << bit);
                const int cnt = __popcll(__ballot(k[0] >= cand)) + __popcll(__ballot(k[1] >= cand)) + __popcll(__ballot(k[2] >= cand));
                if (cnt >= 16) T = cand;
            }
            const unsigned long long below = (1ull << lane) - 1ull;
            int base = 0; const int ngt = __popcll(__ballot(k[0] > T)) + __popcll(__ballot(k[1] > T)) + __popcll(__ballot(k[2] > T));
            const int need = 16 - ngt;
            int eqbefore = 0;
#pragma unroll
            for (int t = 0; t < 3; ++t) {
                const unsigned long long eqm = __ballot(k[t] == T);
                const bool s = (k[t] > T) || ((k[t] == T) && (eqbefore + __popcll(eqm & below) < need));
                const unsigned long long sm = __ballot(s);
                if (s) sel[base + __popcll(sm & below)] = lane + 64 * t;
                base += __popcll(sm); eqbefore += __popcll(eqm);
            }
        }
        __syncthreads();
        if (act) {
            const float g1 = sigmoid_f(bf2f(p.proj[row * WP + 1536 + hd * 3 + 1])), g2 = sigmoid_f(bf2f(p.proj[row * WP + 1536 + hd * 3 + 2]));
            const int myb = sel[lane & 15];
            const int mypage = myb < 128 ? p.page_table[n * NPAGES + (myb >> 1)] : 0;
            float mx = -INFINITY;
            for (int s = 0; s < 16; ++s) {
                const int b = __builtin_amdgcn_readlane(myb, s);
                float x = -INFINITY;
                if (b < 128) {
                    const int kp = b * 64 + lane;
                    const int page = __builtin_amdgcn_readlane(mypage, s);
                    x = dot_qf(p.cache_b_pages + ((((size_t)page * 128 + (kp & 127)) * 2 + li) * 4 + 2) * 128 + kv * 64, q) * C1 - sl2 * (float)(PL - kp);
                } else if (lane == 0) x = dot_qb(p.proj + row * WP + 768 + 2 * 128 + kv * 64, q) * C1;
                sb[s * 64 + lane] = x; mx = fmaxf(mx, x);
            }
            mx = wave_max(mx);
            LDS_SYNC_WAVE();
            float l = 0.f;
            for (int e = lane; e < 1024; e += 64) { const float v = ex2(sb[e] - mx); sb[e] = v; l += v; }
            l = wave_sum(l);
            LDS_SYNC_WAVE();
            float4 o = make_float4(0.f, 0.f, 0.f, 0.f);
            for (int s = 0; s < 16; ++s) {
                const int b = __builtin_amdgcn_readlane(myb, s);
                if (b < 128) {
                    const int page = __builtin_amdgcn_readlane(mypage, s);
                    pv4_f32(o, p.cache_b_pages + ((((size_t)page * 128 + (b & 1) * 64) * 2 + li) * 4 + 3) * 128 + kv * 64, 1024, sb + s * 64, 64, lane);
                } else pv4_bf16_row(o, p.proj + row * WP + 768 + 3 * 128 + kv * 64, sb[s * 64], lane);
            }
            pv4_reduce(o);
            { const float sc = g1 / l; oacc4.x += sc * o.x; oacc4.y += sc * o.y; oacc4.z += sc * o.z; oacc4.w += sc * o.w; }
            LDS_SYNC_WAVE();
            const float* wb = p.cache_b_win + ((size_t)li * NS + n) * LBW * 256 + kv * 64;
            mx = -INFINITY;
            for (int idx = lane; idx < 576; idx += 64) {
                float x = -INFINITY;
                if (idx < 512) x = dot_qf(wb + (size_t)idx * 256, q) * C1 - sl2 * (float)(512 - idx);
                else if (idx == 512) x = dot_qb(p.proj + row * WP + 768 + 4 * 128 + kv * 64, q) * C1;
                sb[idx] = x; mx = fmaxf(mx, x);
            }
            mx = wave_max(mx);
            LDS_SYNC_WAVE();
            l = 0.f;
            for (int e = lane; e < 576; e += 64) { const float v = ex2(sb[e] - mx); sb[e] = v; l += v; }
            l = wave_sum(l);
            LDS_SYNC_WAVE();
            o = make_float4(0.f, 0.f, 0.f, 0.f);
            pv4_bf16_row(o, p.proj + row * WP + 768 + 5 * 128 + kv * 64, sb[512], lane);
            pv4_f32(o, wb + 128, 256, sb, 512, lane);
            pv4_reduce(o);
            { const float sc = g2 / l; oacc4.x += sc * o.x; oacc4.y += sc * o.y; oacc4.z += sc * o.z; oacc4.w += sc * o.w; }
            store4_gated(p.z + row * 1024 + hd * 64, p.proj + row * WP + 1572 + hd * 64, oacc4, 1.0f, lane);
        }
        __syncthreads();
    }
}


constexpr int DSTR = 1152;
__device__ __forceinline__ void dot6_store(const float4 (&x)[16], const LAS float* qs, LAS float* dst, int hd0, float dist, bool valid) {
#pragma unroll 1
    for (int h = 0; h < 6; ++h) {
        float a = 0.f;
#pragma unroll
        for (int j = 0; j < 16; ++j) { const f32x4_t q4 = *(const LAS f32x4_t*)(qs + h * 64 + 4 * j); a += x[j].x * q4[0] + x[j].y * q4[1] + x[j].z * q4[2] + x[j].w * q4[3]; }
        dst[h * DSTR] = valid ? a * C1 - slope_b(hd0 + h) * LOG2E * dist : -INFINITY;
    }
}
__device__ __forceinline__ void ld_row_f32(const float* r, float4 (&x)[16]) {
#pragma unroll
    for (int j = 0; j < 16; ++j) x[j] = *(const float4*)(r + 4 * j);
}
__device__ __forceinline__ void ld_row_b16(const bf16_t* r, float4 (&x)[16]) {
#pragma unroll
    for (int j = 0; j < 8; ++j) {
        const uint4 u = *(const uint4*)(r + 8 * j);
        x[2 * j] = make_float4(__uint_as_float(u.x << 16), __uint_as_float(u.x & 0xffff0000u), __uint_as_float(u.y << 16), __uint_as_float(u.y & 0xffff0000u));
        x[2 * j + 1] = make_float4(__uint_as_float(u.z << 16), __uint_as_float(u.z & 0xffff0000u), __uint_as_float(u.w << 16), __uint_as_float(u.w & 0xffff0000u));
    }
}
__device__ __forceinline__ float dec_softmax(LAS float* sch, int nk, bool norm, int lane) {
    float mx = -INFINITY;
    for (int k = lane; k < nk; k += 64) mx = fmaxf(mx, sch[k]);
    mx = wave_max(mx);
    float l = 0.f;
    for (int k = lane; k < nk; k += 64) { const float e = ex2(sch[k] - mx); sch[k] = e; l += e; }
    l = wave_sum(l);
    LDS_SYNC_WAVE();
    if (norm) { const float il = 1.0f / l; for (int k = lane; k < nk; k += 64) sch[k] *= il; }
    return l;
}
__device__ __forceinline__ void fast_dec_nsa3(const Params& p, int i, LAS unsigned char* lds) {
    int tid = threadIdx.x; asm volatile("" : "+v"(tid));
    const int lane = tid & 63, wid = __builtin_amdgcn_readfirstlane(tid >> 6), li = i >> 1;
    static_assert(NSEL_S == 129 && NC_S == 511 && PL % 128 == 0 && LBW == 512 && NTHREADS == 512, "decode NSA is written for PAST_LEN 8192 and 512 threads");
    LAS float* qs = (LAS float*)lds;
    LAS float* sc = (LAS float*)(lds + 2048);
    LAS float* part = (LAS float*)(lds + 30720);
    LAS int* sel = (LAS int*)(lds + 43008);
    LAS int* pgs = sel + 16;
    LAS float* lsum = (LAS float*)(lds + 43264);
#define DEC_OPAQUE_TID() int tid_s = tid; asm volatile("" : "+v"(tid_s)); const int lane_s = tid_s & 63, kq = lane_s >> 4, dq = lane_s & 15; (void)kq; (void)dq
    for (int u = blockIdx.x; u < NS * 2; u += gridDim.x) {
        const int n = u >> 1, kv = u & 1;
        const size_t row = (size_t)(MP + n);
        const int myh = tid >> 6, myd = tid & 63;
        __syncthreads();
        if (tid < 384) qs[tid] = bf2f(p.proj[row * WP + (kv * 6 + myh) * 64 + myd]);
        __syncthreads();
        float oacc = 0.f;
        float4 x[16];
        {
            DEC_OPAQUE_TID();
            const bf16_t* kb = p.kcmp_s + ((size_t)li * NS * 2 + n * 2 + kv) * CSTR * 64;
            ld_row_b16(kb + (size_t)tid_s * 64, x);
            dot6_store(x, qs, sc + tid_s, kv * 6, (float)(PL - (16 * tid_s + 31)), tid_s < NC_S);
        }
        __syncthreads();
        if (wid < 6) (void)dec_softmax(sc + wid * DSTR, 512, true, lane);
        __syncthreads();
        {
            DEC_OPAQUE_TID();
            const bf16_t* vb = p.vcmpt_s + ((size_t)li * NS * 2 + n * 2 + kv) * 64 * CSTR + (size_t)lane_s * CSTR + wid * 64;
            float a[6] = {0.f, 0.f, 0.f, 0.f, 0.f, 0.f};
#pragma unroll 1
            for (int hf = 0; hf < 2; ++hf) {
                float v[32];
#pragma unroll
                for (int j = 0; j < 4; ++j) ld8(vb + 32 * hf + 8 * j, v + 8 * j);
#pragma unroll
                for (int c = 0; c < 32; ++c) {
#pragma unroll
                    for (int h = 0; h < 6; ++h) a[h] += sc[h * DSTR + wid * 64 + 32 * hf + c] * v[c];
                }
            }
#pragma unroll
            for (int h = 0; h < 6; ++h) part[(wid * 6 + h) * 64 + lane_s] = a[h];
        }
        if (wid == 7) {
            unsigned k[3];
#pragma unroll
            for (int t = 0; t < 3; ++t) {
                const int b = lane + 64 * t;
                float a = -1.f;
                if (b < NSEL_S) {
                    a = 0.f;
                    for (int w = 0; w < 6; ++w) {
                        const LAS float* pc = sc + w * DSTR;
#pragma unroll
                        for (int ii = 4 * b; ii < 4 * b + 4; ++ii) { if (ii < 512) a += pc[ii]; if (ii >= 1 && ii - 1 < 512) a += pc[ii - 1]; }
                    }
                    if (b == 0 || b == 128 || b == 127) a = 1e4f;
                }
                k[t] = a < 0.f ? 0u : __float_as_uint(a) + 1u;
            }
            unsigned T = 0u;
            for (int bit = 31; bit >= 0; --bit) {
                const unsigned cand = T | (1u << bit);
                const int cnt = __popcll(__ballot(k[0] >= cand)) + __popcll(__ballot(k[1] >= cand)) + __popcll(__ballot(k[2] >= cand));
                if (cnt >= 16) T = cand;
            }
            const unsigned long long below = (1ull << lane) - 1ull;
            int base = 0; const int ngt = __popcll(__ballot(k[0] > T)) + __popcll(__ballot(k[1] > T)) + __popcll(__ballot(k[2] > T));
            const int need = 16 - ngt;
            int eqbefore = 0;
#pragma unroll
            for (int t = 0; t < 3; ++t) {
                const unsigned long long eqm = __ballot(k[t] == T);
                const bool sl = (k[t] > T) || ((k[t] == T) && (eqbefore + __popcll(eqm & below) < need));
                const unsigned long long sm = __ballot(sl);
                if (sl) { const int slot = base + __popcll(sm & below), b = lane + 64 * t; sel[slot] = b; pgs[slot] = b < 128 ? p.page_table[n * NPAGES + (b >> 1)] : 0; }
                base += __popcll(sm); eqbefore += __popcll(eqm);
            }
        }
        __syncthreads();
        if (tid < 384) {
            float o = 0.f;
#pragma unroll
            for (int w = 0; w < 8; ++w) o += part[(w * 6 + myh) * 64 + myd];
            oacc = o * sigmoid_f(bf2f(p.proj[row * WP + 1536 + (kv * 6 + myh) * 3 + 0]));
        }
#pragma unroll 1
        for (int t = 0; t < 2; ++t) {
            DEC_OPAQUE_TID();
            const int key = tid_s + 512 * t, s = key >> 6, j = key & 63, b = sel[s], page = pgs[s];
            if (b < 128) {
                ld_row_f32(p.cache_b_pages + ((((size_t)page * 128 + (b & 1) * 64 + j) * 2 + li) * 4 + 2) * 128 + kv * 64, x);
                dot6_store(x, qs, sc + key, kv * 6, (float)(PL - (b * 64 + j)), true);
            } else if (j == 0) {
                ld_row_b16(p.proj + row * WP + 768 + 2 * 128 + kv * 64, x);
                dot6_store(x, qs, sc + key, kv * 6, 0.f, true);
            } else {
#pragma unroll
                for (int h = 0; h < 6; ++h) sc[h * DSTR + key] = -INFINITY;
            }
        }
        __syncthreads();
        if (wid < 6) { const float l = dec_softmax(sc + wid * DSTR, 1024, false, lane); if (lane == 0) lsum[wid] = l; }
        __syncthreads();
        {
            DEC_OPAQUE_TID();
            float4 a[6];
#pragma unroll
            for (int h = 0; h < 6; ++h) a[h] = make_float4(0.f, 0.f, 0.f, 0.f);
#pragma unroll 1
            for (int ss = 0; ss < 2; ++ss) {
                const int s = 2 * wid + ss, b = sel[s], page = pgs[s];
                if (b < 128) {
                    const float* vb = p.cache_b_pages + ((((size_t)page * 128 + (b & 1) * 64 + kq) * 2 + li) * 4 + 3) * 128 + kv * 64 + 4 * dq;
#pragma unroll 4
                    for (int t = 0; t < 16; ++t) {
                        const float4 v = *(const float4*)(vb + (size_t)(4 * t) * 1024);
#pragma unroll
                        for (int h = 0; h < 6; ++h) { const float pr = sc[h * DSTR + s * 64 + 4 * t + kq]; a[h].x += pr * v.x; a[h].y += pr * v.y; a[h].z += pr * v.z; a[h].w += pr * v.w; }
                    }
                } else if (kq == 0) {
                    const uint2 w2 = *(const uint2*)(p.proj + row * WP + 768 + 3 * 128 + kv * 64 + 4 * dq);
                    const float4 v = make_float4(__uint_as_float(w2.x << 16), __uint_as_float(w2.x & 0xffff0000u), __uint_as_float(w2.y << 16), __uint_as_float(w2.y & 0xffff0000u));
#pragma unroll
                    for (int h = 0; h < 6; ++h) { const float pr = sc[h * DSTR + s * 64]; a[h].x += pr * v.x; a[h].y += pr * v.y; a[h].z += pr * v.z; a[h].w += pr * v.w; }
                }
            }
#pragma unroll
            for (int h = 0; h < 6; ++h) {
                pv4_reduce(a[h]);
                if (kq == 0) { part[(wid * 6 + h) * 64 + 4 * dq + 0] = a[h].x; part[(wid * 6 + h) * 64 + 4 * dq + 1] = a[h].y; part[(wid * 6 + h) * 64 + 4 * dq + 2] = a[h].z; part[(wid * 6 + h) * 64 + 4 * dq + 3] = a[h].w; }
            }
        }
        __syncthreads();
        if (tid < 384) {
            float o = 0.f;
#pragma unroll
            for (int w = 0; w < 8; ++w) o += part[(w * 6 + myh) * 64 + myd];
            oacc += sigmoid_f(bf2f(p.proj[row * WP + 1536 + (kv * 6 + myh) * 3 + 1])) * o / lsum[myh];
        }
        __syncthreads();
        {
            DEC_OPAQUE_TID();
            const float* wb = p.cache_b_win + ((size_t)li * NS + n) * LBW * 256 + kv * 64;
            ld_row_f32(wb + (size_t)tid_s * 256, x);
            dot6_store(x, qs, sc + tid_s, kv * 6, (float)(512 - tid_s), true);
            if (tid_s == 0) {
                ld_row_b16(p.proj + row * WP + 768 + 4 * 128 + kv * 64, x);
                dot6_store(x, qs, sc + 512, kv * 6, 0.f, true);
            }
        }
        __syncthreads();
        if (wid < 6) { const float l = dec_softmax(sc + wid * DSTR, 513, false, lane); if (lane == 0) lsum[wid] = l; }
        __syncthreads();
        {
            DEC_OPAQUE_TID();
            const float* wb = p.cache_b_win + ((size_t)li * NS + n) * LBW * 256 + 128 + kv * 64;
            float4 a[6];
#pragma unroll
            for (int h = 0; h < 6; ++h) a[h] = make_float4(0.f, 0.f, 0.f, 0.f);
            const float* vb = wb + (size_t)(wid * 64 + kq) * 256 + 4 * dq;
#pragma unroll 4
            for (int t = 0; t < 16; ++t) {
                const float4 v = *(const float4*)(vb + (size_t)(4 * t) * 256);
#pragma unroll
                for (int h = 0; h < 6; ++h) { const float pr = sc[h * DSTR + wid * 64 + 4 * t + kq]; a[h].x += pr * v.x; a[h].y += pr * v.y; a[h].z += pr * v.z; a[h].w += pr * v.w; }
            }
            if (wid == 0 && kq == 0) {
                const uint2 w2 = *(const uint2*)(p.proj + row * WP + 768 + 5 * 128 + kv * 64 + 4 * dq);
                const float4 v = make_float4(__uint_as_float(w2.x << 16), __uint_as_float(w2.x & 0xffff0000u), __uint_as_float(w2.y << 16), __uint_as_float(w2.y & 0xffff0000u));
#pragma unroll
                for (int h = 0; h < 6; ++h) { const float pr = sc[h * DSTR + 512]; a[h].x += pr * v.x; a[h].y += pr * v.y; a[h].z += pr * v.z; a[h].w += pr * v.w; }
            }
#pragma unroll
            for (int h = 0; h < 6; ++h) {
                pv4_reduce(a[h]);
                if (kq == 0) { part[(wid * 6 + h) * 64 + 4 * dq + 0] = a[h].x; part[(wid * 6 + h) * 64 + 4 * dq + 1] = a[h].y; part[(wid * 6 + h) * 64 + 4 * dq + 2] = a[h].z; part[(wid * 6 + h) * 64 + 4 * dq + 3] = a[h].w; }
            }
        }
        __syncthreads();
        if (tid < 384) {
            float o = 0.f;
#pragma unroll
            for (int w = 0; w < 8; ++w) o += part[(w * 6 + myh) * 64 + myd];
            oacc += sigmoid_f(bf2f(p.proj[row * WP + 1536 + (kv * 6 + myh) * 3 + 2])) * o / lsum[myh];
            const int hd = kv * 6 + myh;
            p.z[row * 1024 + hd * 64 + myd] = f2bf(oacc * silu_f(bf2f(p.proj[row * WP + 1572 + hd * 64 + myd])));
        }
    }
    __syncthreads();
#undef DEC_OPAQUE_TID
}


__global__ void __launch_bounds__(NTHREADS, 2) mega(Params p) {
    extern __shared__ __attribute__((aligned(16))) unsigned char smem[];
    LAS unsigned char* lds = (LAS unsigned char*)smem;
    volatile LAS unsigned* xbw = (volatile LAS unsigned*)(lds + LDS_STAGE);
    if (threadIdx.x == 0) { xbw[0] = 0u; xbw[1] = 0u; xbw[2] = 0u; xbw[3] = 0u; }
    __syncthreads();
    XcdBarrier bar = xcd_barrier_post(p.bar, xbw);
#define BAR() xcd_barrier(bar)
#define STG(call) do { __syncthreads(); call; } while (0)
#define NVRUN(fn, ...) do { int t_ = threadIdx.x; asm volatile("" : "+v"(t_)); fn(__VA_ARGS__, (long)blockIdx.x * NTHREADS + t_, (long)gridDim.x * NTHREADS); } while (0)
    STG(fast_prep_weights(p, lds)); STG(fast_prep_x(p)); BAR();
    STG(fast_memkv(p)); STG(fast_inproj(p, 0, lds)); BAR();
    STG(fast_post(p, 0)); BAR();
    for (int i = 0; i < 4; ++i) {
        if (i > 0) { STG(fast_inproj(p, i, lds)); BAR(); STG(fast_post(p, i)); if (i & 1) fast_pq_p(p, i >> 1); BAR(); }
        if ((i & 1) == 0) { STG(fast_dec_a(p, i, lds)); fast_attn_a(p, i, i == 0); fast_cross_a(p, i); BAR();     }
        else {
            STG(fast_cmpc_p(p, i >> 1)); if (i == 1) STG(fast_pq_s(p, lds, 1)); BAR();
            STG(fast_dec_nsa3(p, i, lds)); STG(fast_dec_cross_b(p, i, lds)); fast_nsa_prompt(p, i, lds); fast_cross_b(p, i); if (i == 1) fast_cmpc_s(p, 1, p.bar + WQ_BASE + 16 * 25); BAR();
        }
        STG(fast_outproj(p, i, lds)); if (i == 0) STG(fast_pq_s(p, lds, 0)); BAR();
        STG(fast_finish(p, i)); if (i == 0) STG(fast_cmpc_s(p, 0)); if (i < 3) BAR();
    }
}

extern "C" void kernel_launch(void* const* d_in, const int* in_sizes, int n_in,
                              void* d_out, int out_size, void* d_ws, size_t ws_size,
                              hipStream_t stream) {
    static int grid = 0;
    if (grid == 0) {
        int dev = 0, cus = 0, per_cu = 0;
        if (hipGetDevice(&dev) != hipSuccess || hipDeviceGetAttribute(&cus, hipDeviceAttributeMultiprocessorCount, dev) != hipSuccess) { grid = -1; return; }
        if (hipFuncSetAttribute((const void*)mega, hipFuncAttributeMaxDynamicSharedMemorySize, LDS_BYTES) != hipSuccess) { grid = -1; return; }
        if (hipOccupancyMaxActiveBlocksPerMultiprocessor(&per_cu, (const void*)mega, NTHREADS, LDS_BYTES) != hipSuccess || per_cu < 1) { (void)hipGetLastError(); }
        grid = cus;
    }
    if (grid < 0) return;
    Params p; fill_params(p, d_in, d_out, d_ws);
    (void)hipMemsetAsync(p.bar, 0, 4096 * sizeof(unsigned), stream);
    hipLaunchKernelGGL(mega, dim3(grid), dim3(NTHREADS), LDS_BYTES, stream, p);
}
```

```cpp
#include <hip/hip_runtime.h>
#include <cstring>
#include <cmath>

#ifdef SMALL
constexpr int D = 128, NB = 1, S = 2048, NS = 2, PL = 2048, NM = 32;
#else
constexpr int D = 1024, NB = 2, S = 8192, NS = 32, PL = 8192, NM = 256;
#endif
constexpr int MP = NB * S, M = MP + NS;
constexpr int MPAD = ((M + 255) / 256) * 256;
constexpr int WP = 3072;
constexpr int W_IN_B = 2852;
constexpr int NPAGES = PL / 128;
constexpr int NC_P = (S - 32) / 16 + 1;
constexpr int NC_S = (PL + 1 - 32) / 16 + 1;
constexpr int NSEL_P = (S + 63) / 64, NSEL_S = (PL + 1 + 63) / 64;
constexpr int HB_P = S / 16, HB_S = PL / 16;
constexpr int CSTR = 512;
constexpr int IMPSTR = 160;
constexpr float SCALE = 0.125f, RMS_EPS = 1e-6f;
constexpr int WROWS0 = (128 < S ? 128 : S), WROWS1 = (512 < S ? 512 : S), WROWS2 = (2048 < S ? 2048 : S);
constexpr int LB0 = (128 < PL ? 128 : PL), LB1 = (512 < PL ? 512 : PL), LB2 = (2048 < PL ? 2048 : PL);
constexpr int LBW = (512 < PL ? 512 : PL);
static_assert(NC_P <= CSTR && NC_S <= CSTR, "cmp stride");
static_assert(NSEL_S <= IMPSTR, "imp stride");

typedef unsigned short bf16_t;
constexpr int WQ_BASE = 3584;
constexpr int NTHREADS = 512;
constexpr int LDS_STAGE = 152832;
constexpr int LDS_PARAMS = LDS_STAGE + 16;
constexpr int LDS_BYTES = LDS_PARAMS + 1024;

#define PARAM_FIELDS(X) \
    X(const float*, x_prompt) X(const float*, x_sample) X(const float*, cache_mem_kv) X(const float*, cache_a0) X(const float*, cache_a1) X(const float*, cache_a2) \
    X(const float*, cache_b_pages) X(const float*, cache_b_win) X(const int*, page_table) X(const float*, mem_prompt) X(const float*, norm_pre) X(const float*, norm_post) \
    X(const float*, norm_mem) X(const float*, w_mem_kv) X(const float*, w_in_a) X(const float*, w_out_a) X(const float*, w_in_b) X(const float*, w_out_b) \
    X(const float*, cmp_pos) X(const float*, cmp_w1) X(const float*, cmp_w2) \
      \
    X(float*, o_y) X(float*, o_ys) X(float*, o_mem) X(float*, o_pa0) X(float*, o_pa1) X(float*, o_pa2) X(float*, o_pb) X(float*, o_pbw) \
    X(float*, o_sa0) X(float*, o_sa1) X(float*, o_sa2) X(float*, o_sb) X(float*, o_sbw) \
      \
    X(bf16_t*, wt_in)      \
    X(bf16_t*, wt_out)     \
    X(bf16_t*, wt_mem)     \
    X(bf16_t*, w1t)        \
    X(bf16_t*, w2t)        \
    X(float*, cb)          \
    X(bf16_t*, xb)         \
    X(float*, rstd)        \
    X(float*, mrstd)       \
    X(bf16_t*, proj)       \
    X(bf16_t*, vta)        \
    X(bf16_t*, vts) X(bf16_t*, vtw)     \
    X(bf16_t*, kta)        \
    X(bf16_t*, kts) X(bf16_t*, ktw)     \
    X(bf16_t*, kc) X(bf16_t*, vc)       \
    X(bf16_t*, mkb)        \
    X(bf16_t*, mvt)        \
    X(float*, hid)         \
    X(float*, hid_s)       \
    X(bf16_t*, kcmp)       \
    X(bf16_t*, vcmpt)      \
    X(bf16_t*, kcmp_s)     \
    X(bf16_t*, vcmpt_s)    \
    X(bf16_t*, z)          \
    X(float*, y)           \
    X(bf16_t*, yb)         \
    X(float*, pc)          \
    X(float*, oc)          \
    X(float*, imp)         \
    X(int*, selb)          \
    X(bf16_t*, w1pq)       \
    X(bf16_t*, cachec)     \
    X(bf16_t*, pq_s)       \
    X(bf16_t*, pq_p)       \
    X(bf16_t*, memb)       \
    X(unsigned*, bar)
struct Params {
#define X(t, n) t n;
    PARAM_FIELDS(X)
#undef X
};

__device__ __host__ inline bf16_t f2bf(float f) {
    union { float f; unsigned u; } v; v.f = f;
    unsigned u = v.u;
    u += 0x7FFFu + ((u >> 16) & 1u);
    return (bf16_t)(u >> 16);
}
__device__ __host__ inline float bf2f(bf16_t b) {
    union { float f; unsigned u; } v; v.u = ((unsigned)b) << 16; return v.f;
}
__device__ __host__ inline float silu_f(float x) { return x / (1.0f + expf(-x)); }
__device__ __host__ inline float sigmoid_f(float x) { return 1.0f / (1.0f + expf(-x)); }
__device__ __host__ inline float slope_a(int g, int h) { return exp2f(-8.0f * (float)(g * 4 + h + 1) / 12.0f); }
__device__ __host__ inline float slope_b(int hd) { return exp2f(-8.0f * (float)(hd + 1) / 12.0f); }
__device__ __host__ inline int dil_of(int g) { return g == 0 ? 1 : (g == 1 ? 4 : 16); }
__device__ __host__ inline int wrows_of(int g) { return g == 0 ? WROWS0 : (g == 1 ? WROWS1 : WROWS2); }
__device__ __host__ inline int lb_of(int g) { return g == 0 ? LB0 : (g == 1 ? LB1 : LB2); }
constexpr int VT_LD = 32;
__device__ __host__ inline size_t vt_pos(int pos) { return (size_t)(pos >> 5) * 2048 + (size_t)(pos & 31); }
__device__ __host__ inline size_t kt_pos(int pos, int e0) { return (size_t)(pos >> 5) * 2048 + (size_t)(e0 >> 5) * 1024 + (size_t)(pos & 31) * 32 + (size_t)(e0 & 31); }
__device__ __host__ inline int cpos(int t, int d) { return (t % d) * (S / d) + t / d; }

__device__ __host__ inline unsigned pack_bf2(float lo, float hi) { return (unsigned)f2bf(lo) | ((unsigned)f2bf(hi) << 16); }
__device__ __host__ inline void st8_bf(bf16_t* dst, const float* v) {
    uint4 u; u.x = pack_bf2(v[0], v[1]); u.y = pack_bf2(v[2], v[3]); u.z = pack_bf2(v[4], v[5]); u.w = pack_bf2(v[6], v[7]);
    *(uint4*)dst = u;
}
__device__ __host__ inline void st8_f(float* dst, const float* v) {
    float4 a, b; a.x = v[0]; a.y = v[1]; a.z = v[2]; a.w = v[3]; b.x = v[4]; b.y = v[5]; b.z = v[6]; b.w = v[7];
    *(float4*)dst = a; *(float4*)(dst + 4) = b;
}
__device__ __host__ __forceinline__ void inproj_extra8(const Params& p, int i, int r, int c0, const float* v, bool compact_copies = true) {
    const int li = i >> 1;
    const bool samp = r >= MP;
    const int n = samp ? r - MP : r / S, t = samp ? 0 : r % S;
    if ((i & 1) == 0) {
        if (c0 >= 768 && c0 < 2304) {
            const int s = c0 / 768, g = (c0 % 768) / 256, h = (c0 % 256) / 64, e0 = c0 % 64;
            float* ob = samp ? (g == 0 ? +p.o_sa0 : (g == 1 ? +p.o_sa1 : +p.o_sa2)) : (g == 0 ? +p.o_pa0 : (g == 1 ? +p.o_pa1 : +p.o_pa2));
            if (samp) {
                st8_f(ob + (size_t)(li * NS + n) * 512 + (s - 1) * 256 + h * 64 + e0, v);
            } else {
                const int wr = wrows_of(g);
                if (t >= S - wr) st8_f(ob + ((size_t)(li * NB + n) * wr + (t - (S - wr))) * 512 + (s - 1) * 256 + h * 64 + e0, v);
                if (s == 1) {
                    const int d = dil_of(g);
                    st8_bf(p.kta + (((size_t)g * NB + n) * 4 + h) * 64 * S + kt_pos(cpos(t, d), e0), v);
                } else {
                    const int d = dil_of(g);
                    bf16_t* vt = p.vta + (((size_t)g * NB + n) * 4 + h) * 64 * S + vt_pos(cpos(t, d)) + e0 * VT_LD;
                    for (int j = 0; j < 8; ++j) vt[j * VT_LD] = f2bf(v[j]);
                }
            }
        }
    } else {
        if (c0 >= 768 && c0 < 1536) {
            const int cc = c0 - 768, ty = cc / 128, kv = (cc % 128) / 64, e0 = cc % 64;
            if (ty < 4) {
                st8_f(samp ? +p.o_sb + (size_t)(n * 2 + li) * 512 + cc : +p.o_pb + ((size_t)(n * S + t) * 2 + li) * 512 + cc, v);
            } else {
                if (samp) st8_f(p.o_sbw + (size_t)(li * NS + n) * 256 + (cc - 512), v);
                else if (t >= S - WROWS1) st8_f(p.o_pbw + ((size_t)(li * NB + n) * WROWS1 + (t - (S - WROWS1))) * 256 + (cc - 512), v);
            }
            if (!samp) {
                if ((ty == 0 || ty == 1) && compact_copies) {
                    st8_bf((ty == 0 ? +p.kc : +p.vc) + (((size_t)n * 2 + kv) * S + t) * 64 + e0, v);
                } else if (ty == 2 || ty == 4) {
                    st8_bf((ty == 2 ? +p.kts : +p.ktw) + ((size_t)n * 2 + kv) * 64 * S + kt_pos(t, e0), v);
                } else if (ty == 3 || ty == 5) {
                    bf16_t* o = (ty == 3 ? +p.vts : +p.vtw) + ((size_t)n * 2 + kv) * 64 * S + vt_pos(t) + e0 * VT_LD;
                    for (int j = 0; j < 8; ++j) o[j * VT_LD] = f2bf(v[j]);
                }
            }
        }
    }
}


#define GS_LOOP(it, n) for (long it = gtid; it < (long)(n); it += gsz)

__device__ inline void ld8(const bf16_t* p, float* f) {
    const uint4 u = *(const uint4*)p;
    f[0] = __uint_as_float(u.x << 16); f[1] = __uint_as_float(u.x & 0xffff0000u);
    f[2] = __uint_as_float(u.y << 16); f[3] = __uint_as_float(u.y & 0xffff0000u);
    f[4] = __uint_as_float(u.z << 16); f[5] = __uint_as_float(u.z & 0xffff0000u);
    f[6] = __uint_as_float(u.w << 16); f[7] = __uint_as_float(u.w & 0xffff0000u);
}
__device__ inline void ld4f(const float* p, float* f) { const float4 u = *(const float4*)p; f[0] = u.x; f[1] = u.y; f[2] = u.z; f[3] = u.w; }
__device__ inline float dot_bb(const bf16_t* a, const bf16_t* b, int n) {
    float acc = 0.f;
    for (int k = 0; k < n; k += 8) { float x[8], y[8]; ld8(a + k, x); ld8(b + k, y);
#pragma unroll
        for (int j = 0; j < 8; ++j) acc += x[j] * y[j]; }
    return acc;
}
#define DOT64_B(acc, qf, kptr) do { _Pragma("unroll") for (int _k = 0; _k < 64; _k += 8) { float _y[8]; ld8((kptr) + _k, _y); _Pragma("unroll") for (int _j = 0; _j < 8; ++_j) acc += qf[_k + _j] * _y[_j]; } } while (0)
#define DOT64_F(acc, qf, kptr) do { _Pragma("unroll") for (int _k = 0; _k < 64; _k += 4) { float _y[4]; ld4f((kptr) + _k, _y); _Pragma("unroll") for (int _j = 0; _j < 4; ++_j) acc += qf[_k + _j] * _y[_j]; } } while (0)
#define LD64_B(dst, ptr) do { _Pragma("unroll") for (int _k = 0; _k < 64; _k += 8) ld8((ptr) + _k, (dst) + _k); } while (0)
#define LD64_F(dst, ptr) do { _Pragma("unroll") for (int _k = 0; _k < 64; _k += 4) ld4f((ptr) + _k, (dst) + _k); } while (0)

#define DOTM_B(acc, qp, kptr) do { _Pragma("unroll") for (int _k = 0; _k < 64; _k += 8) { float _x[8], _y[8]; ld8((qp) + _k, _x); ld8((kptr) + _k, _y); _Pragma("unroll") for (int _j = 0; _j < 8; ++_j) acc += _x[_j] * _y[_j]; } } while (0)
#define DOTM_F(acc, qp, kptr) do { _Pragma("unroll") for (int _k = 0; _k < 64; _k += 8) { float _x[8], _y[8]; ld8((qp) + _k, _x); ld4f((kptr) + _k, _y); ld4f((kptr) + _k + 4, _y + 4); _Pragma("unroll") for (int _j = 0; _j < 8; ++_j) acc += _x[_j] * _y[_j]; } } while (0)

__device__ __forceinline__ void nv_prep_weights(const Params& p, long gtid, long gsz) {
    GS_LOOP(it, (long)4 * WP * D) {
        const int k = it % D, c = (it / D) % WP, i = it / ((long)D * WP);
        const int li = i >> 1;
        float w = 0.f;
        if ((i & 1) == 0) w = p.w_in_a[((size_t)li * D + k) * 3072 + c];
        else if (c < W_IN_B) w = p.w_in_b[((size_t)li * D + k) * W_IN_B + c];
        p.wt_in[it] = f2bf(w * p.norm_pre[i * D + k]);
    }
    GS_LOOP(it, (long)4 * D * 1024) {
        const int i = it / ((long)D * 1024); const long rem = it % ((long)D * 1024);
        const int li = i >> 1;
        if ((i & 1) == 0) {
            if (rem < (long)D * 512) { const int k = rem % 512, c = rem / 512; p.wt_out[it] = f2bf(p.w_out_a[((size_t)li * 512 + k) * D + c]); }
        } else { const int k = rem % 1024, c = rem / 1024; p.wt_out[it] = f2bf(p.w_out_b[((size_t)li * 1024 + k) * D + c]); }
    }
    GS_LOOP(it, (long)4 * 512 * D) {
        const int k = it % D, c = (it / D) % 512, i = it / ((long)D * 512);
        p.wt_mem[it] = f2bf(p.w_mem_kv[((size_t)i * D + k) * 512 + c] * p.norm_mem[i * D + k]);
    }
    GS_LOOP(it, (long)4 * 128 * 2048) {
        const int k = it % 2048, j = (it / 2048) % 128, lt = it / (2048 * 128);
        p.w1t[it] = f2bf(p.cmp_w1[((size_t)lt * 2048 + k) * 128 + j]);
    }
    GS_LOOP(it, (long)4 * 256 * 1024) {
        const int k = it % 1024, jj = (it / 1024) % 256, lt = it / (1024 * 256);
        p.w1pq[it] = f2bf(p.cmp_w1[((size_t)lt * 2048 + (jj < 128 ? k : 1024 + k)) * 128 + (jj & 127)]);
    }
    GS_LOOP(it, (long)4 * 64 * 128) {
        const int j = it % 128, e = (it / 128) % 64, lt = it / (128 * 64);
        p.w2t[it] = f2bf(p.cmp_w2[((size_t)lt * 128 + j) * 64 + e]);
    }
    GS_LOOP(it, (long)4 * 128) {
        const int j = it % 128, lt = it / 128;
        float a = 0.f;
        for (int k = 0; k < 2048; ++k) a += p.cmp_pos[(size_t)lt * 2048 + k] * p.cmp_w1[((size_t)lt * 2048 + k) * 128 + j];
        p.cb[it] = a;
    }
}

__device__ __forceinline__ void nv_prep_x(const Params& p, long gtid, long gsz) {
    GS_LOOP(r, M) {
        const float* src = r < MP ? p.x_prompt + (size_t)r * D : p.x_sample + (size_t)(r - MP) * D;
        float* dst = r < MP ? p.o_y + (size_t)r * D : p.o_ys + (size_t)(r - MP) * D;
        float ss = 0.f;
        for (int k = 0; k < D; ++k) { const float v = src[k]; dst[k] = v; p.xb[(size_t)r * D + k] = f2bf(v); ss += v * v; }
        p.rstd[r] = 1.0f / sqrtf(ss / D + RMS_EPS);
    }
    GS_LOOP(r, NB * NM) {
        float ss = 0.f;
        for (int k = 0; k < D; ++k) { const float v = p.mem_prompt[(size_t)r * D + k]; ss += v * v; }
        p.mrstd[r] = 1.0f / sqrtf(ss / D + RMS_EPS);
    }
}

__device__ __forceinline__ void nv_memkv(const Params& p, long gtid, long gsz) {
    GS_LOOP(it, (long)4 * NB * NM * 512) {
        const int c = it % 512, row = (it / 512) % (NB * NM), i = it / ((long)512 * NB * NM);
        const bf16_t* w = p.wt_mem + ((size_t)i * 512 + c) * D;
        const float* a = p.mem_prompt + (size_t)row * D;
        float acc = 0.f;
        for (int k = 0; k < D; ++k) acc += bf2f(f2bf(a[k])) * bf2f(w[k]);
        acc *= p.mrstd[row];
        p.o_mem[it] = acc;
        const int n = row / NM, m = row % NM, kvs = c / 256, h = (c % 256) / 64, e = c % 64;
        if (kvs == 0) p.mkb[((((size_t)i * NB + n) * 4 + h) * NM + m) * 64 + e] = f2bf(acc);
        else p.mvt[((((size_t)i * NB + n) * 4 + h) * 64 + e) * NM + m] = f2bf(acc);
    }
}

__device__ __forceinline__ void nv_inproj(const Params& p, int i, long gtid, long gsz) {
    GS_LOOP(it, (long)M * (WP / 8)) {
        const int r = it % M, c0 = (it / M) * 8;
        const bf16_t* a = p.xb + (size_t)r * D;
        const bf16_t* w = p.wt_in + ((size_t)i * WP + c0) * D;
        float v[8];
#pragma unroll
        for (int j = 0; j < 8; ++j) v[j] = 0.f;
        for (int k = 0; k < D; k += 8) {
            float x[8]; ld8(a + k, x);
#pragma unroll
            for (int j = 0; j < 8; ++j) { float y[8]; ld8(w + (size_t)j * D + k, y);
#pragma unroll
                for (int q = 0; q < 8; ++q) v[j] += x[q] * y[q]; }
        }
        const float rs = p.rstd[r];
#pragma unroll
        for (int j = 0; j < 8; ++j) v[j] *= rs;
        st8_bf(p.proj + (size_t)r * WP + c0, v);
    }
}
__device__ __forceinline__ void nv_post(const Params& p, int i, long gtid, long gsz) {
    const int nc8 = ((i & 1) ? 768 : 1536) / 8;
    GS_LOOP(it, (long)M * nc8) {
        const int r = it % M, c0 = 768 + (it / M) * 8;
        float v[8]; ld8(p.proj + (size_t)r * WP + c0, v);
        inproj_extra8(p, i, r, c0, v);
    }
}

#define OSM_HEAD(sc) const float _mn = fmaxf(mx, (sc)), _al = expf(mx - _mn), _pe = expf((sc) - _mn); den = den * _al + _pe; mx = _mn;
#define OSM_UPD_T(sc, vt, stride) do { OSM_HEAD(sc) _Pragma("unroll") for (int _e = 0; _e < 64; ++_e) { if ((_e & 15) == 0) asm volatile("" ::: "memory"); o[_e] = o[_e] * _al + _pe * bf2f((vt)[(size_t)_e * (stride)]); } } while (0)
#define OSM_UPD_B(sc, vrow) do { OSM_HEAD(sc) _Pragma("unroll") for (int _e = 0; _e < 64; _e += 8) { float _v[8]; if ((_e & 15) == 0) asm volatile("" ::: "memory"); ld8((vrow) + _e, _v); _Pragma("unroll") for (int _j = 0; _j < 8; ++_j) o[_e + _j] = o[_e + _j] * _al + _pe * _v[_j]; } } while (0)
#define OSM_UPD_F(sc, vrow) do { OSM_HEAD(sc) _Pragma("unroll") for (int _e = 0; _e < 64; _e += 4) { float _v[4]; if ((_e & 15) == 0) asm volatile("" ::: "memory"); ld4f((vrow) + _e, _v); _Pragma("unroll") for (int _j = 0; _j < 4; ++_j) o[_e + _j] = o[_e + _j] * _al + _pe * _v[_j]; } } while (0)

__device__ __forceinline__ void nv_attn_a(const Params& p, int i, int r0, long gtid, long gsz) {
    const int li = i >> 1;
    GS_LOOP(it, (long)(M - r0) * 4) {
        const int r = r0 + it % (M - r0), h = it / (M - r0);
        const bool samp = r >= MP;
        const int n = samp ? r - MP : r / S, t = samp ? 0 : r % S;
        float o[64]; float mx = -INFINITY, den = 0.f;
#pragma unroll
        for (int e = 0; e < 64; ++e) o[e] = 0.f;
        for (int g = 0; g < 3; ++g) {
            const int d = dil_of(g); const float sl = slope_a(g, h);
            const bf16_t* q = p.proj + (size_t)r * WP + g * 256 + h * 64;
            const float* cache = g == 0 ? +p.cache_a0 : (g == 1 ? +p.cache_a1 : +p.cache_a2);
            const int lb = lb_of(g);
            for (int j = 0; j <= 128; ++j) {
                float sc = 0.f; const float bias = sl * (float)(j * d);
                if (!samp) {
                    const int tk = t - j * d; if (tk < 0) break;
                    const bf16_t* k = p.proj + (size_t)(n * S + tk) * WP + 768 + g * 256 + h * 64;
                    DOTM_B(sc, q, k); sc = sc * SCALE - bias;
                    const bf16_t* vt = p.vta + (((size_t)g * NB + n) * 4 + h) * 64 * S + vt_pos(cpos(tk, d));
                    OSM_UPD_T(sc, vt, VT_LD);
                } else {
                    const int idx = lb - j * d; if (idx < 0) break;
                    if (j == 0) {
                        const bf16_t* k = p.proj + (size_t)r * WP + 768 + g * 256 + h * 64;
                        DOTM_B(sc, q, k); sc = sc * SCALE - bias; OSM_UPD_B(sc, k + 768);
                    } else {
                        const float* k = cache + (((size_t)li * NS + n) * lb + idx) * 512 + h * 64;
                        DOTM_F(sc, q, k); sc = sc * SCALE - bias; OSM_UPD_F(sc, k + 256);
                    }
                }
            }
        }
        const bf16_t* gm = p.proj + (size_t)r * WP + 2304 + h * 64;
        bf16_t* z = p.z + (size_t)r * 512 + h * 64;
#pragma unroll
        for (int e = 0; e < 64; ++e) z[e] = f2bf(o[e] / den * silu_f(bf2f(gm[e])));
    }
}

__device__ __forceinline__ void nv_cross(const Params& p, int i, int zld, int zoff, int qoff, int goff, int r0, long gtid, long gsz) {
    GS_LOOP(it, (long)(M - r0) * 4) {
        const int r = r0 + it % (M - r0), h = it / (M - r0);
        const bool samp = r >= MP;
        const int n = samp ? r - MP : r / S;
        const bf16_t* qp = p.proj + (size_t)r * WP + qoff + h * 64;
        float o[64]; float mx = -INFINITY, den = 0.f;
#pragma unroll
        for (int e = 0; e < 64; ++e) o[e] = 0.f;
        for (int m = 0; m < NM; ++m) {
            float sc = 0.f;
            if (!samp) {
                const bf16_t* k = p.mkb + ((((size_t)i * NB + n) * 4 + h) * NM + m) * 64;
                const bf16_t* vt = p.mvt + (((size_t)i * NB + n) * 4 + h) * 64 * NM + m;
                DOTM_B(sc, qp, k); sc *= SCALE;
                OSM_UPD_T(sc, vt, NM);
            } else {
                const float* k = p.cache_mem_kv + ((((size_t)i * NS + n) * NM + m) * 2) * 256 + h * 64;
                DOTM_F(sc, qp, k); sc *= SCALE; OSM_UPD_F(sc, k + 256);
            }
        }
        const bf16_t* gx = p.proj + (size_t)r * WP + goff + h * 64;
        bf16_t* z = p.z + (size_t)r * zld + zoff + h * 64;
#pragma unroll
        for (int e = 0; e < 64; ++e) z[e] = f2bf(o[e] / den * silu_f(bf2f(gx[e])));
    }
}

__device__ __forceinline__ void nv_outproj(const Params& p, int i, long gtid, long gsz) {
    const int KO = (i & 1) ? 1024 : 512;
    GS_LOOP(it, (long)M * (D / 8)) {
        const int r = it % M, c0 = (it / M) * 8;
        const bf16_t* a = p.z + (size_t)r * KO;
        const bf16_t* w = p.wt_out + (size_t)i * D * 1024 + (size_t)c0 * KO;
        float v[8];
#pragma unroll
        for (int j = 0; j < 8; ++j) v[j] = 0.f;
        for (int k = 0; k < KO; k += 8) {
            float x[8]; ld8(a + k, x);
#pragma unroll
            for (int j = 0; j < 8; ++j) { float y[8]; ld8(w + (size_t)j * KO + k, y);
#pragma unroll
                for (int q = 0; q < 8; ++q) v[j] += x[q] * y[q]; }
        }
#pragma unroll
        for (int j = 0; j < 8; ++j) p.y[(size_t)r * D + c0 + j] = v[j];
    }
}

__device__ __forceinline__ void nv_finish(const Params& p, int i, long gtid, long gsz) {
    GS_LOOP(r, M) {
        float* x = r < MP ? p.o_y + (size_t)r * D : p.o_ys + (size_t)(r - MP) * D;
        const float* y = p.y + (size_t)r * D;
        float ss = 0.f;
        for (int k = 0; k < D; ++k) ss += y[k] * y[k];
        const float yr = 1.0f / sqrtf(ss / D + RMS_EPS);
        float s2 = 0.f;
        for (int k = 0; k < D; ++k) { const float v = x[k] + y[k] * yr * p.norm_post[i * D + k]; x[k] = v; p.xb[(size_t)r * D + k] = f2bf(v); s2 += v * v; }
        p.rstd[r] = 1.0f / sqrtf(s2 / D + RMS_EPS);
    }
}

__device__ __forceinline__ void nv_cmp1_p(const Params& p, int li, long gtid, long gsz) {
    GS_LOOP(it, (long)2 * NB * 2 * NC_P * 128) {
        const int j = it % 128, c = (it / 128) % NC_P, nk = (it / (128 * NC_P)) % (NB * 2), ty = it / ((long)128 * NC_P * NB * 2);
        const bf16_t* a = (ty == 0 ? +p.kc : +p.vc) + ((size_t)nk * S + 16 * c) * 64;
        const bf16_t* w = p.w1t + ((size_t)(li * 2 + ty) * 128 + j) * 2048;
        const float acc = p.cb[(li * 2 + ty) * 128 + j] + dot_bb(a, w, 2048);
        p.hid[(((size_t)ty * NB * 2 + nk) * CSTR + c) * 128 + j] = silu_f(acc);
    }
}
__device__ __forceinline__ void nv_cmp1_s(const Params& p, int li, long gtid, long gsz) {
    GS_LOOP(it, (long)2 * NS * 2 * NC_S * 128) {
        const int j = it % 128, c = (it / 128) % NC_S, nk = (it / (128 * NC_S)) % (NS * 2), ty = it / ((long)128 * NC_S * NS * 2);
        const int n = nk / 2, kv = nk % 2;
        const bf16_t* w = p.w1t + ((size_t)(li * 2 + ty) * 128 + j) * 2048;
        float acc = p.cb[(li * 2 + ty) * 128 + j];
        for (int l = 0; l < 32; ++l) {
            const int pos = 16 * c + l;
            const int page = p.page_table[n * NPAGES + pos / 128];
            const float* a = p.cache_b_pages + ((((size_t)page * 128 + pos % 128) * 2 + li) * 4 + ty) * 128 + kv * 64;
            for (int e = 0; e < 64; e += 8) { float x[8], y[8]; ld4f(a + e, x); ld4f(a + e + 4, x + 4); ld8(w + l * 64 + e, y);
#pragma unroll
                for (int q = 0; q < 8; ++q) acc += bf2f(f2bf(x[q])) * y[q]; }
        }
        p.hid_s[((((size_t)li * 2 + ty) * NS * 2 + nk) * CSTR + c) * 128 + j] = silu_f(acc);
    }
}
__device__ __forceinline__ void nv_cmp2_p(const Params& p, int li, long gtid, long gsz) {
    GS_LOOP(it, (long)2 * NB * 2 * NC_P * 64) {
        const int e = it % 64, c = (it / 64) % NC_P, nk = (it / (64 * NC_P)) % (NB * 2), ty = it / ((long)64 * NC_P * NB * 2);
        const float* hd = p.hid + (((size_t)ty * NB * 2 + nk) * CSTR + c) * 128;
        const bf16_t* w = p.w2t + ((size_t)(li * 2 + ty) * 64 + e) * 128;
        float acc = 0.f;
        for (int j = 0; j < 128; ++j) acc += bf2f(f2bf(hd[j])) * bf2f(w[j]);
        if (ty == 0) p.kcmp[((size_t)nk * CSTR + c) * 64 + e] = f2bf(acc);
        else p.vcmpt[((size_t)nk * 64 + e) * CSTR + c] = f2bf(acc);
    }
}
__device__ __forceinline__ void nv_cmp2_s(const Params& p, int li, long gtid, long gsz) {
    GS_LOOP(it, (long)2 * NS * 2 * NC_S * 64) {
        const int e = it % 64, c = (it / 64) % NC_S, nk = (it / (64 * NC_S)) % (NS * 2), ty = it / ((long)64 * NC_S * NS * 2);
        const float* hd = p.hid_s + ((((size_t)li * 2 + ty) * NS * 2 + nk) * CSTR + c) * 128;
        const bf16_t* w = p.w2t + ((size_t)(li * 2 + ty) * 64 + e) * 128;
        float acc = 0.f;
        for (int j = 0; j < 128; ++j) acc += bf2f(f2bf(hd[j])) * bf2f(w[j]);
        if (ty == 0) p.kcmp_s[(((size_t)li * NS * 2 + nk) * CSTR + c) * 64 + e] = f2bf(acc);
        else p.vcmpt_s[(((size_t)li * NS * 2 + nk) * 64 + e) * CSTR + c] = f2bf(acc);
    }
}

__device__ __forceinline__ void nv_nsa_cmp(const Params& p, int i, int r0, long gtid, long gsz) {
    const int li = i >> 1;
    GS_LOOP(it, (long)(M - r0) * 12) {
        const int r = r0 + it % (M - r0), hd = it / (M - r0), kv = hd / 6;
        const bool samp = r >= MP;
        const int n = samp ? r - MP : r / S, tq = samp ? PL : r % S;
        const int nc = samp ? NC_S : NC_P;
        const bf16_t* kb = samp ? p.kcmp_s + ((size_t)li * NS * 2 + n * 2 + kv) * CSTR * 64 : p.kcmp + ((size_t)n * 2 + kv) * CSTR * 64;
        const bf16_t* vb = samp ? p.vcmpt_s + ((size_t)li * NS * 2 + n * 2 + kv) * 64 * CSTR : p.vcmpt + ((size_t)n * 2 + kv) * 64 * CSTR;
        float q[64], o[64];
        LD64_B(q, p.proj + (size_t)r * WP + hd * 64);
        const float sl = slope_b(hd);
        float* pc = p.pc + ((size_t)r * 12 + hd) * CSTR;
        float mx = -INFINITY;
        for (int c = 0; c < nc; ++c) {
            const int ce = 16 * c + 31; if (ce > tq) break;
            float sc = 0.f;
            DOT64_B(sc, q, kb + c * 64);
            sc = sc * SCALE - sl * (float)(tq - ce);
            pc[c] = sc; mx = fmaxf(mx, sc);
        }
        float den = 0.f;
        for (int c = 0; c < nc; ++c) { const int ce = 16 * c + 31; if (ce > tq) break; den += expf(pc[c] - mx); }
        den = fmaxf(den, 1e-30f);
#pragma unroll
        for (int e = 0; e < 64; ++e) o[e] = 0.f;
        for (int c = 0; c < CSTR; ++c) {
            const int ce = 16 * c + 31;
            if (c < nc && ce <= tq) {
                const float pe = expf(pc[c] - mx) / den; pc[c] = pe;
#pragma unroll
                for (int e = 0; e < 64; ++e) o[e] += pe * bf2f(vb[(size_t)e * CSTR + c]);
            } else pc[c] = 0.f;
        }
        float* oc = p.oc + ((size_t)r * 12 + hd) * 64;
#pragma unroll
        for (int e = 0; e < 64; ++e) oc[e] = o[e];
    }
}
__device__ __forceinline__ void nv_nsa_imp(const Params& p, int r0, long gtid, long gsz) {
    GS_LOOP(it0, (long)(M - r0) * 2 * IMPSTR) {
        const long it = it0 + (long)r0 * 2 * IMPSTR;
        const int b = it % IMPSTR, kv = (it / IMPSTR) % 2, r = it / (2 * IMPSTR);
        const bool samp = r >= MP;
        const int tq = samp ? PL : r % S, nsel = samp ? NSEL_S : NSEL_P;
        float v = -INFINITY;
        if (b < nsel) {
            float a = 0.f;
            for (int g = 0; g < 6; ++g) {
                const float* pc = p.pc + ((size_t)r * 12 + kv * 6 + g) * CSTR;
                for (int ii = 4 * b; ii < 4 * b + 4; ++ii) {
                    if (ii < CSTR) a += pc[ii];
                    if (ii - 1 >= 0 && ii - 1 < CSTR) a += pc[ii - 1];
                }
            }
            const int cur = tq / 64;
            const bool forced = (b == 0) || (b == cur) || (b == cur - 1);
            v = (b * 64 > tq) ? -INFINITY : (forced ? 1e4f : a);
        }
        p.imp[it] = v;
    }
}
__device__ __forceinline__ void nv_nsa_topk(const Params& p, int r0, long gtid, long gsz) {
    GS_LOOP(it0, (long)(M - r0) * 2 * IMPSTR) {
        const long it = it0 + (long)r0 * 2 * IMPSTR;
        const int b = it % IMPSTR, r = it / (2 * IMPSTR);
        const int nsel = r >= MP ? NSEL_S : NSEL_P;
        const float* im = p.imp + (it - b);
        int sel = 0;
        if (b < nsel) {
            const float v = im[b]; int rank = 0;
            for (int b2 = 0; b2 < nsel; ++b2) { const float w = im[b2]; rank += (w > v || (w == v && b2 < b)) ? 1 : 0; }
            sel = rank < 16 ? 1 : 0;
        }
        p.selb[it] = sel;
    }
}
__device__ __forceinline__ void nv_nsa_main(const Params& p, int i, int r0, long gtid, long gsz) {
    const int li = i >> 1;
    GS_LOOP(it, (long)(M - r0) * 12) {
        const int r = r0 + it % (M - r0), hd = it / (M - r0), kv = hd / 6;
        const bool samp = r >= MP;
        const int n = samp ? r - MP : r / S, tq = samp ? PL : r % S;
        const int nsel = samp ? NSEL_S : NSEL_P;
        const float sl = slope_b(hd);
        const int* selb = p.selb + ((size_t)r * 2 + kv) * IMPSTR;
        float o[64]; float mx = -INFINITY, den = 0.f;
        const bf16_t* q = p.proj + (size_t)r * WP + hd * 64;
#pragma unroll
        for (int e = 0; e < 64; ++e) o[e] = 0.f;
        for (int b = 0; b < nsel; ++b) {
            if (!selb[b]) continue;
            for (int s = 0; s < 64; ++s) {
                const int kp = b * 64 + s; if (kp > tq) break;
                float sc = 0.f; const float bias = sl * (float)(tq - kp);
                if (!samp) {
                    const bf16_t* k = p.proj + (size_t)(n * S + kp) * WP + 768 + 2 * 128 + kv * 64;
                    const bf16_t* vt = p.vts + ((size_t)n * 2 + kv) * 64 * S + vt_pos(kp);
                    DOTM_B(sc, q, k); sc = sc * SCALE - bias; OSM_UPD_T(sc, vt, VT_LD);
                } else if (kp < PL) {
                    const int page = p.page_table[n * NPAGES + kp / 128];
                    const float* k = p.cache_b_pages + ((((size_t)page * 128 + kp % 128) * 2 + li) * 4 + 2) * 128 + kv * 64;
                    DOTM_F(sc, q, k); sc = sc * SCALE - bias; OSM_UPD_F(sc, k + 128);
                } else {
                    const bf16_t* k = p.proj + (size_t)r * WP + 768 + 2 * 128 + kv * 64;
                    DOTM_B(sc, q, k); sc = sc * SCALE - bias; OSM_UPD_B(sc, k + 128);
                }
            }
        }
        const float g0 = sigmoid_f(bf2f(p.proj[(size_t)r * WP + 1536 + hd * 3 + 0]));
        const float g1 = sigmoid_f(bf2f(p.proj[(size_t)r * WP + 1536 + hd * 3 + 1]));
        const float g2 = sigmoid_f(bf2f(p.proj[(size_t)r * WP + 1536 + hd * 3 + 2]));
        float* oc = p.oc + ((size_t)r * 12 + hd) * 64;
        const float inv_s = den > 0.f ? 1.0f / den : 0.f;
#pragma unroll
        for (int e = 0; e < 64; ++e) oc[e] = g0 * oc[e] + g1 * o[e] * inv_s;
        mx = -INFINITY; den = 0.f;
#pragma unroll
        for (int e = 0; e < 64; ++e) o[e] = 0.f;
        for (int dw = 512; dw >= 0; --dw) {
            const int kp = tq - dw; if (kp < 0) continue;
            float sc = 0.f; const float bias = sl * (float)dw;
            if (!samp) {
                const bf16_t* k = p.proj + (size_t)(n * S + kp) * WP + 768 + 4 * 128 + kv * 64;
                const bf16_t* vt = p.vtw + ((size_t)n * 2 + kv) * 64 * S + vt_pos(kp);
                DOTM_B(sc, q, k); sc = sc * SCALE - bias; OSM_UPD_T(sc, vt, VT_LD);
            } else if (dw > 0) {
                const int idx = LBW - dw; if (idx < 0) continue;
                const float* k = p.cache_b_win + ((((size_t)li * NS + n) * LBW + idx) * 2) * 128 + kv * 64;
                DOTM_F(sc, q, k); sc = sc * SCALE - bias; OSM_UPD_F(sc, k + 128);
            } else {
                const bf16_t* k = p.proj + (size_t)r * WP + 768 + 4 * 128 + kv * 64;
                DOTM_B(sc, q, k); sc = sc * SCALE - bias; OSM_UPD_B(sc, k + 128);
            }
        }
        const float inv_w = den > 0.f ? 1.0f / den : 0.f;
        const bf16_t* gm = p.proj + (size_t)r * WP + 1572 + hd * 64;
        bf16_t* z = p.z + (size_t)r * 1024 + hd * 64;
#pragma unroll
        for (int e = 0; e < 64; ++e) z[e] = f2bf((oc[e] + g2 * o[e] * inv_w) * silu_f(bf2f(gm[e])));
    }
}

__device__ __forceinline__ void nv_conv_cache(const Params& p, long gtid, long gsz) {
    GS_LOOP(it, (long)NS * PL * 2 * 32) {
        const int e8 = it % 8, kv = (it / 8) % 2, ty = (it / 16) % 2, li = (it / 32) % 2; const long np = it / 64;
        const int pos = np % PL, n = np / PL;
        const int page = p.page_table[n * NPAGES + pos / 128];
        const float* a = p.cache_b_pages + ((((size_t)page * 128 + pos % 128) * 2 + li) * 4 + ty) * 128 + kv * 64 + e8 * 8;
        float v[8]; ld4f(a, v); ld4f(a + 4, v + 4);
        st8_bf(p.cachec + (((((size_t)li * 2 + ty) * NS + n) * 2 + kv) * PL + pos) * 64 + e8 * 8, v);
    }
}
__device__ __forceinline__ void nv_pq_s(const Params& p, long gtid, long gsz) {
    GS_LOOP(it, (long)4 * NS * 2 * HB_S * 256) {
        const int jj = it % 256; const long row = it / 256; const int lt = row / (NS * 2 * HB_S);
        p.pq_s[it] = f2bf(dot_bb(p.cachec + (size_t)row * 1024, p.w1pq + ((size_t)lt * 256 + jj) * 1024, 1024));
    }
}
__device__ __forceinline__ void nv_pq_p(const Params& p, int li, long gtid, long gsz) {
    GS_LOOP(it, (long)2 * NB * 2 * HB_P * 256) {
        const int jj = it % 256; const long row = it / 256; const int ty = row / (NB * 2 * HB_P); const long rr = row % (NB * 2 * HB_P);
        p.pq_p[it] = f2bf(dot_bb((ty == 0 ? +p.kc : +p.vc) + (size_t)rr * 1024, p.w1pq + ((size_t)(li * 2 + ty) * 256 + jj) * 1024, 1024));
    }
}
__device__ __forceinline__ void cmpc_one(const bf16_t* pq, const float* cb, const bf16_t* w2t, int c, int e, float& out) {
    const bf16_t* w = w2t + (size_t)e * 128;
    float acc = 0.f;
    for (int j = 0; j < 128; ++j) {
        const float pre = bf2f(pq[(size_t)c * 256 + j]) + bf2f(pq[(size_t)(c + 1) * 256 + 128 + j]) + cb[j];
        acc += bf2f(f2bf(silu_f(pre))) * bf2f(w[j]);
    }
    out = acc;
}
__device__ __forceinline__ void nv_cmpc_s(const Params& p, long gtid, long gsz) {
    GS_LOOP(it, (long)4 * NS * 2 * NC_S * 64) {
        const int e = it % 64, c = (it / 64) % NC_S, nk = (it / (64 * NC_S)) % (NS * 2), lt = it / ((long)64 * NC_S * NS * 2);
        const int li = lt >> 1, ty = lt & 1;
        float acc; cmpc_one(p.pq_s + ((size_t)lt * NS * 2 + nk) * HB_S * 256, p.cb + lt * 128, p.w2t + (size_t)lt * 64 * 128, c, e, acc);
        if (ty == 0) p.kcmp_s[(((size_t)li * NS * 2 + nk) * CSTR + c) * 64 + e] = f2bf(acc);
        else p.vcmpt_s[(((size_t)li * NS * 2 + nk) * 64 + e) * CSTR + c] = f2bf(acc);
    }
}
__device__ __forceinline__ void nv_cmpc_p(const Params& p, int li, long gtid, long gsz) {
    GS_LOOP(it, (long)2 * NB * 2 * NC_P * 64) {
        const int e = it % 64, c = (it / 64) % NC_P, nk = (it / (64 * NC_P)) % (NB * 2), ty = it / ((long)64 * NC_P * NB * 2);
        const int lt = li * 2 + ty;
        float acc; cmpc_one(p.pq_p + ((size_t)ty * NB * 2 + nk) * HB_P * 256, p.cb + lt * 128, p.w2t + (size_t)lt * 64 * 128, c, e, acc);
        if (ty == 0) p.kcmp[((size_t)nk * CSTR + c) * 64 + e] = f2bf(acc);
        else p.vcmpt[((size_t)nk * 64 + e) * CSTR + c] = f2bf(acc);
    }
}

#define XB_TMO      128
#define XB_XCNT(j)  (256  + 64 * (j))
#define XB_XSUB(j)  (1280 + 64 * (j))
#define XB_XGEN(j)  (2304 + 64 * (j))
#define XB_TOP      3328
#define XB_TOPGEN   3392
#define XCD_BAR_WORDS 3456
#define XB_SPIN_CAP (1u << 22)
#define LAS __attribute__((address_space(3)))

__device__ __forceinline__ unsigned xb_ld(unsigned* p)              { return __hip_atomic_load(p, __ATOMIC_RELAXED, __HIP_MEMORY_SCOPE_AGENT); }
__device__ __forceinline__ unsigned xb_add(unsigned* p, unsigned v) { return __hip_atomic_fetch_add(p, v, __ATOMIC_RELAXED, __HIP_MEMORY_SCOPE_AGENT); }
__device__ __forceinline__ unsigned xb_xcc_id() { return (unsigned)__builtin_amdgcn_readfirstlane((int)((unsigned)__builtin_amdgcn_s_getreg((3 << 11) | 20) & 0xFu)); }
#define XB_SPIN(cond, bar) do { unsigned _sp = 0; while (cond) { __builtin_amdgcn_s_sleep(1); \
    if ((++_sp & 255u) == 0u) { if (xb_ld(&(bar)[XB_TMO])) break; if (_sp > XB_SPIN_CAP) { atomicAdd(&(bar)[XB_TMO], 1u); break; } } } } while (0)

struct XcdBarrier {
    unsigned* bar; unsigned x;
    volatile LAS unsigned* st;
};

__device__ __forceinline__ XcdBarrier xcd_barrier_post(unsigned* bar, volatile LAS unsigned* st) {
    XcdBarrier b; b.bar = bar; b.x = xb_xcc_id(); b.st = st;
    if (threadIdx.x == 0) (void)xb_add(&bar[XB_XCNT(b.x)], 1u);
    return b;
}
__device__ __forceinline__ void xcd_barrier_complete(unsigned* bar, unsigned x, unsigned& nloc, unsigned& nx) {
    const unsigned G = gridDim.x * gridDim.y * gridDim.z;
    unsigned sum, cnt, mine, sp = 0u;
    for (;;) {
        sum = 0u; cnt = 0u; mine = 0u;
#pragma unroll
        for (unsigned j = 0; j < 16; ++j) { const unsigned c = xb_ld(&bar[XB_XCNT(j)]); sum += c; cnt += (c > 0u) ? 1u : 0u; mine = (j == x) ? c : mine; }
        if (sum == G) break;
        __builtin_amdgcn_s_sleep(1);
        if ((++sp & 255u) == 0u) { if (xb_ld(&bar[XB_TMO])) break; if (sp > XB_SPIN_CAP) { atomicAdd(&bar[XB_TMO], 1u); break; } }
    }
    nloc = mine > 0u ? mine : 1u; nx = cnt > 0u ? cnt : 1u;
}

__device__ __forceinline__ void xcd_barrier(const XcdBarrier& b) {
    asm volatile("s_waitcnt vmcnt(0)" ::: "memory");
    __syncthreads();
    if (threadIdx.x == 0) {
        unsigned* bar = b.bar; asm volatile("" : "+s"(bar)); unsigned bx = b.x; asm volatile("" : "+s"(bx));
        __builtin_amdgcn_s_waitcnt(0);
        unsigned nloc = b.st[0], nx = b.st[1];
        if (nloc == 0u) { xcd_barrier_complete(bar, bx, nloc, nx); b.st[0] = nloc; b.st[1] = nx; }
        const unsigned old = xb_add(&bar[XB_XSUB(bx)], 1u);
        const unsigned gen = old / nloc;
        if (old + 1u == (gen + 1u) * nloc) {
            __builtin_amdgcn_fence(__ATOMIC_RELEASE, "agent");
            asm volatile("s_waitcnt vmcnt(0)" ::: "memory");
            const unsigned og = xb_add(&bar[XB_TOP], 1u);
            const unsigned tg = og / nx;
            if (og + 1u == (tg + 1u) * nx) xb_add(&bar[XB_TOPGEN], 1u);
            else XB_SPIN(xb_ld(&bar[XB_TOPGEN]) == tg, bar);
            __builtin_amdgcn_fence(__ATOMIC_ACQUIRE, "agent");
            xb_add(&bar[XB_XGEN(bx)], 1u);
            asm volatile("s_waitcnt vmcnt(0)" ::: "memory");
        } else {
            XB_SPIN(xb_ld(&bar[XB_XGEN(bx)]) == gen, bar);
            __builtin_amdgcn_fence(__ATOMIC_ACQUIRE, "agent");
            asm volatile("s_waitcnt vmcnt(0)" ::: "memory");
        }
    }
    __syncthreads();
}


namespace pg8 {
#define PG8_LAS __attribute__((address_space(3)))
typedef unsigned short bf16_t;
typedef short bf16x8 __attribute__((ext_vector_type(8)));
typedef float f32x4 __attribute__((ext_vector_type(4)));
typedef unsigned u32x4 __attribute__((ext_vector_type(4)));
constexpr int BM = 256, BK = 64, HALF = 128, HTB = HALF * BK * 2  , STAGE_BYTES = 8 * HTB, NXCD = 8, WGM = 8;

__host__ __device__ __forceinline__ int lds_byte(int r, int c) { const int st = (r >> 4) * 2 + (c >> 5), rr = r & 15, cc = c & 31, ob = rr * 64 + cc * 2; return st * 1024 + (ob ^ (((ob >> 9) & 1) << 5)); }
__host__ __device__ __forceinline__ void stage_rc(int b, int& R, int& C) { const int st = b / 1024, sb = b % 1024, swz = sb ^ (((sb >> 9) & 1) << 5); R = (st >> 1) * 16 + swz / 64; C = (st & 1) * 32 + (swz % 64) / 2; }
__host__ __device__ __forceinline__ int perm32(int rho) { const int n = rho >> 4, i = rho & 15; return 8 * (i >> 2) + 4 * n + (i & 3); }

struct Unit { int pm, pn; };
struct Gemm { const bf16_t* A; const bf16_t* Bt; int M, N, K; };

struct StaticOrder {
    int nM, nN, nwg, G, c;
    __host__ __device__ void init(int M, int N, int G_, int c_) { nM = M / BM; nN = N / BM; nwg = nM * nN; G = G_; c = c_; }
    __host__ __device__ bool next(int i, Unit& u) const {
        const long L = (long)i * G + c; if (L >= nwg) return false;
        int wgid = (int)L; { const int q = nwg / NXCD, r = nwg % NXCD, xcd = wgid % NXCD, off = wgid / NXCD; wgid = (xcd < r ? xcd * (q + 1) : r * (q + 1) + (xcd - r) * q) + off; }
        const int nig = WGM * nN, gid = wgid / nig, fm = gid * WGM, gsz = (nM - fm) < WGM ? (nM - fm) : WGM;
        u.pm = fm + ((wgid % nig) % gsz); u.pn = (wgid % nig) / gsz; return true;
    }
    __device__ __forceinline__ void a_ready(const Unit&) const {}
    __device__ __forceinline__ void done(const Unit&) const {}
};
struct CountedOrder : StaticOrder {
    const unsigned* ready; unsigned need; unsigned* tmo;
    __device__ __forceinline__ void a_ready(const Unit& u) const {
        if (threadIdx.x < 64) {
            const unsigned long long t0 = __builtin_amdgcn_s_memrealtime(); unsigned polls = 0;
            while ((unsigned)__builtin_amdgcn_readfirstlane(__hip_atomic_load(ready + 64 * u.pm, __ATOMIC_RELAXED, __HIP_MEMORY_SCOPE_AGENT)) < need) {
                if ((++polls & 255u) == 0u && __builtin_amdgcn_readfirstlane(__hip_atomic_load(tmo, __ATOMIC_RELAXED, __HIP_MEMORY_SCOPE_AGENT)) != 0u) break;
                if (__builtin_amdgcn_s_memrealtime() - t0 > 2000000ull) {
                    if (threadIdx.x == 0) { unsigned expect = 0u; __hip_atomic_compare_exchange_strong(tmo + 1, &expect, 0x600u | (unsigned)(u.pm & 0xff), __ATOMIC_RELAXED, __ATOMIC_RELAXED, __HIP_MEMORY_SCOPE_AGENT); __hip_atomic_store(tmo, 1u, __ATOMIC_RELAXED, __HIP_MEMORY_SCOPE_AGENT); }
                    break; }
                __builtin_amdgcn_s_sleep(2); }
            __builtin_amdgcn_fence(__ATOMIC_ACQUIRE, "agent");
            asm volatile("s_waitcnt vmcnt(0)" ::: "memory");
        }
#if !defined(BROKEN_HOOK_NO_BARRIER)
        asm volatile("" ::: "memory"); __builtin_amdgcn_s_barrier(); asm volatile("" ::: "memory");
#endif
    }
};

__device__ __forceinline__ unsigned cvt_pk_bf16(float lo, float hi) { unsigned r; asm volatile("v_cvt_pk_bf16_f32 %0, %1, %2" : "=v"(r) : "v"(lo), "v"(hi)); return r; }
typedef float f32x2 __attribute__((ext_vector_type(2)));
__device__ __forceinline__ f32x2 gelu_pk(f32x2 v) {
    const f32x2 av = __builtin_elementwise_abs(v), d = av * 0.2316418882f + 1.0f;
    f32x2 t; t.x = __builtin_amdgcn_rcpf(d.x); t.y = __builtin_amdgcn_rcpf(d.y);
    f32x2 q = t * 0.5307027145f + (-0.7265760135f); q = q * t + 0.7107068705f; q = q * t + (-0.142248368f); q = q * t + 0.127414796f; q = q * t;
    const f32x2 s = (v * v) * (-0.72134752044f);
    f32x2 e; e.x = __builtin_amdgcn_exp2f(s.x); e.y = __builtin_amdgcn_exp2f(s.y);
    const f32x2 m = v * (q * e), r = v - m;
    f32x2 o; o.x = v.x < 0.f ? m.x : r.x; o.y = v.y < 0.f ? m.y : r.y; return o;
}

struct EpiF32 {
    static constexpr bool PERM = false, AFTER_DRAIN = false;
    float* C; int ldc; const float* bias;
    __device__ __forceinline__ void operator()(const f32x4 (&acc)[2][2][4][2], const Unit& u, int wr, int wc, int fr, int fq) const {
        const int row0 = u.pm * BM + wr * 64 + fr, col0 = u.pn * BM + wc * 32 + 4 * fq;
        f32x4 bv[2][2];
#pragma unroll
        for (int bj = 0; bj < 2; ++bj)
#pragma unroll
            for (int n = 0; n < 2; ++n) bv[bj][n] = bias ? *(const f32x4*)(bias + col0 + bj * HALF + n * 16) : (f32x4){0.f, 0.f, 0.f, 0.f};
#pragma unroll
        for (int ai = 0; ai < 2; ++ai)
#pragma unroll
            for (int m = 0; m < 4; ++m) { float* rowp = C + (size_t)(row0 + ai * HALF + m * 16) * ldc + col0;
#pragma unroll
                for (int bj = 0; bj < 2; ++bj)
#pragma unroll
                    for (int n = 0; n < 2; ++n) *(f32x4*)(rowp + bj * HALF + n * 16) = acc[ai][bj][m][n] + bv[bj][n]; }
    }
};
template <int ACT  > struct EpiBf16 {
    static constexpr bool PERM = true, AFTER_DRAIN = false;
    bf16_t* O; int ldc; const float* bias; int split_cols; size_t split_stride;
    __device__ __forceinline__ void operator()(const f32x4 (&acc)[2][2][4][2], const Unit& u, int wr, int wc, int fr, int fq) const {
        const int row0 = u.pm * BM + wr * 64 + fr; int colt = u.pn * BM; bf16_t* base = O;
        if (split_cols) { const int t = colt / split_cols; base += (size_t)t * split_stride; colt -= t * split_cols; }
        const int col0 = colt + wc * 32 + 8 * fq, bcol0 = u.pn * BM + wc * 32 + 8 * fq;
        f32x4 bv[2][2];
#pragma unroll
        for (int bj = 0; bj < 2; ++bj)
#pragma unroll
            for (int n = 0; n < 2; ++n) bv[bj][n] = bias ? *(const f32x4*)(bias + bcol0 + bj * HALF + 4 * n) : (f32x4){0.f, 0.f, 0.f, 0.f};
#pragma unroll
        for (int ai = 0; ai < 2; ++ai)
#pragma unroll
            for (int m = 0; m < 4; ++m) { bf16_t* rowp = base + (size_t)(row0 + ai * HALF + m * 16) * ldc + col0;
#pragma unroll
                for (int bj = 0; bj < 2; ++bj) { f32x4 v0 = acc[ai][bj][m][0] + bv[bj][0], v1 = acc[ai][bj][m][1] + bv[bj][1];
                    if (ACT == 1) { f32x2 a = gelu_pk((f32x2){v0[0], v0[1]}), b = gelu_pk((f32x2){v0[2], v0[3]}), c = gelu_pk((f32x2){v1[0], v1[1]}), d = gelu_pk((f32x2){v1[2], v1[3]});
                        v0 = (f32x4){a.x, a.y, b.x, b.y}; v1 = (f32x4){c.x, c.y, d.x, d.y}; }
                    if (ACT == 2) {
#pragma unroll
                        for (int j = 0; j < 4; ++j) { v0[j] = 0.5f * v0[j] * (1.0f + erff(v0[j] * 0.70710678f)); v1[j] = 0.5f * v1[j] * (1.0f + erff(v1[j] * 0.70710678f)); } }
                    u32x4 w; w.x = cvt_pk_bf16(v0[0], v0[1]); w.y = cvt_pk_bf16(v0[2], v0[3]); w.z = cvt_pk_bf16(v1[0], v1[1]); w.w = cvt_pk_bf16(v1[2], v1[3]);
                    *(u32x4*)(rowp + bj * HALF) = w; } }
    }
};

struct PanelStats {
    unsigned* xbuf;
    unsigned* cnt;
    unsigned* tmo;
    int ntn; float eps;
    unsigned code;
    __device__ __forceinline__ bool run(const f32x4 (&v)[2][2][4][2], const Unit& u, int wr, int wc, int fr, int fq, PG8_LAS unsigned char* lds, int wid, int lane) const {
        typedef float f32x2v __attribute__((ext_vector_type(2)));
        PG8_LAS f32x2v* P = (PG8_LAS f32x2v*)lds;
        PG8_LAS f32x2v* S = (PG8_LAS f32x2v*)(lds + 8192);
        PG8_LAS unsigned* flag = (PG8_LAS unsigned*)(lds + 8192 + 2048);
#pragma unroll
        for (int ai = 0; ai < 2; ++ai)
#pragma unroll
            for (int m = 0; m < 4; ++m) {
                float s = 0.f;
#pragma unroll
                for (int bj = 0; bj < 2; ++bj)
#pragma unroll
                    for (int n = 0; n < 2; ++n) { const f32x4 x = v[ai][bj][m][n]; s += (x[0] + x[1]) + (x[2] + x[3]); }
                s += __shfl_xor(s, 16); s += __shfl_xor(s, 32);
                const float mw = s * (1.0f / 64.0f); float q = 0.f;
#pragma unroll
                for (int bj = 0; bj < 2; ++bj)
#pragma unroll
                    for (int n = 0; n < 2; ++n) { const f32x4 d = v[ai][bj][m][n] - mw; q += (d[0] * d[0] + d[1] * d[1]) + (d[2] * d[2] + d[3] * d[3]); }
                q += __shfl_xor(q, 16); q += __shfl_xor(q, 32);
                if (fq == 0) P[(ai * HALF + wr * 64 + m * 16 + fr) * 4 + wc] = (f32x2v){mw, q};
            }
        asm volatile("s_waitcnt lgkmcnt(0)" ::: "memory"); __builtin_amdgcn_s_barrier(); asm volatile("" ::: "memory");
#if defined(BROKEN_NO_WAIT)
        if (blockIdx.x >= 64) { const long long t0 = clock64(); while (clock64() - t0 < 60000) __builtin_amdgcn_s_sleep(8); }
#endif
        const int row = wid * 32 + (lane & 31);
        if (lane < 32) {
            const f32x2v a = P[row * 4 + 0], b = P[row * 4 + 1], c = P[row * 4 + 2], d = P[row * 4 + 3];
            const float mt = (a.x + b.x + c.x + d.x) * 0.25f;
            const float da = a.x - mt, db = b.x - mt, dc = c.x - mt, dd = d.x - mt;
            const float m2 = (a.y + b.y) + (c.y + d.y) + 64.0f * ((da * da + db * db) + (dc * dc + dd * dd));
            unsigned long long* slot = (unsigned long long*)xbuf + ((size_t)(u.pm * BM + row) * 4 + u.pn);
            __hip_atomic_store(slot, ((unsigned long long)__float_as_uint(m2) << 32) | __float_as_uint(mt), __ATOMIC_RELAXED, __HIP_MEMORY_SCOPE_AGENT);
        }
        asm volatile("s_waitcnt vmcnt(0)" ::: "memory");
        if (lane == 0) __hip_atomic_fetch_add(cnt + 64 * u.pm, 1u, __ATOMIC_RELAXED, __HIP_MEMORY_SCOPE_AGENT);
        if (wid == 0) {
            bool dead = false; const unsigned long long t0 = __builtin_amdgcn_s_memrealtime(); const unsigned want = 8u * (unsigned)ntn;
            for (;;) {
#if defined(BROKEN_NO_WAIT)
                break;
#endif
                if ((unsigned)__builtin_amdgcn_readfirstlane(__hip_atomic_load(cnt + 64 * u.pm, __ATOMIC_RELAXED, __HIP_MEMORY_SCOPE_AGENT)) >= want) break;
                if (__builtin_amdgcn_s_memrealtime() - t0 > 2000000ull) {
                    if (lane == 0) { unsigned expect = 0u; __hip_atomic_compare_exchange_strong(tmo + 1, &expect, code | (unsigned)(u.pm & 0xff), __ATOMIC_RELAXED, __ATOMIC_RELAXED, __HIP_MEMORY_SCOPE_AGENT);
                                     __hip_atomic_store(tmo, 1u, __ATOMIC_RELAXED, __HIP_MEMORY_SCOPE_AGENT); }
                    dead = true; break; }
                __builtin_amdgcn_s_sleep(2);
            }
            __builtin_amdgcn_fence(__ATOMIC_ACQUIRE, "agent");
            if (lane == 0) flag[0] = dead ? 1u : 0u;
        }
        asm volatile("s_waitcnt vmcnt(0) lgkmcnt(0)" ::: "memory"); __builtin_amdgcn_s_barrier(); asm volatile("" ::: "memory");
        const bool bad = flag[0] != 0u;
        if (lane < 32) {
            const unsigned long long* slot = (const unsigned long long*)xbuf + (size_t)(u.pm * BM + row) * 4; float mt[4], m2[4]; float ms = 0.f;
#pragma unroll
            for (int t = 0; t < 4; ++t) { if (t < ntn) { const unsigned long long w = __hip_atomic_load(slot + t, __ATOMIC_RELAXED, __HIP_MEMORY_SCOPE_AGENT); mt[t] = __uint_as_float((unsigned)w); m2[t] = __uint_as_float((unsigned)(w >> 32)); } else { mt[t] = 0.f; m2[t] = 0.f; } ms += mt[t]; }
            const float mean = ms / (float)ntn; float q = 0.f;
#pragma unroll
            for (int t = 0; t < 4; ++t) if (t < ntn) { const float dm = mt[t] - mean; q += m2[t] + 256.0f * dm * dm; }
            S[row] = (f32x2v){mean, 1.0f / sqrtf(q / (256.0f * (float)ntn) + eps)};
        }
        asm volatile("s_waitcnt lgkmcnt(0)" ::: "memory"); __builtin_amdgcn_s_barrier(); asm volatile("" ::: "memory");
        return bad;
    }
};
struct EpiLnRes {
    static constexpr bool PERM = false, AFTER_DRAIN = true;
    const float* base; float* out; int ldc; const float* bias; PanelStats st; unsigned poison;
    __device__ __forceinline__ void refuse(size_t i0, size_t stride, int M, int N) const { const float q = __builtin_nanf(""); for (size_t i = i0; i < (size_t)M * N; i += stride) out[(i / N) * ldc + i % N] = q;
        if (i0 == 0) { unsigned expect = 0u; __hip_atomic_compare_exchange_strong(st.tmo + 1, &expect, 0x7f0u, __ATOMIC_RELAXED, __ATOMIC_RELAXED, __HIP_MEMORY_SCOPE_AGENT); __hip_atomic_store(st.tmo, 1u, __ATOMIC_RELAXED, __HIP_MEMORY_SCOPE_AGENT); } }
    __device__ __forceinline__ void fused(f32x4 (&acc)[2][2][4][2], const Unit& u, int wr, int wc, int fr, int fq, PG8_LAS unsigned char* lds, int wid, int lane) const {
        typedef float f32x2v __attribute__((ext_vector_type(2)));
        const PG8_LAS f32x2v* S = (const PG8_LAS f32x2v*)(lds + 8192);
        const int col0 = u.pn * BM + wc * 32 + 4 * fq;
#pragma unroll
        for (int bj = 0; bj < 2; ++bj)
#pragma unroll
            for (int n = 0; n < 2; ++n) { const f32x4 bv = bias ? *(const f32x4*)(bias + col0 + bj * HALF + n * 16) : (f32x4){0.f, 0.f, 0.f, 0.f};
#pragma unroll
                for (int ai = 0; ai < 2; ++ai)
#pragma unroll
                    for (int m = 0; m < 4; ++m) acc[ai][bj][m][n] += bv; }
        const bool bad = st.run(acc, u, wr, wc, fr, fq, lds, wid, lane) || poison != 0u;
        const float qnan = __builtin_nanf("");
#pragma unroll
        for (int ai = 0; ai < 2; ++ai)
#pragma unroll
            for (int m = 0; m < 4; ++m) { const int r = ai * HALF + wr * 64 + m * 16 + fr; const f32x2v sr = S[r]; const size_t off = (size_t)(u.pm * BM + r) * ldc + col0;
#pragma unroll
                for (int bj = 0; bj < 2; ++bj)
#pragma unroll
                    for (int n = 0; n < 2; ++n) { const f32x4 bs = *(const f32x4*)(base + off + bj * HALF + n * 16); f32x4 o = bs + (acc[ai][bj][m][n] - sr.x) * sr.y;
                        if (bad) o = (f32x4){qnan, qnan, qnan, qnan}; *(f32x4*)(out + off + bj * HALF + n * 16) = o; }
                asm volatile("" ::: "memory"); }
    }
};
struct EpiLnResLn {
    static constexpr bool PERM = false, AFTER_DRAIN = true;
    const float* base; float* out; bf16_t* xn; int ldc; const float* bias; PanelStats st1, st2; unsigned poison;
    __device__ __forceinline__ void refuse(size_t i0, size_t stride, int M, int N) const { const float q = __builtin_nanf(""); for (size_t i = i0; i < (size_t)M * N; i += stride) { const size_t o = (i / N) * ldc + i % N; out[o] = q; xn[o] = (bf16_t)0x7fc0u; }
        if (i0 == 0) { unsigned expect = 0u; __hip_atomic_compare_exchange_strong(st1.tmo + 1, &expect, 0x7f0u, __ATOMIC_RELAXED, __ATOMIC_RELAXED, __HIP_MEMORY_SCOPE_AGENT); __hip_atomic_store(st1.tmo, 1u, __ATOMIC_RELAXED, __HIP_MEMORY_SCOPE_AGENT); } }
    __device__ __forceinline__ void fused(f32x4 (&acc)[2][2][4][2], const Unit& u, int wr, int wc, int fr, int fq, PG8_LAS unsigned char* lds, int wid, int lane) const {
        typedef float f32x2v __attribute__((ext_vector_type(2))); typedef unsigned u32x2v __attribute__((ext_vector_type(2)));
        const PG8_LAS f32x2v* S = (const PG8_LAS f32x2v*)(lds + 8192);
        const int col0 = u.pn * BM + wc * 32 + 4 * fq;
#pragma unroll
        for (int bj = 0; bj < 2; ++bj)
#pragma unroll
            for (int n = 0; n < 2; ++n) { const f32x4 bv = bias ? *(const f32x4*)(bias + col0 + bj * HALF + n * 16) : (f32x4){0.f, 0.f, 0.f, 0.f};
#pragma unroll
                for (int ai = 0; ai < 2; ++ai)
#pragma unroll
                    for (int m = 0; m < 4; ++m) acc[ai][bj][m][n] += bv; }
        bool bad = st1.run(acc, u, wr, wc, fr, fq, lds, wid, lane) || poison != 0u;
        const float qnan = __builtin_nanf("");
#pragma unroll
        for (int ai = 0; ai < 2; ++ai)
#pragma unroll
            for (int m = 0; m < 4; ++m) { const int r = ai * HALF + wr * 64 + m * 16 + fr; const f32x2v sr = S[r]; const size_t off = (size_t)(u.pm * BM + r) * ldc + col0;
#pragma unroll
                for (int bj = 0; bj < 2; ++bj)
#pragma unroll
                    for (int n = 0; n < 2; ++n) { const f32x4 bs = *(const f32x4*)(base + off + bj * HALF + n * 16); acc[ai][bj][m][n] = bs + (acc[ai][bj][m][n] - sr.x) * sr.y; }
                asm volatile("" : "+v"(acc[ai][0][m][0]), "+v"(acc[ai][0][m][1]), "+v"(acc[ai][1][m][0]), "+v"(acc[ai][1][m][1]));
                if (m & 1) asm volatile("" ::: "memory"); }
        const bool bad1 = bad;
        bad = st2.run(acc, u, wr, wc, fr, fq, lds, wid, lane) || bad;
#pragma unroll
        for (int ai = 0; ai < 2; ++ai)
#pragma unroll
            for (int m = 0; m < 4; ++m) { const int r = ai * HALF + wr * 64 + m * 16 + fr; const f32x2v sr = S[r]; const size_t off = (size_t)(u.pm * BM + r) * ldc + col0;
#pragma unroll
                for (int bj = 0; bj < 2; ++bj)
#pragma unroll
                    for (int n = 0; n < 2; ++n) { const f32x4 x1 = acc[ai][bj][m][n]; *(f32x4*)(out + off + bj * HALF + n * 16) = bad1 ? (f32x4){qnan, qnan, qnan, qnan} : x1;
                        const f32x4 o = (x1 - sr.x) * sr.y; u32x2v w; w.x = cvt_pk_bf16(o[0], o[1]); w.y = cvt_pk_bf16(o[2], o[3]);
                        if (bad) { w.x = 0x7fc07fc0u; w.y = 0x7fc07fc0u; } *(u32x2v*)(xn + off + bj * HALF + n * 16) = w; }
                asm volatile("" ::: "memory"); }
    }
};

template <class Epi, class Sched, bool STAMP = false>
__device__ __forceinline__ void gemm_phase(PG8_LAS unsigned char* lds, const Gemm g, const Sched& S, const Epi& E, unsigned long long* stamps) {
    int tid_l = threadIdx.x; asm volatile("" : "+v"(tid_l));
    const int tid = tid_l, wid = __builtin_amdgcn_readfirstlane(tid >> 6), lane = tid & 63, wr = wid >> 2, wc = wid & 3, fr = lane & 15, fq = lane >> 4;
    const int K = g.K, nt = K / BK;
    int ts_lo = 0, ts_hi = 0, nts = 0; const unsigned long long rt_entry = STAMP ? (unsigned long long)wall_clock64() : 0ull;
#define PG8_STAMP() do { if (STAMP && wid == 0 && nts < 64) { const unsigned long long _c = (unsigned long long)clock64(); \
        ts_lo = (lane == nts) ? (int)(unsigned)_c : ts_lo; ts_hi = (lane == nts) ? (int)(unsigned)(_c >> 32) : ts_hi; ++nts; } } while (0)
    PG8_STAMP();
    unsigned voffA[2], voffB[2];
#pragma unroll
    for (int i = 0; i < 2; ++i) { int R, C; stage_rc(tid * 16 + i * 8192, R, C); const int Rb = Epi::PERM ? ((R & ~31) + perm32(R & 31)) : R;
        voffA[i] = (unsigned)(R * K + C) * 2u; voffB[i] = (unsigned)(Rb * K + C) * 2u; }
    const size_t kstep = (size_t)(BK * 2);
    const size_t hstep = (size_t)HALF * K * 2;
    const size_t tstep = 2 * hstep;
    const unsigned ldsw = (unsigned)wid * 1024u;
    const int aoff = lds_byte(wr * 64 + fr, fq * 8), boff = lds_byte(wc * 32 + fr, fq * 8);
#define PG8_SA(b, h) (((b) * 2 + (h)) * HTB)
#define PG8_SB(b, h) ((4 + (b) * 2 + (h)) * HTB)
#define PG8_STAGE(bufoff, gbase, voff) do { _Pragma("unroll") for (int _i = 0; _i < 2; ++_i) \
        __builtin_amdgcn_global_load_lds((const unsigned*)((const char*)(gbase) + (voff)[_i]), (PG8_LAS unsigned*)(lds + (bufoff) + ldsw + _i * 8192), 16, 0, 0); } while (0)
#define PG8_LDA(dst, b, h) do { _Pragma("unroll") for (int m = 0; m < 4; ++m) _Pragma("unroll") for (int k = 0; k < 2; ++k) dst[m][k] = *(const PG8_LAS bf16x8*)(lds + PG8_SA(b, h) + aoff + m * 2048 + k * 1024); } while (0)
#define PG8_LDB(dst, b, h) do { _Pragma("unroll") for (int n = 0; n < 2; ++n) _Pragma("unroll") for (int k = 0; k < 2; ++k) dst[n][k] = *(const PG8_LAS bf16x8*)(lds + PG8_SB(b, h) + boff + n * 2048 + k * 1024); } while (0)
#define PG8_MMA(ai, bj, At, Bt) do { __builtin_amdgcn_s_setprio(1); _Pragma("unroll") for (int m = 0; m < 4; ++m) _Pragma("unroll") for (int n = 0; n < 2; ++n) _Pragma("unroll") for (int k = 0; k < 2; ++k) \
        acc[ai][bj][m][n] = __builtin_amdgcn_mfma_f32_16x16x32_bf16(Bt[n][k], At[m][k], acc[ai][bj][m][n], 0, 0, 0); __builtin_amdgcn_s_setprio(0); } while (0)
#define PG8_WAIT_V(n) asm volatile("s_waitcnt vmcnt(" #n ")" ::: "memory")
#define PG8_WAIT_L(n) asm volatile("s_waitcnt lgkmcnt(" #n ")" ::: "memory")
#define PG8_BAR __builtin_amdgcn_s_barrier()
#define PG8_SCHED __builtin_amdgcn_sched_barrier(0)
    Unit cur, nxt; int ui = 0;
    if (!S.next(0, cur)) return;
    f32x4 acc[2][2][4][2];
#pragma unroll
    for (int a = 0; a < 2; ++a)
#pragma unroll
        for (int b = 0; b < 2; ++b)
#pragma unroll
            for (int m = 0; m < 4; ++m)
#pragma unroll
                for (int n = 0; n < 2; ++n) acc[a][b][m][n] = (f32x4){0.f, 0.f, 0.f, 0.f};
    bf16x8 At[4][2], B0[2][2], B1[2][2];
    const char* cA = (const char*)g.A + (size_t)cur.pm * tstep; const char* cB = (const char*)g.Bt + (size_t)cur.pn * tstep;
    S.a_ready(cur);
    PG8_STAGE(PG8_SB(0, 0), cB, voffB); PG8_STAGE(PG8_SA(0, 0), cA, voffA); PG8_STAGE(PG8_SB(0, 1), cB + hstep, voffB); PG8_STAGE(PG8_SA(0, 1), cA + hstep, voffA);
    if (wr == 1) PG8_BAR;
    PG8_WAIT_V(4); PG8_BAR;
    PG8_STAGE(PG8_SB(1, 0), cB + kstep, voffB); PG8_STAGE(PG8_SA(1, 0), cA + kstep, voffA); PG8_STAGE(PG8_SB(1, 1), cB + hstep + kstep, voffB);
    PG8_WAIT_V(6); PG8_BAR;
    PG8_STAMP();
    for (;;) {
        const bool has_next = S.next(ui + 1, nxt);
        const char* nA = has_next ? (const char*)g.A + (size_t)nxt.pm * tstep : cA; const char* nB = has_next ? (const char*)g.Bt + (size_t)nxt.pn * tstep : cB;
        for (int t = 0; t < nt; t += 2) {
            const bool last = (t == nt - 2);
            const char* a1 = cA + (size_t)(t + 1) * kstep;
            const char* a2 = last ? nA : cA + (size_t)(t + 2) * kstep; const char* b2 = last ? nB : cB + (size_t)(t + 2) * kstep;
            const char* a3 = a2 + kstep; const char* b3 = b2 + kstep;
            if (last && has_next) S.a_ready(nxt);
            PG8_LDB(B0, 0, 0); PG8_SCHED; PG8_LDA(At, 0, 0); PG8_STAGE(PG8_SA(1, 1), a1 + hstep, voffA);
            PG8_WAIT_L(8); PG8_BAR; PG8_WAIT_L(0); PG8_MMA(0, 0, At, B0); PG8_BAR; PG8_SCHED;
            PG8_LDB(B1, 0, 1); PG8_STAGE(PG8_SB(0, 0), b2, voffB);
            PG8_BAR; PG8_WAIT_L(0); PG8_MMA(0, 1, At, B1); PG8_BAR;
            PG8_LDA(At, 0, 1); PG8_STAGE(PG8_SA(0, 0), a2, voffA);
            PG8_BAR; PG8_WAIT_L(0); PG8_MMA(1, 0, At, B0); PG8_BAR; PG8_SCHED;
            PG8_STAGE(PG8_SB(0, 1), b2 + hstep, voffB);
            PG8_WAIT_V(6); PG8_BAR; PG8_MMA(1, 1, At, B1); PG8_BAR;
            PG8_LDB(B0, 1, 0); PG8_SCHED; PG8_LDA(At, 1, 0); PG8_STAGE(PG8_SA(0, 1), a2 + hstep, voffA);
            PG8_WAIT_L(8); PG8_BAR; PG8_WAIT_L(0); PG8_MMA(0, 0, At, B0); PG8_BAR; PG8_SCHED;
            PG8_LDB(B1, 1, 1); PG8_STAGE(PG8_SB(1, 0), b3, voffB);
            PG8_BAR; PG8_WAIT_L(0); PG8_MMA(0, 1, At, B1); PG8_BAR;
            PG8_LDA(At, 1, 1); PG8_STAGE(PG8_SA(1, 0), a3, voffA);
            PG8_BAR; PG8_WAIT_L(0); PG8_MMA(1, 0, At, B0); PG8_BAR; PG8_SCHED;
            PG8_STAGE(PG8_SB(1, 1), b3 + hstep, voffB);
            PG8_WAIT_V(6); PG8_BAR; PG8_MMA(1, 1, At, B1); PG8_BAR;
        }
        PG8_STAMP();
        if constexpr (!Epi::AFTER_DRAIN) { E(acc, cur, wr, wc, fr, fq); S.done(cur); }
        PG8_STAMP();
        if (!has_next) break;
#pragma unroll
        for (int a = 0; a < 2; ++a)
#pragma unroll
            for (int b = 0; b < 2; ++b)
#pragma unroll
                for (int m = 0; m < 4; ++m)
#pragma unroll
                    for (int n = 0; n < 2; ++n) acc[a][b][m][n] = (f32x4){0.f, 0.f, 0.f, 0.f};
        cur = nxt; cA = nA; cB = nB; ++ui;
    }
    PG8_WAIT_V(0);
    if (wr == 0) PG8_BAR;
    PG8_BAR;
    if constexpr (Epi::AFTER_DRAIN) { E.fused(acc, cur, wr, wc, fr, fq, lds, wid, lane); S.done(cur); }
    PG8_STAMP();
    if (STAMP && wid == 0) { stamps[lane] = lane < nts ? (((unsigned long long)(unsigned)ts_hi << 32) | (unsigned)ts_lo) : 0ull;
        if (lane == 62) stamps[62] = rt_entry; if (lane == 63) stamps[63] = (unsigned long long)wall_clock64(); }
#undef PG8_STAMP
#undef PG8_SA
#undef PG8_SB
#undef PG8_STAGE
#undef PG8_LDA
#undef PG8_LDB
#undef PG8_MMA
#undef PG8_WAIT_V
#undef PG8_WAIT_L
#undef PG8_BAR
#undef PG8_SCHED
}
}

struct WsAlloc {
    char* base; size_t off;
    template <class T> T* get(size_t n) { T* r = (T*)(base + off); off += (n * sizeof(T) + 255) & ~(size_t)255; return r; }
};

static void fill_params(Params& p, void* const* d_in, void* d_out, void* d_ws) {
    memset(&p, 0, sizeof(p));
    p.x_prompt = (const float*)d_in[0]; p.x_sample = (const float*)d_in[1]; p.cache_mem_kv = (const float*)d_in[2];
    p.cache_a0 = (const float*)d_in[3]; p.cache_a1 = (const float*)d_in[4]; p.cache_a2 = (const float*)d_in[5];
    p.cache_b_pages = (const float*)d_in[6]; p.cache_b_win = (const float*)d_in[7]; p.page_table = (const int*)d_in[8];
    p.mem_prompt = (const float*)d_in[9]; p.norm_pre = (const float*)d_in[10]; p.norm_post = (const float*)d_in[11]; p.norm_mem = (const float*)d_in[12];
    p.w_mem_kv = (const float*)d_in[13]; p.w_in_a = (const float*)d_in[14]; p.w_out_a = (const float*)d_in[15]; p.w_in_b = (const float*)d_in[16];
    p.w_out_b = (const float*)d_in[17]; p.cmp_pos = (const float*)d_in[18]; p.cmp_w1 = (const float*)d_in[19]; p.cmp_w2 = (const float*)d_in[20];
    const size_t osz[13] = {(size_t)NB * S * D, (size_t)NS * D, (size_t)4 * NB * NM * 512, (size_t)2 * NB * WROWS0 * 512, (size_t)2 * NB * WROWS1 * 512, (size_t)2 * NB * WROWS2 * 512,
                            (size_t)NB * S * 1024, (size_t)2 * NB * WROWS1 * 256, (size_t)2 * NS * 512, (size_t)2 * NS * 512, (size_t)2 * NS * 512, (size_t)NS * 1024, (size_t)2 * NS * 256};
    float* o = (float*)d_out; float* outs[13];
    for (int i = 0; i < 13; ++i) { outs[i] = o; o += osz[i]; }
    p.o_y = outs[0]; p.o_ys = outs[1]; p.o_mem = outs[2]; p.o_pa0 = outs[3]; p.o_pa1 = outs[4]; p.o_pa2 = outs[5]; p.o_pb = outs[6]; p.o_pbw = outs[7];
    p.o_sa0 = outs[8]; p.o_sa1 = outs[9]; p.o_sa2 = outs[10]; p.o_sb = outs[11]; p.o_sbw = outs[12];
    WsAlloc a{(char*)d_ws, 0};
    p.bar = a.get<unsigned>(4096);
    p.wt_in = a.get<bf16_t>((size_t)4 * WP * D); p.wt_out = a.get<bf16_t>((size_t)4 * D * 1024); p.wt_mem = a.get<bf16_t>((size_t)4 * 512 * D);
    p.w1t = a.get<bf16_t>((size_t)4 * 128 * 2048); p.w2t = a.get<bf16_t>((size_t)4 * 64 * 128); p.cb = a.get<float>(4 * 128);
    p.xb = a.get<bf16_t>((size_t)MPAD * D); p.rstd = a.get<float>(MPAD); p.mrstd = a.get<float>(NB * NM);
    p.proj = a.get<bf16_t>((size_t)MPAD * WP); p.vta = a.get<bf16_t>((size_t)3 * NB * 4 * 64 * S);
    p.vts = a.get<bf16_t>((size_t)NB * 2 * 64 * S); p.vtw = a.get<bf16_t>((size_t)NB * 2 * 64 * S);
    p.kta = a.get<bf16_t>((size_t)3 * NB * 4 * 64 * S); p.kts = a.get<bf16_t>((size_t)NB * 2 * 64 * S); p.ktw = a.get<bf16_t>((size_t)NB * 2 * 64 * S);
    p.kc = a.get<bf16_t>((size_t)NB * 2 * S * 64); p.vc = a.get<bf16_t>((size_t)NB * 2 * S * 64);
    p.mkb = a.get<bf16_t>((size_t)4 * NB * 4 * NM * 64); p.mvt = a.get<bf16_t>((size_t)4 * NB * 4 * 64 * NM);
    p.hid = a.get<float>((size_t)2 * NB * 2 * CSTR * 128); p.hid_s = a.get<float>((size_t)2 * 2 * NS * 2 * CSTR * 128);
    p.kcmp = a.get<bf16_t>((size_t)NB * 2 * CSTR * 64); p.vcmpt = a.get<bf16_t>((size_t)NB * 2 * 64 * CSTR);
    p.kcmp_s = a.get<bf16_t>((size_t)2 * NS * 2 * CSTR * 64); p.vcmpt_s = a.get<bf16_t>((size_t)2 * NS * 2 * 64 * CSTR);
    p.z = a.get<bf16_t>((size_t)MPAD * 1024); p.y = a.get<float>((size_t)MPAD * D);
    p.pc = a.get<float>((size_t)M * 12 * CSTR); p.oc = a.get<float>((size_t)M * 12 * 64);
    p.imp = a.get<float>((size_t)M * 2 * IMPSTR); p.selb = a.get<int>((size_t)M * 2 * IMPSTR);
    p.memb = a.get<bf16_t>((size_t)NB * NM * D); p.yb = a.get<bf16_t>((size_t)MPAD * D);
    p.w1pq = a.get<bf16_t>((size_t)4 * 256 * 1024); p.cachec = a.get<bf16_t>((size_t)4 * NS * 2 * PL * 64);
    p.pq_s = a.get<bf16_t>((size_t)4 * NS * 2 * HB_S * 256 + 256 * 256); p.pq_p = a.get<bf16_t>((size_t)2 * NB * 2 * HB_P * 256 + 256 * 256);
}


typedef short bf16x8_t __attribute__((ext_vector_type(8)));
typedef float f32x4_t __attribute__((ext_vector_type(4)));
#define MFMA16(a, b, c) __builtin_amdgcn_mfma_f32_16x16x32_bf16((a), (b), (c), 0, 0, 0)

struct EpiProj {
    static constexpr bool PERM = true, AFTER_DRAIN = false;
    bf16_t* O; const float* rstd; int ldo;
    __device__ __forceinline__ void operator()(const pg8::f32x4 (&acc)[2][2][4][2], const pg8::Unit& u, int wr, int wc, int fr, int fq) const {
        const int row0 = u.pm * 256 + wr * 64 + fr, col0 = u.pn * 256 + wc * 32 + 8 * fq;
#pragma unroll
        for (int ai = 0; ai < 2; ++ai)
#pragma unroll
            for (int m = 0; m < 4; ++m) {
                const int row = row0 + ai * 128 + m * 16;
                const float rs = rstd ? rstd[row] : 1.0f;
                bf16_t* rowp = O + (size_t)row * ldo + col0;
#pragma unroll
                for (int bj = 0; bj < 2; ++bj) {
                    const pg8::f32x4 v0 = acc[ai][bj][m][0] * rs, v1 = acc[ai][bj][m][1] * rs;
                    pg8::u32x4 w; w.x = pg8::cvt_pk_bf16(v0[0], v0[1]); w.y = pg8::cvt_pk_bf16(v0[2], v0[3]); w.z = pg8::cvt_pk_bf16(v1[0], v1[1]); w.w = pg8::cvt_pk_bf16(v1[2], v1[3]);
                    *(pg8::u32x4*)(rowp + bj * 128) = w;
                }
            }
    }
};

__device__ __forceinline__ void wave_tile_32x16(const bf16_t* A, size_t lda, const bf16_t* Wt, int ldw, int r0, int c0, int K, float* out, int lane, size_t seg = 64) {
    const int l15 = lane & 15, g = lane >> 4;
    const bf16_t* ap = A + (size_t)(r0 + l15) * lda + 8 * g;
    const bf16_t* w0 = Wt + (size_t)(c0 + 8 * (l15 >> 2) + (l15 & 3)) * ldw + 8 * g;
    const bf16_t* w1 = w0 + (size_t)4 * ldw;
    f32x4_t d0 = {0.f, 0.f, 0.f, 0.f}, d1 = {0.f, 0.f, 0.f, 0.f};
#pragma unroll 8
    for (int k = 0; k < K; k += 32) {
        const bf16x8_t a = *(const bf16x8_t*)(ap + (size_t)(k >> 6) * seg + (k & 63));
        const bf16x8_t b0 = *(const bf16x8_t*)(w0 + k);
        const bf16x8_t b1 = *(const bf16x8_t*)(w1 + k);
        d0 = MFMA16(b0, a, d0);
        d1 = MFMA16(b1, a, d1);
    }
#pragma unroll
    for (int j = 0; j < 4; ++j) { out[j] = d0[j]; out[4 + j] = d1[j]; }
}


__device__ __forceinline__ void wg_tile_32x16(const bf16_t* A, size_t lda, const bf16_t* Wt, int ldw, int r0, int c0, int K, float* out, int lane, int wid, LAS float* red) {
    const int l15 = lane & 15, g = lane >> 4, kw = K / 8;
    const bf16_t* ap = A + (size_t)(r0 + l15) * lda + 8 * g + wid * kw;
    const bf16_t* w0 = Wt + (size_t)(c0 + 8 * (l15 >> 2) + (l15 & 3)) * ldw + 8 * g + wid * kw;
    const bf16_t* w1 = w0 + (size_t)4 * ldw;
    f32x4_t d0 = {0.f, 0.f, 0.f, 0.f}, d1 = {0.f, 0.f, 0.f, 0.f};
#pragma unroll 4
    for (int k = 0; k < kw; k += 32) {
        const bf16x8_t a = *(const bf16x8_t*)(ap + k);
        const bf16x8_t b0 = *(const bf16x8_t*)(w0 + k);
        const bf16x8_t b1 = *(const bf16x8_t*)(w1 + k);
        d0 = MFMA16(b0, a, d0);
        d1 = MFMA16(b1, a, d1);
    }
    __syncthreads();
#pragma unroll
    for (int j = 0; j < 4; ++j) { red[(wid * 8 + j) * 64 + lane] = d0[j]; red[(wid * 8 + 4 + j) * 64 + lane] = d1[j]; }
    __syncthreads();
#pragma unroll
    for (int j = 0; j < 8; ++j) {
        float s = 0.f;
#pragma unroll
        for (int w = 0; w < 8; ++w) s += red[(w * 8 + j) * 64 + lane];
        out[j] = s;
    }
}

__device__ __forceinline__ void fast_inproj(const Params& p, int i, LAS unsigned char* lds) {
    pg8::Gemm g; g.A = p.xb; g.Bt = p.wt_in + (size_t)i * WP * D; g.M = MP; g.N = WP; g.K = D;
    pg8::StaticOrder so; so.init(MP, WP, gridDim.x, blockIdx.x);
    EpiProj E; E.O = p.proj; E.rstd = p.rstd; E.ldo = WP;
    pg8::gemm_phase<EpiProj, pg8::StaticOrder, false>(lds, g, so, E, nullptr);
    int tid_l = threadIdx.x; asm volatile("" : "+v"(tid_l));
    const int lane = tid_l & 63, wid = __builtin_amdgcn_readfirstlane(tid_l >> 6);
    for (int u = blockIdx.x; u < (NS / 16) * (WP / 32); u += gridDim.x) {
        const int rt = u % (NS / 16), cg = u / (NS / 16);
        float v[8];
        wg_tile_32x16(p.xb, D, p.wt_in + (size_t)i * WP * D, D, MP + rt * 16, cg * 32, D, v, lane, wid, (LAS float*)lds);
        if (wid == 0) {
            const int row = MP + rt * 16 + (lane & 15);
            const float rs = p.rstd[row];
#pragma unroll
            for (int j = 0; j < 8; ++j) v[j] *= rs;
            st8_bf(p.proj + (size_t)row * WP + cg * 32 + 8 * (lane >> 4), v);
        }
    }
}

__device__ __forceinline__ void fast_outproj(const Params& p, int i, LAS unsigned char* lds) {
    const int KO = (i & 1) ? 1024 : 512;
    const bf16_t* wt = p.wt_out + (size_t)i * D * 1024;
    pg8::Gemm g; g.A = p.z; g.Bt = wt; g.M = MP; g.N = D; g.K = KO;
    pg8::StaticOrder so; so.init(MP, D, gridDim.x, blockIdx.x);
    EpiProj E; E.O = p.yb; E.rstd = nullptr; E.ldo = D;
    pg8::gemm_phase<EpiProj, pg8::StaticOrder, false>(lds, g, so, E, nullptr);
    int tid_l = threadIdx.x; asm volatile("" : "+v"(tid_l));
    const int lane = tid_l & 63, wid = __builtin_amdgcn_readfirstlane(tid_l >> 6);
    for (int u = blockIdx.x; u < (NS / 16) * (D / 32); u += gridDim.x) {
        const int rt = u % (NS / 16), cg = u / (NS / 16);
        float v[8];
        wg_tile_32x16(p.z, KO, wt, KO, MP + rt * 16, cg * 32, KO, v, lane, wid, (LAS float*)lds);
        if (wid == 0) st8_bf(p.yb + (size_t)(MP + rt * 16 + (lane & 15)) * D + cg * 32 + 8 * (lane >> 4), v);
    }
}


static_assert(D % 256 == 0, "row stages assume D a multiple of 256");
__device__ __forceinline__ float wave_sum(float v) {
#pragma unroll
    for (int o = 32; o > 0; o >>= 1) v += __shfl_xor(v, o);
    return v;
}
struct TrArgs { const float* src; int ldsrc, csrc, k0, c0; bf16_t* dst; int lddst; const float* scale; };
__device__ __forceinline__ void tr_load(const TrArgs& a, float4 (&v)[2], float (&sc)[2], int tid) {
#pragma unroll
    for (int h = 0; h < 2; ++h) {
        const int r = (tid >> 4) + 32 * h, c4 = (tid & 15) * 4;
        v[h] = make_float4(0.f, 0.f, 0.f, 0.f);
        if (a.c0 + c4 < a.csrc) v[h] = *(const float4*)(a.src + (size_t)(a.k0 + r) * a.ldsrc + a.c0 + c4);
        sc[h] = a.scale ? a.scale[a.k0 + r] : 1.0f;
    }
}
__device__ __forceinline__ void tr_to_lds(LAS float* tile, const float4 (&v)[2], const float (&sc)[2], int tid) {
#pragma unroll
    for (int h = 0; h < 2; ++h) {
        const int r = (tid >> 4) + 32 * h, c4 = (tid & 15) * 4;
        tile[r * 65 + c4 + 0] = v[h].x * sc[h]; tile[r * 65 + c4 + 1] = v[h].y * sc[h]; tile[r * 65 + c4 + 2] = v[h].z * sc[h]; tile[r * 65 + c4 + 3] = v[h].w * sc[h];
    }
}
__device__ __forceinline__ void tr_from_lds(const TrArgs& a, const LAS float* tile, int tid) {
    const int c = tid >> 3, k8 = (tid & 7) * 8;
    float v[8];
#pragma unroll
    for (int j = 0; j < 8; ++j) v[j] = tile[(k8 + j) * 65 + c];
    st8_bf(a.dst + (size_t)(a.c0 + c) * a.lddst + a.k0 + k8, v);
}
__device__ __forceinline__ TrArgs tr_job(const Params& p, int job) {
    constexpr int T_IN = (D / 64) * (WP / 64), T_OA = 8 * (D / 64), T_OB = 16 * (D / 64), T_MEM = (D / 64) * 8, T_W1 = 16 * 2, T_W2 = 2;
    constexpr int N_IN = 4 * T_IN, N_OUT = 2 * T_OA + 2 * T_OB, N_MEM = 4 * T_MEM, N_W1 = 8 * T_W1;
    TrArgs t; int j = job;
    if (j < N_IN) {
        const int i = j / T_IN, tt = j % T_IN, li = i >> 1, kt = tt % (D / 64), ct = tt / (D / 64);
        const bool isb = i & 1;
        t.src = isb ? p.w_in_b + (size_t)li * D * W_IN_B : p.w_in_a + (size_t)li * D * 3072; t.ldsrc = isb ? W_IN_B : 3072; t.csrc = t.ldsrc; t.k0 = kt * 64; t.c0 = ct * 64;
        t.dst = p.wt_in + (size_t)i * WP * D; t.lddst = D; t.scale = p.norm_pre + i * D; return t;
    }
    j -= N_IN;
    if (j < N_OUT) {
        int i, tt, KO;
        if (j < 2 * T_OA) { i = 2 * (j / T_OA); tt = j % T_OA; KO = 512; } else { j -= 2 * T_OA; i = 2 * (j / T_OB) + 1; tt = j % T_OB; KO = 1024; }
        const int li = i >> 1, kt = tt % (KO / 64), ct = tt / (KO / 64);
        t.src = KO == 512 ? p.w_out_a + (size_t)li * 512 * D : p.w_out_b + (size_t)li * 1024 * D; t.ldsrc = D; t.csrc = D; t.k0 = kt * 64; t.c0 = ct * 64;
        t.dst = p.wt_out + (size_t)i * D * 1024; t.lddst = KO; t.scale = nullptr; return t;
    }
    j -= N_OUT;
    if (j < N_MEM) {
        const int i = j / T_MEM, tt = j % T_MEM, kt = tt % (D / 64), ct = tt / (D / 64);
        t.src = p.w_mem_kv + (size_t)i * D * 512; t.ldsrc = 512; t.csrc = 512; t.k0 = kt * 64; t.c0 = ct * 64; t.dst = p.wt_mem + (size_t)i * 512 * D; t.lddst = D; t.scale = p.norm_mem + i * D; return t;
    }
    j -= N_MEM;
    if (j < N_W1) {
        const int lt = j / (2 * T_W1), hf = (j / T_W1) & 1, tt = j % T_W1, kt = tt % 16, ct = tt / 16;
        t.src = p.cmp_w1 + ((size_t)lt * 2048 + hf * 1024) * 128; t.ldsrc = 128; t.csrc = 128; t.k0 = kt * 64; t.c0 = ct * 64; t.dst = p.w1pq + ((size_t)lt * 256 + hf * 128) * 1024; t.lddst = 1024; t.scale = nullptr; return t;
    }
    j -= N_W1;
    { const int lt = j / T_W2, kt = j % T_W2; t.src = p.cmp_w2 + (size_t)lt * 128 * 64; t.ldsrc = 64; t.csrc = 64; t.k0 = kt * 64; t.c0 = 0; t.dst = p.w2t + (size_t)lt * 64 * 128; t.lddst = 128; t.scale = nullptr; return t; }
}
__device__ __forceinline__ void fast_prep_weights(const Params& p, LAS unsigned char* lds) {
    int tid = threadIdx.x; asm volatile("" : "+v"(tid));
    LAS float* tile = (LAS float*)lds;
    constexpr int N_ALL = 4 * (D / 64) * (WP / 64) + 2 * 8 * (D / 64) + 2 * 16 * (D / 64) + 4 * (D / 64) * 8 + 8 * 32 + 4 * 2;
    for (int job = 2 * blockIdx.x; job < N_ALL; job += 2 * gridDim.x) {
        const bool two = job + 1 < N_ALL;
        const TrArgs a0 = tr_job(p, job), a1 = tr_job(p, two ? job + 1 : job);
        float4 v0[2], v1[2]; float s0[2], s1[2];
        tr_load(a0, v0, s0, tid); tr_load(a1, v1, s1, tid);
        tr_to_lds(tile, v0, s0, tid); tr_to_lds(tile + 64 * 65, v1, s1, tid);
        __syncthreads();
        tr_from_lds(a0, tile, tid); if (two) tr_from_lds(a1, tile + 64 * 65, tid);
        __syncthreads();
    }
    {
        const int lane = tid & 63, wid = __builtin_amdgcn_readfirstlane(tid >> 6);
        for (int job = blockIdx.x * (NTHREADS / 64) + wid; job < 4 * 128; job += gridDim.x * (NTHREADS / 64)) {
            const int lt = job >> 7, jj = job & 127;
            const float* w = p.cmp_w1 + (size_t)lt * 2048 * 128 + jj; const float* ps = p.cmp_pos + (size_t)lt * 2048;
            float a = 0.f;
#pragma unroll 8
            for (int k = lane; k < 2048; k += 64) a += ps[k] * w[(size_t)k * 128];
            a = wave_sum(a);
            if (lane == 0) p.cb[job] = a;
        }
    }
}
__device__ __forceinline__ void prep_rows2(const float* src0, const float* src1, bf16_t* dst0, bf16_t* dst1, float* rs0, float* rs1, bool two, int lane) {
    constexpr int Q = D / 256;
    float4 v0[Q], v1[Q];
#pragma unroll
    for (int q = 0; q < Q; ++q) { v0[q] = *(const float4*)(src0 + q * 256 + lane * 4); v1[q] = *(const float4*)(src1 + q * 256 + lane * 4); }
    float s0 = 0.f, s1 = 0.f;
#pragma unroll
    for (int q = 0; q < Q; ++q) {
        s0 += v0[q].x * v0[q].x + v0[q].y * v0[q].y + v0[q].z * v0[q].z + v0[q].w * v0[q].w;
        s1 += v1[q].x * v1[q].x + v1[q].y * v1[q].y + v1[q].z * v1[q].z + v1[q].w * v1[q].w;
        uint2 o; o.x = pack_bf2(v0[q].x, v0[q].y); o.y = pack_bf2(v0[q].z, v0[q].w);
        *(uint2*)(dst0 + q * 256 + lane * 4) = o;
        if (two) { uint2 o1; o1.x = pack_bf2(v1[q].x, v1[q].y); o1.y = pack_bf2(v1[q].z, v1[q].w); *(uint2*)(dst1 + q * 256 + lane * 4) = o1; }
    }
    s0 = wave_sum(s0); s1 = wave_sum(s1);
    if (lane == 0) { *rs0 = 1.0f / sqrtf(s0 / D + RMS_EPS); if (two) *rs1 = 1.0f / sqrtf(s1 / D + RMS_EPS); }
}
__device__ __forceinline__ void fast_prep_x(const Params& p) {
    int tid_l = threadIdx.x; asm volatile("" : "+v"(tid_l));
    const int lane = tid_l & 63, wid = __builtin_amdgcn_readfirstlane(tid_l >> 6);
    const int gw = blockIdx.x * (NTHREADS / 64) + wid, nw = gridDim.x * (NTHREADS / 64);
    static_assert(MP % 2 == 0 && NS % 2 == 0 && (NB * NM) % 2 == 0, "row pairs");
    for (int r = 2 * gw; r < MP; r += 2 * nw) prep_rows2(p.x_prompt + (size_t)r * D, p.x_prompt + (size_t)(r + 1) * D, p.xb + (size_t)r * D, p.xb + (size_t)(r + 1) * D, p.rstd + r, p.rstd + r + 1, true, lane);
    for (int r = 2 * gw; r < NS; r += 2 * nw) prep_rows2(p.x_sample + (size_t)r * D, p.x_sample + (size_t)(r + 1) * D, p.xb + (size_t)(MP + r) * D, p.xb + (size_t)(MP + r + 1) * D, p.rstd + MP + r, p.rstd + MP + r + 1, true, lane);
    for (int r = 2 * gw; r < NB * NM; r += 2 * nw) prep_rows2(p.mem_prompt + (size_t)r * D, p.mem_prompt + (size_t)(r + 1) * D, p.memb + (size_t)r * D, p.memb + (size_t)(r + 1) * D, p.mrstd + r, p.mrstd + r + 1, true, lane);
}
__device__ __forceinline__ void fast_finish(const Params& p, int i) {
    int tid_l = threadIdx.x; asm volatile("" : "+v"(tid_l));
    const int lane = tid_l & 63, wid = __builtin_amdgcn_readfirstlane(tid_l >> 6);
    const int gw = blockIdx.x * (NTHREADS / 64) + wid, nw = gridDim.x * (NTHREADS / 64);
    constexpr int Q = D / 256;
    for (int r0 = 2 * gw; r0 < M; r0 += 2 * nw) {
        float4 yv[2][Q], xv[2][Q], gv[Q];
#pragma unroll
        for (int k = 0; k < 2; ++k) {
            const int r = (r0 + k < M) ? r0 + k : r0;
            const bf16_t* y = p.yb + (size_t)r * D; const bf16_t* xi = p.xb + (size_t)r * D;
#pragma unroll
            for (int q = 0; q < Q; ++q) {
                const uint2 u = *(const uint2*)(y + q * 256 + lane * 4), w = *(const uint2*)(xi + q * 256 + lane * 4);
                yv[k][q] = make_float4(__uint_as_float(u.x << 16), __uint_as_float(u.x & 0xffff0000u), __uint_as_float(u.y << 16), __uint_as_float(u.y & 0xffff0000u));
                xv[k][q] = make_float4(__uint_as_float(w.x << 16), __uint_as_float(w.x & 0xffff0000u), __uint_as_float(w.y << 16), __uint_as_float(w.y & 0xffff0000u));
            }
        }
#pragma unroll
        for (int q = 0; q < Q; ++q) gv[q] = *(const float4*)(p.norm_post + i * D + q * 256 + lane * 4);
#pragma unroll
        for (int k = 0; k < 2; ++k) {
            if (r0 + k >= M) break;
            const int r = r0 + k;
            float ss = 0.f;
#pragma unroll
            for (int q = 0; q < Q; ++q) ss += yv[k][q].x * yv[k][q].x + yv[k][q].y * yv[k][q].y + yv[k][q].z * yv[k][q].z + yv[k][q].w * yv[k][q].w;
            const float yr = 1.0f / sqrtf(wave_sum(ss) / D + RMS_EPS);
            float s2 = 0.f;
            float* xo = r < MP ? p.o_y + (size_t)r * D : p.o_ys + (size_t)(r - MP) * D;
#pragma unroll
            for (int q = 0; q < Q; ++q) {
                float4 v; v.x = xv[k][q].x + yv[k][q].x * yr * gv[q].x; v.y = xv[k][q].y + yv[k][q].y * yr * gv[q].y; v.z = xv[k][q].z + yv[k][q].z * yr * gv[q].z; v.w = xv[k][q].w + yv[k][q].w * yr * gv[q].w;
                if (i == 3) *(float4*)(xo + q * 256 + lane * 4) = v;
                else {
                    uint2 o; o.x = pack_bf2(v.x, v.y); o.y = pack_bf2(v.z, v.w);
                    *(uint2*)(p.xb + (size_t)r * D + q * 256 + lane * 4) = o;
                    const float a = __uint_as_float(o.x << 16), b = __uint_as_float(o.x & 0xffff0000u), c = __uint_as_float(o.y << 16), d = __uint_as_float(o.y & 0xffff0000u);
                    s2 += a * a + b * b + c * c + d * d;
                }
            }
            if (i < 3) { s2 = wave_sum(s2); if (lane == 0) p.rstd[r] = 1.0f / sqrtf(s2 / D + RMS_EPS); }
        }
    }
}
__device__ __forceinline__ void fast_memkv(const Params& p) {
    int tid_l = threadIdx.x; asm volatile("" : "+v"(tid_l));
    const int lane = tid_l & 63, wid = __builtin_amdgcn_readfirstlane(tid_l >> 6);
    const int gw = blockIdx.x * (NTHREADS / 64) + wid, nw = gridDim.x * (NTHREADS / 64);
    constexpr int RT = NB * NM / 16;
    for (int u = gw; u < 4 * RT * 16; u += nw) {
        const int cg = u % 16, rt = (u / 16) % RT, i = u / (16 * RT);
        float v[8];
        wave_tile_32x16(p.memb, D, p.wt_mem + (size_t)i * 512 * D, D, rt * 16, cg * 32, D, v, lane);
        const int row = rt * 16 + (lane & 15), c0 = cg * 32 + 8 * (lane >> 4);
        const float rs = p.mrstd[row];
#pragma unroll
        for (int j = 0; j < 8; ++j) v[j] *= rs;
        st8_f(p.o_mem + ((size_t)i * NB * NM + row) * 512 + c0, v);
        const int n = row / NM, m = row % NM, h = (c0 % 256) / 64, e0 = c0 % 64;
        if (c0 < 256) st8_bf(p.mkb + (((size_t)i * NB + n) * 4 + h) * NM * 64 + kt_pos(m, e0), v);
        else {
            bf16_t* o = p.mvt + (((size_t)i * NB + n) * 4 + h) * 64 * NM + vt_pos(m) + e0 * VT_LD;
#pragma unroll
            for (int j = 0; j < 8; ++j) o[j * VT_LD] = f2bf(v[j]);
        }
    }
}

__device__ __forceinline__ void fast_conv_cache(const Params& p) {
    int tid = threadIdx.x; asm volatile("" : "+v"(tid));
    constexpr long NITEMS = (long)NS * PL * 64;
    const long gsz = (long)gridDim.x * NTHREADS;
    for (long base = (long)blockIdx.x * NTHREADS + tid; base < NITEMS; base += 8 * gsz) {
        f32x4_t a[8][2]; bf16_t* dst[8];
#pragma unroll
        for (int u = 0; u < 8; ++u) {
            const long it = base + u * gsz;
            dst[u] = nullptr;
            if (it < NITEMS) {
                const int e8 = it & 7, kv = (it >> 3) & 1, ty = (it >> 4) & 1, li = (it >> 5) & 1; const long np = it >> 6;
                const int pos = (int)(np % PL), n = (int)(np / PL);
                const int page = p.page_table[n * NPAGES + (pos >> 7)];
                const float* src = p.cache_b_pages + ((((size_t)page * 128 + (pos & 127)) * 2 + li) * 4 + ty) * 128 + kv * 64 + e8 * 8;
                a[u][0] = __builtin_nontemporal_load((const f32x4_t*)src); a[u][1] = __builtin_nontemporal_load((const f32x4_t*)src + 1);
                dst[u] = p.cachec + (((((size_t)li * 2 + ty) * NS + n) * 2 + kv) * PL + pos) * 64 + e8 * 8;
            }
        }
#pragma unroll
        for (int u = 0; u < 8; ++u)
            if (dst[u]) { uint4 o; o.x = pack_bf2(a[u][0][0], a[u][0][1]); o.y = pack_bf2(a[u][0][2], a[u][0][3]); o.z = pack_bf2(a[u][1][0], a[u][1][1]); o.w = pack_bf2(a[u][1][2], a[u][1][3]); *(uint4*)dst[u] = o; }
    }
}

__device__ __forceinline__ void post_items(const Params& p, int i, int nrows, int c8lo, int nc8, bool window_rows, int tid) {
    const int nitems = nrows * nc8, gsz = (int)gridDim.x * NTHREADS;
    for (int base = (int)blockIdx.x * NTHREADS + tid; base < nitems; base += 4 * gsz) {
        uint4 u[4]; int rr[4];
#pragma unroll
        for (int k = 0; k < 4; ++k) {
            const int it = base + k * gsz;
            int r = it % nrows;
            if (window_rows) r = r < NB * WROWS2 ? (r / WROWS2) * S + (S - WROWS2) + r % WROWS2 : MP + (r - NB * WROWS2);
            rr[k] = r;
            if (it < nitems) u[k] = *(const uint4*)(p.proj + (size_t)r * WP + 768 + (c8lo + it / nrows) * 8);
        }
#pragma unroll
        for (int k = 0; k < 4; ++k) {
            const int it = base + k * gsz;
            if (it < nitems) {
                float v[8];
                v[0] = __uint_as_float(u[k].x << 16); v[1] = __uint_as_float(u[k].x & 0xffff0000u); v[2] = __uint_as_float(u[k].y << 16); v[3] = __uint_as_float(u[k].y & 0xffff0000u);
                v[4] = __uint_as_float(u[k].z << 16); v[5] = __uint_as_float(u[k].z & 0xffff0000u); v[6] = __uint_as_float(u[k].w << 16); v[7] = __uint_as_float(u[k].w & 0xffff0000u);
                inproj_extra8(p, i, rr[k], 768 + (c8lo + it / nrows) * 8, v, false);
            }
        }
    }
}
__device__ __forceinline__ void fast_post(const Params& p, int i) {
    int tid = threadIdx.x; asm volatile("" : "+v"(tid));
    if (i & 1) post_items(p, i, M, 0, 96, false, tid);
    else {
        post_items(p, i, M, 0, 192, false, tid);
    }
}
constexpr long CONV_TOTAL = (long)NS * PL * 64;
constexpr int CONV_NITEMS = 2048;
constexpr long CONV_ITEM = CONV_TOTAL / CONV_NITEMS;
static_assert(CONV_TOTAL < (1l << 31) && CONV_TOTAL % CONV_NITEMS == 0 && CONV_ITEM % (64 * 4) == 0, "conversion items");
__device__ __forceinline__ void conv_item(const Params& p, int c, int lane) {
    for (int base = c * (int)CONV_ITEM + lane; base < (c + 1) * (int)CONV_ITEM; base += 64 * 4) {
        f32x4_t a[4][2]; bf16_t* dst[4];
#pragma unroll
        for (int u = 0; u < 4; ++u) {
            const int it = base + u * 64;
            const int e8 = it & 7, kv = (it >> 3) & 1, ty = (it >> 4) & 1, li = (it >> 5) & 1, np = it >> 6;
            const int pos = np % PL, n = np / PL;
            const int page = p.page_table[n * NPAGES + (pos >> 7)];
            const float* src = p.cache_b_pages + ((((size_t)page * 128 + (pos & 127)) * 2 + li) * 4 + ty) * 128 + kv * 64 + e8 * 8;
            a[u][0] = *(const f32x4_t*)src; a[u][1] = *((const f32x4_t*)src + 1);
            dst[u] = p.cachec + (((((size_t)li * 2 + ty) * NS + n) * 2 + kv) * PL + pos) * 64 + e8 * 8;
        }
#pragma unroll
        for (int u = 0; u < 4; ++u) { uint4 o; o.x = pack_bf2(a[u][0][0], a[u][0][1]); o.y = pack_bf2(a[u][0][2], a[u][0][3]); o.z = pack_bf2(a[u][1][0], a[u][1][1]); o.w = pack_bf2(a[u][1][2], a[u][1][3]); *(uint4*)dst[u] = o; }
    }
}


constexpr float LOG2E = 1.4426950408889634f;
constexpr float C1 = SCALE * LOG2E;

typedef __bf16 bf16v2_t __attribute__((ext_vector_type(2)));
__device__ __forceinline__ unsigned cvt_pk(float lo, float hi) { bf16v2_t v; v.x = (__bf16)lo; v.y = (__bf16)hi; return __builtin_bit_cast(unsigned, v); }
__device__ __forceinline__ float ex2(float x) { return __builtin_amdgcn_exp2f(x); }
__device__ __forceinline__ float xmax4(float v) { v = fmaxf(v, __shfl_xor(v, 16)); return fmaxf(v, __shfl_xor(v, 32)); }
__device__ __forceinline__ float xsum4(float v) { v += __shfl_xor(v, 16); return v + __shfl_xor(v, 32); }

template <int NB_> struct Stream {
    f32x4_t o[NB_][4];
    float m[NB_], l[NB_], thr[NB_];
    __device__ __forceinline__ void reset2() {
#pragma unroll
        for (int b = 0; b < NB_; ++b) { m[b] = 0.f; thr[b] = -INFINITY; l[b] = 0.f;
#pragma unroll
            for (int d = 0; d < 4; ++d) o[b][d] = (f32x4_t){0.f, 0.f, 0.f, 0.f}; }
    }
    __device__ __forceinline__ void reset() {
#pragma unroll
        for (int b = 0; b < NB_; ++b) { m[b] = -INFINITY; l[b] = 0.f;
#pragma unroll
            for (int d = 0; d < 4; ++d) o[b][d] = (f32x4_t){0.f, 0.f, 0.f, 0.f}; }
    }
};

__device__ __forceinline__ void load_k(bf16x8_t (&kf)[2][2], const bf16_t* krow0, size_t ldk, int m, int g) {
    const bf16_t* r0 = krow0 + (size_t)(8 * (m >> 2) + (m & 3)) * ldk + 8 * g;
#pragma unroll
    for (int t = 0; t < 2; ++t)
#pragma unroll
        for (int ks = 0; ks < 2; ++ks) kf[t][ks] = *(const bf16x8_t*)(r0 + (size_t)(4 * t) * ldk + 32 * ks);
}
__device__ __forceinline__ void load_kt(bf16x8_t (&kf)[2][2], const bf16_t* chunk0, int m, int g) {
    const bf16_t* r0 = chunk0 + (8 * (m >> 2) + (m & 3)) * 32 + 8 * g;
#pragma unroll
    for (int t = 0; t < 2; ++t)
#pragma unroll
        for (int ks = 0; ks < 2; ++ks) kf[t][ks] = *(const bf16x8_t*)(r0 + 4 * t * 32 + ks * 1024);
}
__device__ __forceinline__ void load_v(bf16x8_t (&vf)[4], const bf16_t* vt0, size_t ldv, int m, int g) {
#pragma unroll
    for (int d = 0; d < 4; ++d) vf[d] = *(const bf16x8_t*)(vt0 + (size_t)(16 * d + m) * ldv + 8 * g);
}

__device__ __forceinline__ void chunk_scores(float (&x)[8], const bf16x8_t (&kf)[2][2], const bf16x8_t (&q)[2], float sl2, float dist0, float dstep, float maxd, bool ok, bool allv) {
    f32x4_t s0 = {0.f, 0.f, 0.f, 0.f}, s1 = {0.f, 0.f, 0.f, 0.f};
    s0 = MFMA16(kf[0][0], q[0], s0); s0 = MFMA16(kf[0][1], q[1], s0);
    s1 = MFMA16(kf[1][0], q[0], s1); s1 = MFMA16(kf[1][1], q[1], s1);
    const float cb = -sl2 * dist0, cs = sl2 * dstep;
    if (allv) {
#pragma unroll
        for (int j = 0; j < 8; ++j) x[j] = fmaf(j < 4 ? s0[j & 3] : s1[j & 3], C1, fmaf(cs, (float)j, cb));
    } else {
        float dist0o = dist0; asm volatile("" : "+v"(dist0o));
#pragma unroll
        for (int j = 0; j < 8; ++j) {
            const float d = dist0o - dstep * (float)j;
            const float v = fmaf(j < 4 ? s0[j & 3] : s1[j & 3], C1, fmaf(cs, (float)j, cb));
            x[j] = (ok && d >= 0.f && d <= maxd) ? v : -INFINITY;
        }
    }
}
__device__ __forceinline__ float max8(const float (&x)[8]) { return fmaxf(fmaxf(fmaxf(x[0], x[1]), fmaxf(x[2], x[3])), fmaxf(fmaxf(x[4], x[5]), fmaxf(x[6], x[7]))); }
__device__ __forceinline__ float max3q(float a, float b, float c) { float r; asm("v_max3_f32 %0, %1, %2, %3" : "=v"(r) : "v"(a), "v"(b), "v"(c)); return r; }
__device__ __forceinline__ float max8q(const float (&x)[8]) { const float t0 = max3q(x[0], x[1], x[2]), t1 = max3q(x[3], x[4], x[5]); return max3q(x[6], x[7], max3q(t0, t1, t1)); }
constexpr float ZERO_GAP = 150.0f;
constexpr float LAZY_THR = 8.0f;

template <int NB_> __device__ __forceinline__ void chunk_attend(Stream<NB_>& st, const bf16x8_t (&kf)[2][2], const bf16x8_t (&vf)[4], const bf16x8_t (&q)[NB_][2],
                                                                   const float (&sl2)[NB_], float dist0, float dstep, float maxd, bool ok) {
    const bool allv = __all(ok && (dist0 - 7.f * dstep >= 0.f) && (dist0 <= maxd));
#pragma unroll
    for (int b = 0; b < NB_; ++b) {
        float x[8];
        chunk_scores(x, kf, q[b], sl2[b], dist0, dstep, maxd, ok, allv);
        const float lm = max8(x);
        if (__any(lm > st.m[b] + LAZY_THR)) {
            const float mn = fmaxf(st.m[b], xmax4(lm));
            const float ms = mn == -INFINITY ? 0.f : mn;
            const float al = ex2(st.m[b] - ms);
            st.l[b] *= al; st.m[b] = mn;
#pragma unroll
            for (int d = 0; d < 4; ++d) st.o[b][d] *= al;
        }
        const float ms = st.m[b] == -INFINITY ? 0.f : st.m[b];
        if (__all(lm < ms - ZERO_GAP)) continue;
        float pj[8], ps = 0.f;
#pragma unroll
        for (int j = 0; j < 8; ++j) { pj[j] = ex2(x[j] - ms); ps += pj[j]; }
        st.l[b] += ps;
        union { bf16x8_t v; unsigned u[4]; } pk;
#pragma unroll
        for (int j = 0; j < 4; ++j) pk.u[j] = cvt_pk(pj[2 * j], pj[2 * j + 1]);
#pragma unroll
        for (int d = 0; d < 4; ++d) st.o[b][d] = MFMA16(vf[d], pk.v, st.o[b][d]);
    }
}


__device__ __forceinline__ bf16x8_t scale_q(bf16x8_t q) {
    union { bf16x8_t v; unsigned u[4]; } a; a.v = q;
#pragma unroll
    for (int j = 0; j < 4; ++j) a.u[j] = cvt_pk(__uint_as_float(a.u[j] << 16) * C1, __uint_as_float(a.u[j] & 0xffff0000u) * C1);
    return a.v;
}
template <int NB_> __device__ __forceinline__ void qk_folded(float (&x)[NB_][8], const bf16x8_t (&kf)[2][2], const bf16x8_t (&q)[NB_][2], const float (&sl2)[NB_], const float (&m)[NB_], float dist0, float dstep) {
#pragma unroll
    for (int b = 0; b < NB_; ++b) {
        const float base = fmaf(-sl2[b], dist0, -m[b]), cs = sl2[b] * dstep;
        f32x4_t s0 = {base, base + cs, fmaf(cs, 2.f, base), fmaf(cs, 3.f, base)}, s1 = {fmaf(cs, 4.f, base), fmaf(cs, 5.f, base), fmaf(cs, 6.f, base), fmaf(cs, 7.f, base)};
        s0 = MFMA16(kf[0][0], q[b][0], s0); s0 = MFMA16(kf[0][1], q[b][1], s0);
        s1 = MFMA16(kf[1][0], q[b][0], s1); s1 = MFMA16(kf[1][1], q[b][1], s1);
#pragma unroll
        for (int j = 0; j < 8; ++j) x[b][j] = j < 4 ? s0[j & 3] : s1[j & 3];
    }
}
template <int NB_> __device__ __forceinline__ void mask_folded(float (&x)[NB_][8], float dist0, float dstep) {
    float dm = dist0; asm volatile("" : "+v"(dm));
#pragma unroll
    for (int j = 0; j < 8; ++j) {
        const bool v = dm - dstep * (float)j >= 0.f;
#pragma unroll
        for (int b = 0; b < NB_; ++b) x[b][j] = v ? x[b][j] : -INFINITY;
    }
}
template <int NB_> __device__ __forceinline__ void refresh_folded(Stream<NB_>& st, float (&x)[NB_][8]) {
#pragma unroll
    for (int b = 0; b < NB_; ++b) {
        const float lmx = xmax4(max8(x[b]));
        const bool first = st.thr[b] < 0.f, none = lmx == -INFINITY;
        const float up = none ? 0.f : (first ? lmx : fmaxf(lmx, 0.f));
        const float al = first ? 1.f : ex2(-up);
        st.m[b] += up; st.l[b] *= al;
        st.thr[b] = (first && none) ? -INFINITY : LAZY_THR;
#pragma unroll
        for (int d = 0; d < 4; ++d) st.o[b][d] *= al;
#pragma unroll
        for (int j = 0; j < 8; ++j) x[b][j] -= up;
    }
}
template <int NB_, class LoadK> __device__ __forceinline__ void chunk_attend_pf(Stream<NB_>& st, bf16x8_t (&kf)[2][2], const bf16x8_t (&vf)[4], const bf16x8_t (&q)[NB_][2],
                                                                                  const float (&sl2)[NB_], float dist0, float dstep, float maxd, bool ok, bool has_next, LoadK load_next_k) {
    float x[NB_][8];
#pragma unroll
    for (int b = 0; b < NB_; ++b) {
        const float base = fmaf(-sl2[b], dist0, -st.m[b]), cs = sl2[b] * dstep;
        f32x4_t s0 = {base, base + cs, fmaf(cs, 2.f, base), fmaf(cs, 3.f, base)}, s1 = {fmaf(cs, 4.f, base), fmaf(cs, 5.f, base), fmaf(cs, 6.f, base), fmaf(cs, 7.f, base)};
        __builtin_amdgcn_s_setprio(1);
        s0 = MFMA16(kf[0][0], q[b][0], s0); s0 = MFMA16(kf[0][1], q[b][1], s0);
        s1 = MFMA16(kf[1][0], q[b][0], s1); s1 = MFMA16(kf[1][1], q[b][1], s1);
        __builtin_amdgcn_s_setprio(0);
#pragma unroll
        for (int j = 0; j < 8; ++j) x[b][j] = j < 4 ? s0[j & 3] : s1[j & 3];
    }
    if (has_next) load_next_k(kf);
    if (!__all(ok && (dist0 - 7.f * dstep >= 0.f) && (dist0 <= maxd))) {
        float dm = dist0; asm volatile("" : "+v"(dm));
#pragma unroll
        for (int j = 0; j < 8; ++j) {
            const float d = dm - dstep * (float)j;
            const bool v = ok && d >= 0.f && d <= maxd;
#pragma unroll
            for (int b = 0; b < NB_; ++b) x[b][j] = v ? x[b][j] : -INFINITY;
        }
    }
    bool need = false;
#pragma unroll
    for (int b = 0; b < NB_; ++b) need |= (max8q(x[b]) > st.thr[b]);
    if (__any(need)) refresh_folded<NB_>(st, x);
#pragma unroll
    for (int b = 0; b < NB_; ++b) {
        float pj[8];
#pragma unroll
        for (int j = 0; j < 8; ++j) pj[j] = ex2(x[b][j]);
        st.l[b] += ((pj[0] + pj[1]) + (pj[2] + pj[3])) + ((pj[4] + pj[5]) + (pj[6] + pj[7]));
        union { bf16x8_t v; unsigned u[4]; } pk;
#pragma unroll
        for (int j = 0; j < 4; ++j) pk.u[j] = cvt_pk(pj[2 * j], pj[2 * j + 1]);
        __builtin_amdgcn_s_setprio(1);
#pragma unroll
        for (int d = 0; d < 4; ++d) st.o[b][d] = MFMA16(vf[d], pk.v, st.o[b][d]);
        __builtin_amdgcn_s_setprio(0);
    }
}

template <int NB_> __device__ __forceinline__ void chunk_attend_mb(Stream<NB_>& st, const bf16x8_t (&kf)[2][2], const bf16x8_t (&vf)[4], const bf16x8_t (&q)[NB_][2],
                                                                     float sl2, const float (&dist0)[NB_], float maxd) {
    float x[NB_][8];
    bool allv = true;
#pragma unroll
    for (int b = 0; b < NB_; ++b) {
        const float base = fmaf(-sl2, dist0[b], -st.m[b]);
        f32x4_t s0 = {base, base + sl2, fmaf(sl2, 2.f, base), fmaf(sl2, 3.f, base)}, s1 = {fmaf(sl2, 4.f, base), fmaf(sl2, 5.f, base), fmaf(sl2, 6.f, base), fmaf(sl2, 7.f, base)};
        s0 = MFMA16(kf[0][0], q[b][0], s0); s0 = MFMA16(kf[0][1], q[b][1], s0);
        s1 = MFMA16(kf[1][0], q[b][0], s1); s1 = MFMA16(kf[1][1], q[b][1], s1);
#pragma unroll
        for (int j = 0; j < 8; ++j) x[b][j] = j < 4 ? s0[j & 3] : s1[j & 3];
        allv = allv && (dist0[b] - 7.f >= 0.f) && (dist0[b] <= maxd);
    }
    if (!__all(allv)) {
#pragma unroll
        for (int b = 0; b < NB_; ++b) {
            float dm = dist0[b]; asm volatile("" : "+v"(dm));
#pragma unroll
            for (int j = 0; j < 8; ++j) { const float d = dm - (float)j; x[b][j] = (d >= 0.f && d <= maxd) ? x[b][j] : -INFINITY; }
        }
    }
    bool need = false;
#pragma unroll
    for (int b = 0; b < NB_; ++b) need |= (max8q(x[b]) > st.thr[b]);
    if (__any(need)) refresh_folded<NB_>(st, x);
#pragma unroll
    for (int b = 0; b < NB_; ++b) {
        float pj[8];
#pragma unroll
        for (int j = 0; j < 8; ++j) pj[j] = ex2(x[b][j]);
        st.l[b] += ((pj[0] + pj[1]) + (pj[2] + pj[3])) + ((pj[4] + pj[5]) + (pj[6] + pj[7]));
        union { bf16x8_t v; unsigned u[4]; } pk;
#pragma unroll
        for (int j = 0; j < 4; ++j) pk.u[j] = cvt_pk(pj[2 * j], pj[2 * j + 1]);
#pragma unroll
        for (int d = 0; d < 4; ++d) st.o[b][d] = MFMA16(vf[d], pk.v, st.o[b][d]);
    }
}

template <int DEPTH, class LoadF, class AttF> __device__ __forceinline__ void chunk_loop_d(int first, int last, LoadF load, AttF att) {
    if (first < last) return;
    bf16x8_t kfr[DEPTH][2][2], vfr[DEPTH][4];
#pragma unroll
    for (int d = 0; d < DEPTH; ++d) { const int k = first - 32 * d; if (k >= last) load(k, kfr[d], vfr[d]); }
    for (int k0 = first; k0 >= last; k0 -= 32 * DEPTH) {
#pragma unroll
        for (int d = 0; d < DEPTH; ++d) {
            const int k = k0 - 32 * d;
            if (k >= last) {
                att(k, kfr[d], vfr[d]);
                const int kn = k - 32 * DEPTH;
                if (kn >= last) load(kn, kfr[d], vfr[d]);
            }
        }
    }
}
template <class LoadF, class AttF> __device__ __forceinline__ void chunk_loop(int first, int last, LoadF load, AttF att) { chunk_loop_d<3>(first, last, load, att); }

__device__ __forceinline__ int wq_next(unsigned* ctr, int lane) {
    unsigned v = 0u;
    if (lane == 0) v = __hip_atomic_fetch_add(ctr, 1u, __ATOMIC_RELAXED, __HIP_MEMORY_SCOPE_AGENT);
    return (int)__builtin_amdgcn_readfirstlane(v);
}

__device__ __forceinline__ int wq_next8(unsigned* ctr, LAS int* slot, int wid, int lane) {
    __syncthreads();
    if (wid == 0 && lane == 0) *slot = (int)__hip_atomic_fetch_add(ctr, 8u, __ATOMIC_RELAXED, __HIP_MEMORY_SCOPE_AGENT);
    __syncthreads();
    return *slot + wid;
}

__device__ __forceinline__ void fast_nsa_prompt(const Params& p, int i, LAS unsigned char* lds, int cslot = 0) {
    int tid_l = threadIdx.x; asm volatile("" : "+v"(tid_l));
    const int lane = tid_l & 63, wid = __builtin_amdgcn_readfirstlane(tid_l >> 6);
    const int c = lane & 15, g = lane >> 4, tok = c & 7, hsel = c >> 3;
    LAS float* imp = (LAS float*)(lds + wid * 16640);
    LAS unsigned* selm = (LAS unsigned*)(lds + wid * 16640 + 4096);
    LAS float* ofl = (LAS float*)(lds + wid * 16640 + 4224) + lane;
    constexpr int TILES = S / 8, NSEQ = NB * 2, NUNITS = NSEQ * TILES;
    unsigned* ctr0 = p.bar + WQ_BASE + 16 * (16 + (i >> 1) * 4);
    const int xcd = (int)xb_xcc_id();
    int qs = 0, nk = xcd & 3;
    for (;;) {
        int up;
        for (;;) { up = wq_next(ctr0 + 16 * nk, lane); if (up < TILES || ++qs >= NSEQ) break; nk = (xcd + qs) & 3; }
        if (qs >= NSEQ) break;
        const int tile = TILES - 1 - up;
        const int n = nk >> 1, kv = nk & 1, t0 = tile * 8, tq = t0 + tok;
        const size_t rowq = (size_t)(n * S + tq);
        bf16x8_t q[3][2]; float sl2[3];
#pragma unroll
        for (int b = 0; b < 3; ++b) {
            const int hd = kv * 6 + 2 * b + hsel;
            sl2[b] = slope_b(hd) * LOG2E;
#pragma unroll
            for (int ks = 0; ks < 2; ++ks) q[b][ks] = scale_q(*(const bf16x8_t*)(p.proj + rowq * WP + hd * 64 + 32 * ks + 8 * g));
        }
#define GATE(b, br) sigmoid_f(bf2f(p.proj[rowq * WP + 1536 + (kv * 6 + 2 * (b) + hsel) * 3 + (br)]))
#pragma unroll
        for (int k = 0; k < 16; ++k) imp[lane + 64 * k] = 0.f;

        const bf16_t* kcb = p.kcmp + (size_t)nk * CSTR * 64;
        const bf16_t* vcb = p.vcmpt + (size_t)nk * 64 * CSTR;
        const int ncv = (t0 + 7 >= 31) ? ((t0 + 7 - 31) / 16 + 1) : 0;
        const int nch = (ncv + 31) / 32;
        const float dq = (float)(tq - 31);
        float mc[3], il[3];
        {
            Stream<3> s1; s1.reset2();
            bf16x8_t kf[2][2];
            if (nch > 0) load_kt(kf, kcb + (size_t)(32 * (nch - 1)) * 64, c, g);
            for (int ch = nch - 1; ch >= 0; --ch) {
                const float dist0 = dq - 16.f * (float)(32 * ch + 8 * g);
                float x[3][8];
                qk_folded<3>(x, kf, q, sl2, s1.m, dist0, 16.f);
                if (ch > 0) load_kt(kf, kcb + (size_t)(32 * (ch - 1)) * 64, c, g);
                if (!__all(dist0 - 7.f * 16.f >= 0.f)) mask_folded<3>(x, dist0, 16.f);
                bool need = false;
#pragma unroll
                for (int b = 0; b < 3; ++b) need |= (max8q(x[b]) > s1.thr[b]);
                if (__any(need)) refresh_folded<3>(s1, x);
#pragma unroll
                for (int b = 0; b < 3; ++b) {
                    float pj[8];
#pragma unroll
                    for (int j = 0; j < 8; ++j) pj[j] = ex2(x[b][j]);
                    s1.l[b] += ((pj[0] + pj[1]) + (pj[2] + pj[3])) + ((pj[4] + pj[5]) + (pj[6] + pj[7]));
                }
            }
#pragma unroll
            for (int b = 0; b < 3; ++b) { const float lt = xsum4(s1.l[b]); il[b] = 1.0f / fmaxf(lt, 1e-30f); mc[b] = s1.m[b]; }
        }
        {
            Stream<3> st; st.reset();
            for (int ch = nch - 1; ch >= 0; --ch) {
                bf16x8_t kf[2][2], vf[4];
                load_kt(kf, kcb + (size_t)(32 * ch) * 64, c, g);
                load_v(vf, vcb + (size_t)(32 * ch) * 64, VT_LD, c, g);
                const float dist0 = dq - 16.f * (float)(32 * ch + 8 * g);
                float x[3][8];
                qk_folded<3>(x, kf, q, sl2, mc, dist0, 16.f);
                if (!__all(dist0 - 7.f * 16.f >= 0.f)) mask_folded<3>(x, dist0, 16.f);
                float a0 = 0.f, a1 = 0.f, a2 = 0.f;
#pragma unroll
                for (int b = 0; b < 3; ++b) {
                    float pj[8];
#pragma unroll
                    for (int j = 0; j < 8; ++j) pj[j] = ex2(x[b][j]) * il[b];
                    a0 += 2.f * (pj[0] + pj[1] + pj[2]) + pj[3];
                    a1 += pj[3] + 2.f * (pj[4] + pj[5] + pj[6]) + pj[7];
                    a2 += pj[7];
                    union { bf16x8_t v; unsigned u[4]; } pk;
#pragma unroll
                    for (int j = 0; j < 4; ++j) pk.u[j] = cvt_pk(pj[2 * j], pj[2 * j + 1]);
#pragma unroll
                    for (int d = 0; d < 4; ++d) st.o[b][d] = MFMA16(vf[d], pk.v, st.o[b][d]);
                }
                a0 += __shfl_xor(a0, 8); a1 += __shfl_xor(a1, 8); a2 += __shfl_xor(a2, 8);
                if (hsel == 0) {
                    const int b0 = 8 * ch + 2 * g;
                    __hip_atomic_fetch_add(imp + tok * 128 + b0, a0, __ATOMIC_RELAXED, __HIP_MEMORY_SCOPE_WORKGROUP);
                    __hip_atomic_fetch_add(imp + tok * 128 + b0 + 1, a1, __ATOMIC_RELAXED, __HIP_MEMORY_SCOPE_WORKGROUP);
                    if (b0 + 2 < 128) __hip_atomic_fetch_add(imp + tok * 128 + b0 + 2, a2, __ATOMIC_RELAXED, __HIP_MEMORY_SCOPE_WORKGROUP);
                }
            }
#pragma unroll
            for (int b = 0; b < 3; ++b) {
                const float sc = GATE(b, 0);
#pragma unroll
                for (int d = 0; d < 4; ++d)
#pragma unroll
                    for (int j = 0; j < 4; ++j) ofl[64 * ((b * 4 + d) * 4 + j)] = st.o[b][d][j] * sc;
            }
        }
        asm volatile("s_waitcnt lgkmcnt(0)" ::: "memory");

        unsigned long long un0 = 0ull, un1 = 0ull;
        for (int tk = 0; tk < 8; ++tk) {
            const int tqk = t0 + tk, cur = tqk >> 6;
            float v0 = imp[tk * 128 + lane], v1 = imp[tk * 128 + 64 + lane];
            const int b0 = lane, b1 = lane + 64;
            v0 = (b0 * 64 > tqk) ? -INFINITY : ((b0 == 0 || b0 == cur || b0 == cur - 1) ? 1e4f : v0);
            v1 = (b1 * 64 > tqk) ? -INFINITY : ((b1 == cur || b1 == cur - 1) ? 1e4f : v1);
            const unsigned k0 = v0 < 0.f ? 0u : __float_as_uint(v0) + 1u, k1 = v1 < 0.f ? 0u : __float_as_uint(v1) + 1u;
            unsigned T = 0u;
            for (int bit = 31; bit >= 0; --bit) {
                const unsigned cand = T | (1u << bit);
                const int cnt = __popcll(__ballot(k0 >= cand)) + __popcll(__ballot(k1 >= cand));
                if (cnt >= 16) T = cand;
            }
            const unsigned long long gt0 = __ballot(k0 > T), gt1 = __ballot(k1 > T), eq0 = __ballot(k0 == T), eq1 = __ballot(k1 == T);
            const int need = 16 - (__popcll(gt0) + __popcll(gt1));
            const unsigned long long below = (1ull << lane) - 1ull;
            const bool s0 = (k0 > T) || ((k0 == T) && (__popcll(eq0 & below) < need));
            const bool s1 = (k1 > T) || ((k1 == T) && (__popcll(eq0) + __popcll(eq1 & below) < need));
            const unsigned long long m0 = __ballot(s0), m1 = __ballot(s1);
            un0 |= m0; un1 |= m1;
            if (lane == 0) { selm[tk * 4 + 0] = (unsigned)m0; selm[tk * 4 + 1] = (unsigned)(m0 >> 32); selm[tk * 4 + 2] = (unsigned)m1; selm[tk * 4 + 3] = (unsigned)(m1 >> 32); }
        }
        asm volatile("s_waitcnt lgkmcnt(0)" ::: "memory");
        const unsigned sm0 = selm[tok * 4 + 0], sm1 = selm[tok * 4 + 1], sm2 = selm[tok * 4 + 2], sm3 = selm[tok * 4 + 3];

        {
            Stream<3> st; st.reset2();
            const bf16_t* kb = p.kts + (size_t)nk * 64 * S;
            const bf16_t* vb = p.vts + (size_t)nk * 64 * S;
            const int bmax = (t0 + 7) >> 6;
            LAS int* chl = (LAS int*)imp;
            int nchk = 0;
            for (int blk = bmax; blk >= 0; --blk) {
                const bool inun = blk < 64 ? ((un0 >> blk) & 1ull) : ((un1 >> (blk - 64)) & 1ull);
                if (!inun) continue;
                if (blk * 64 + 32 <= t0 + 7) { if (lane == 0) chl[nchk] = blk * 64 + 32; ++nchk; }
                if (lane == 0) chl[nchk] = blk * 64; ++nchk;
            }
            asm volatile("s_waitcnt lgkmcnt(0)" ::: "memory");
            if (nchk > 0) {
                bf16x8_t kf[2][2], vf[4];
                int k0 = __builtin_amdgcn_readfirstlane(chl[0]);
                load_kt(kf, kb + (size_t)k0 * 64, c, g);
                for (int ci = 0; ci < nchk; ++ci) {
                    const int kn = ci + 1 < nchk ? __builtin_amdgcn_readfirstlane(chl[ci + 1]) : 0;
                    load_v(vf, vb + (size_t)k0 * 64, VT_LD, c, g);
                    const int blk = k0 >> 6;
                    const unsigned w = blk < 32 ? sm0 : (blk < 64 ? sm1 : (blk < 96 ? sm2 : sm3));
                    const bool ok = (w >> (blk & 31)) & 1u;
                    chunk_attend_pf<3>(st, kf, vf, q, sl2, (float)(tq - k0 - 8 * g), 1.f, 1e30f, ok, ci + 1 < nchk,
                                       [&](bf16x8_t (&kfn)[2][2]) { load_kt(kfn, kb + (size_t)kn * 64, c, g); });
                    k0 = kn;
                }
            }
#pragma unroll
            for (int b = 0; b < 3; ++b) {
                const float lt = xsum4(st.l[b]); const float sc = lt > 0.f ? GATE(b, 1) / lt : 0.f;
#pragma unroll
                for (int d = 0; d < 4; ++d)
#pragma unroll
                    for (int j = 0; j < 4; ++j) ofl[64 * ((b * 4 + d) * 4 + j)] += st.o[b][d][j] * sc;
            }
        }
        {
            Stream<3> st; st.reset2();
            const bf16_t* kb = p.ktw + (size_t)nk * 64 * S;
            const bf16_t* vb = p.vtw + (size_t)nk * 64 * S;
            const int klo = (t0 - 512 > 0 ? t0 - 512 : 0) & ~31;
            {
                bf16x8_t kf[2][2], vf[4];
                int k0 = (t0 + 7) & ~31;
                load_kt(kf, kb + (size_t)k0 * 64, c, g);
                for (; k0 >= klo; k0 -= 32) {
                    load_v(vf, vb + (size_t)k0 * 64, VT_LD, c, g);
                    const int kn = k0 - 32;
                    chunk_attend_pf<3>(st, kf, vf, q, sl2, (float)(tq - k0 - 8 * g), 1.f, 512.f, true, kn >= klo,
                                       [&](bf16x8_t (&kfn)[2][2]) { load_kt(kfn, kb + (size_t)kn * 64, c, g); });
                }
            }
#pragma unroll
            for (int b = 0; b < 3; ++b) {
                const float lt = xsum4(st.l[b]); const float sc = lt > 0.f ? GATE(b, 2) / lt : 0.f;
                const int hd = kv * 6 + 2 * b + hsel;
#pragma unroll
                for (int d = 0; d < 4; ++d) {
                    float of[4];
#pragma unroll
                    for (int j = 0; j < 4; ++j) of[j] = ofl[64 * ((b * 4 + d) * 4 + j)] + st.o[b][d][j] * sc;
                    const int col = hd * 64 + 16 * d + 4 * g;
                    const uint2 gm = *(const uint2*)(p.proj + rowq * WP + 1572 + col);
                    const float g0 = __uint_as_float(gm.x << 16), g1 = __uint_as_float(gm.x & 0xffff0000u), g2 = __uint_as_float(gm.y << 16), g3 = __uint_as_float(gm.y & 0xffff0000u);
                    uint2 o; o.x = cvt_pk(of[0] * silu_f(g0), of[1] * silu_f(g1)); o.y = cvt_pk(of[2] * silu_f(g2), of[3] * silu_f(g3));
                    *(uint2*)(p.z + rowq * 1024 + col) = o;
                }
            }
        }
        asm volatile("s_waitcnt lgkmcnt(0)" ::: "memory");
#undef GATE
    }
}

constexpr int NXB = 4;
__device__ __forceinline__ void cross_unit(const Params& p, int i, int n, int h, size_t rowq0, int qoff, int goff, int zld, int zoff, int c, int g) {
    bf16x8_t q[NXB][2];
#pragma unroll
    for (int b = 0; b < NXB; ++b)
#pragma unroll
        for (int ks = 0; ks < 2; ++ks) q[b][ks] = scale_q(*(const bf16x8_t*)(p.proj + (rowq0 + 16 * b) * WP + qoff + h * 64 + 32 * ks + 8 * g));
    float sl2[NXB];
#pragma unroll
    for (int b = 0; b < NXB; ++b) sl2[b] = 0.f;
    Stream<NXB> st; st.reset2();
    const bf16_t* kb = p.mkb + (((size_t)i * NB + n) * 4 + h) * NM * 64;
    const bf16_t* vb = p.mvt + (((size_t)i * NB + n) * 4 + h) * 64 * NM;
    {
        bf16x8_t kf[2][2], vf[4];
        load_kt(kf, kb + (size_t)(NM - 32) * 64, c, g);
        for (int k0 = NM - 32; k0 >= 0; k0 -= 32) {
            load_v(vf, vb + (size_t)k0 * 64, VT_LD, c, g);
            const int kn = k0 - 32;
            chunk_attend_pf<NXB>(st, kf, vf, q, sl2, 0.f, 0.f, 1e30f, true, kn >= 0, [&](bf16x8_t (&kfn)[2][2]) { load_kt(kfn, kb + (size_t)kn * 64, c, g); });
        }
    }
#pragma unroll
    for (int b = 0; b < NXB; ++b) {
        const size_t rowq = rowq0 + 16 * b;
        const float lt = xsum4(st.l[b]); const float il = 1.0f / lt;
#pragma unroll
        for (int d = 0; d < 4; ++d) {
            const int col = h * 64 + 16 * d + 4 * g;
            const uint2 gm = *(const uint2*)(p.proj + rowq * WP + goff + col);
            const float g0 = __uint_as_float(gm.x << 16), g1 = __uint_as_float(gm.x & 0xffff0000u), g2 = __uint_as_float(gm.y << 16), g3 = __uint_as_float(gm.y & 0xffff0000u);
            uint2 o; o.x = cvt_pk(st.o[b][d][0] * il * silu_f(g0), st.o[b][d][1] * il * silu_f(g1)); o.y = cvt_pk(st.o[b][d][2] * il * silu_f(g2), st.o[b][d][3] * il * silu_f(g3));
            *(uint2*)(p.z + rowq * zld + zoff + col) = o;
        }
    }
}

__device__ __forceinline__ void fast_cross_q(const Params& p, int i, int qoff, int goff, int zld, int zoff, int cslot = 1) {
    int tid_l = threadIdx.x; asm volatile("" : "+v"(tid_l));
    const int lane = tid_l & 63, wid = __builtin_amdgcn_readfirstlane(tid_l >> 6), c = lane & 15, g = lane >> 4;
    unsigned* ctr = p.bar + WQ_BASE + 16 * (i * 4 + cslot);
    constexpr int XT = S / (16 * NXB);
    for (;;) {
        const int u = wq_next(ctr, lane);
        if (u >= NB * 4 * XT) break;
        const int tile = u % XT, nh = u / XT, n = nh >> 2, h = nh & 3;
        cross_unit(p, i, n, h, (size_t)(n * S + tile * 16 * NXB + c), qoff, goff, zld, zoff, c, g);
    }
}
__device__ __forceinline__ void fast_cross_b(const Params& p, int i, int cslot = 1) { fast_cross_q(p, i, 2340, 2596, 1024, 768, cslot); }
__device__ __forceinline__ void fast_cross_a(const Params& p, int i, int cslot = 1) { fast_cross_q(p, i, 2560, 2816, 512, 256, cslot); }

constexpr int NBA = 2;
static_assert((S / 256) % NBA == 0, "block groups");
static_assert(NB * 4 * (S / 16 / NBA) >= CONV_NITEMS, "attention units vs conversion items");
__device__ __forceinline__ void fast_attn_a(const Params& p, int i, bool with_conv, int cslot = 0) {
    int tid_l = threadIdx.x; asm volatile("" : "+v"(tid_l));
    const int lane = tid_l & 63, wid = __builtin_amdgcn_readfirstlane(tid_l >> 6), c = lane & 15, g = lane >> 4;
    unsigned* ctr = p.bar + WQ_BASE + 16 * (i * 4 + cslot);
    constexpr int CPU_ = S / 16 / NBA, NATT = NB * 4 * CPU_;
    const int nconv = with_conv ? CONV_NITEMS : 0;
    for (;;) {
        const int id = wq_next(ctr, lane);
        if (id >= NATT + nconv) break;
        int u;
        if (id < 2 * nconv) { if ((id & 1) == 0) { conv_item(p, id >> 1, lane); continue; } u = id >> 1; } else u = id - nconv;
        const int cgp = u % CPU_, nh = u / CPU_, n = nh >> 2, h = nh & 3;
        const int bp = cgp >> 4, r16 = cgp & 15;
        const int tq0 = bp * (NBA * 256) + r16 + 16 * c;
        const size_t rowq0 = (size_t)(n * S + tq0);
        Stream<NBA> st; st.reset2();
#pragma unroll 1
        for (int gi = 0; gi < 3; ++gi) {
            const int d = dil_of(gi), r = r16 % d, U = S / d;
            bf16x8_t q[NBA][2];
#pragma unroll
            for (int b = 0; b < NBA; ++b)
#pragma unroll
                for (int ks = 0; ks < 2; ++ks) q[b][ks] = scale_q(*(const bf16x8_t*)(p.proj + (rowq0 + 256 * b) * WP + gi * 256 + h * 64 + 32 * ks + 8 * g));
            const float sl2 = slope_a(gi, h) * (float)d * LOG2E;
            const int uq0 = tq0 / d, ustep = 256 / d;
            const int umin = (bp * (NBA * 256) + r16) / d, umax = (bp * (NBA * 256) + (NBA - 1) * 256 + r16 + 240) / d;
            const int ulo = (umin - 128 > 0 ? umin - 128 : 0) & ~31;
            const bf16_t* kb = p.kta + ((((size_t)gi * NB + n) * 4 + h) * 64) * S + (size_t)r * U * 64;
            const bf16_t* vb = p.vta + ((((size_t)gi * NB + n) * 4 + h) * 64) * S + (size_t)r * U * 64;
            chunk_loop(umax & ~31, ulo,
                [&](int uk0, bf16x8_t (&kf)[2][2], bf16x8_t (&vf)[4]) { load_kt(kf, kb + (size_t)uk0 * 64, c, g); load_v(vf, vb + (size_t)uk0 * 64, VT_LD, c, g); },
                [&](int uk0, const bf16x8_t (&kf)[2][2], const bf16x8_t (&vf)[4]) {
                    float dist0[NBA];
#pragma unroll
                    for (int b = 0; b < NBA; ++b) dist0[b] = (float)(uq0 + b * ustep - uk0 - 8 * g);
                    chunk_attend_mb<NBA>(st, kf, vf, q, sl2, dist0, 128.f);
                });
        }
#pragma unroll
        for (int b = 0; b < NBA; ++b) {
            const size_t rowq = rowq0 + 256 * b;
            const float lt = xsum4(st.l[b]); const float il = 1.0f / lt;
#pragma unroll
            for (int dd = 0; dd < 4; ++dd) {
                const int col = h * 64 + 16 * dd + 4 * g;
                const uint2 gm = *(const uint2*)(p.proj + rowq * WP + 2304 + col);
                const float g0 = __uint_as_float(gm.x << 16), g1 = __uint_as_float(gm.x & 0xffff0000u), g2 = __uint_as_float(gm.y << 16), g3 = __uint_as_float(gm.y & 0xffff0000u);
                uint2 o; o.x = cvt_pk(st.o[b][dd][0] * il * silu_f(g0), st.o[b][dd][1] * il * silu_f(g1)); o.y = cvt_pk(st.o[b][dd][2] * il * silu_f(g2), st.o[b][dd][3] * il * silu_f(g3));
                *(uint2*)(p.z + rowq * 512 + col) = o;
            }
        }
    }
}

constexpr int PB_S = NS * 2 * HB_S / 256;
struct BatchOrder {
    int G, c;
    __device__ __forceinline__ bool next(int i, pg8::Unit& u) const { const int L = i * G + c; if (L >= 4 * PB_S) return false; u.pm = L; u.pn = L / PB_S; return true; }
    __device__ __forceinline__ void a_ready(const pg8::Unit&) const {}
    __device__ __forceinline__ void done(const pg8::Unit&) const {}
};
struct EpiPQ {
    static constexpr bool PERM = true, AFTER_DRAIN = false;
    bf16_t* O;
    __device__ __forceinline__ void operator()(const pg8::f32x4 (&acc)[2][2][4][2], const pg8::Unit& u, int wr, int wc, int fr, int fq) const {
        const int row0 = u.pm * 256 + wr * 64 + fr, col0 = wc * 32 + 8 * fq;
#pragma unroll
        for (int ai = 0; ai < 2; ++ai)
#pragma unroll
            for (int m = 0; m < 4; ++m) {
                bf16_t* rowp = O + (size_t)(row0 + ai * 128 + m * 16) * 256 + col0;
#pragma unroll
                for (int bj = 0; bj < 2; ++bj) {
                    const pg8::f32x4 v0 = acc[ai][bj][m][0], v1 = acc[ai][bj][m][1];
                    pg8::u32x4 w; w.x = pg8::cvt_pk_bf16(v0[0], v0[1]); w.y = pg8::cvt_pk_bf16(v0[2], v0[3]); w.z = pg8::cvt_pk_bf16(v1[0], v1[1]); w.w = pg8::cvt_pk_bf16(v1[2], v1[3]);
                    *(pg8::u32x4*)(rowp + bj * 128) = w;
                }
            }
    }
};
__device__ __forceinline__ void fast_pq_s(const Params& p, LAS unsigned char* lds) {
    pg8::Gemm g; g.A = p.cachec; g.Bt = p.w1pq; g.M = 4 * PB_S * 256; g.N = 1024; g.K = 1024;
    BatchOrder so; so.G = gridDim.x; so.c = blockIdx.x;
    EpiPQ E; E.O = p.pq_s;
    pg8::gemm_phase<EpiPQ, BatchOrder, false>(lds, g, so, E, nullptr);
}
__device__ __forceinline__ void fast_pq_p(const Params& p, int li) {
    int tid_l = threadIdx.x; asm volatile("" : "+v"(tid_l));
    const int lane = tid_l & 63, wid = __builtin_amdgcn_readfirstlane(tid_l >> 6);
    const int gw = blockIdx.x * (NTHREADS / 64) + wid, nw = gridDim.x * (NTHREADS / 64);
    constexpr int RT = HB_P / 16;
    for (int u = gw; u < 2 * NB * 2 * RT * 8; u += nw) {
        const int cg = u % 8, rt = (u / 8) % RT, nk = (u / (8 * RT)) % (NB * 2), ty = u / (8 * RT * NB * 2), n = nk >> 1, kv = nk & 1;
        float v[8];
        wave_tile_32x16(p.proj + (size_t)(n * S) * WP + 768 + ty * 128 + kv * 64, (size_t)16 * WP, p.w1pq + (size_t)(li * 2 + ty) * 256 * 1024, 1024, rt * 16, cg * 32, 1024, v, lane, WP);
        st8_bf(p.pq_p + (((size_t)ty * NB * 2 + nk) * HB_P + rt * 16 + (lane & 15)) * 256 + cg * 32 + 8 * (lane >> 4), v);
    }
}
template <bool TILED> __device__ __forceinline__ void cmpc_tile(const bf16_t* pq, const float* cb, const bf16_t* w2t, int c0, bool is_v, bf16_t* kout, bf16_t* vout, int lane) {
    const int m = lane & 15, g = lane >> 4;
    bf16x8_t hf[4];
#pragma unroll
    for (int ks = 0; ks < 4; ++ks) {
        const int j0 = 32 * ks + 8 * g;
        float a[8], b[8]; ld8(pq + (size_t)(c0 + m) * 256 + j0, a); ld8(pq + (size_t)(c0 + m + 1) * 256 + 128 + j0, b);
        union { bf16x8_t v; unsigned u[4]; } pk;
#pragma unroll
        for (int j = 0; j < 4; ++j) pk.u[j] = cvt_pk(silu_f(a[2 * j] + b[2 * j] + cb[j0 + 2 * j]), silu_f(a[2 * j + 1] + b[2 * j + 1] + cb[j0 + 2 * j + 1]));
        hf[ks] = pk.v;
    }
#pragma unroll
    for (int eb = 0; eb < 4; ++eb) {
        f32x4_t d = {0.f, 0.f, 0.f, 0.f};
#pragma unroll
        for (int ks = 0; ks < 4; ++ks) {
            const bf16x8_t wf = *(const bf16x8_t*)(w2t + (size_t)(16 * eb + m) * 128 + 32 * ks + 8 * g);
            d = is_v ? MFMA16(hf[ks], wf, d) : MFMA16(wf, hf[ks], d);
        }
        uint2 o; o.x = cvt_pk(d[0], d[1]); o.y = cvt_pk(d[2], d[3]);
        if (TILED) {
            if (is_v) *(uint2*)(vout + vt_pos(c0 + 4 * g) + (16 * eb + m) * VT_LD) = o;
            else *(uint2*)(kout + kt_pos(c0 + m, 16 * eb + 4 * g)) = o;
        } else {
            if (is_v) *(uint2*)(vout + (size_t)(16 * eb + m) * CSTR + c0 + 4 * g) = o;
            else *(uint2*)(kout + (size_t)(c0 + m) * 64 + 16 * eb + 4 * g) = o;
        }
    }
}
__device__ __forceinline__ void fast_cmpc_s(const Params& p) {
    int tid_l = threadIdx.x; asm volatile("" : "+v"(tid_l));
    const int lane = tid_l & 63, wid = __builtin_amdgcn_readfirstlane(tid_l >> 6);
    const int gw = blockIdx.x * (NTHREADS / 64) + wid, nw = gridDim.x * (NTHREADS / 64);
    for (int u = gw; u < 4 * NS * 2 * (CSTR / 16); u += nw) {
        const int ct = u % (CSTR / 16), nk = (u / (CSTR / 16)) % (NS * 2), lt = u / ((CSTR / 16) * NS * 2), li = lt >> 1, ty = lt & 1;
        cmpc_tile<false>(p.pq_s + ((size_t)lt * NS * 2 + nk) * HB_S * 256, p.cb + lt * 128, p.w2t + (size_t)lt * 64 * 128, ct * 16, ty == 1,
                  p.kcmp_s + ((size_t)li * NS * 2 + nk) * CSTR * 64, p.vcmpt_s + ((size_t)li * NS * 2 + nk) * 64 * CSTR, lane);
    }
}
__device__ __forceinline__ void fast_cmpc_p(const Params& p, int li) {
    int tid_l = threadIdx.x; asm volatile("" : "+v"(tid_l));
    const int lane = tid_l & 63, wid = __builtin_amdgcn_readfirstlane(tid_l >> 6);
    const int gw = blockIdx.x * (NTHREADS / 64) + wid, nw = gridDim.x * (NTHREADS / 64);
    for (int u = gw; u < 2 * NB * 2 * (CSTR / 16); u += nw) {
        const int ct = u % (CSTR / 16), nk = (u / (CSTR / 16)) % (NB * 2), ty = u / ((CSTR / 16) * NB * 2), lt = li * 2 + ty;
        cmpc_tile<true>(p.pq_p + ((size_t)ty * NB * 2 + nk) * HB_P * 256, p.cb + lt * 128, p.w2t + (size_t)lt * 64 * 128, ct * 16, ty == 1,
                  p.kcmp + (size_t)nk * CSTR * 64, p.vcmpt + (size_t)nk * 64 * CSTR, lane);
    }
}


__device__ __forceinline__ float wave_max(float v) {
#pragma unroll
    for (int o = 32; o > 0; o >>= 1) v = fmaxf(v, __shfl_xor(v, o));
    return v;
}
__device__ __forceinline__ float dot_qf(const float* k, const float (&q)[64]) { float a = 0.f; DOT64_F(a, q, k); return a; }
__device__ __forceinline__ float dot_qb(const bf16_t* k, const float (&q)[64]) { float a = 0.f; DOT64_B(a, q, k); return a; }
#define LDS_SYNC_WAVE() asm volatile("s_waitcnt lgkmcnt(0)" ::: "memory")


__device__ __forceinline__ void pv4_f32(float4& acc, const float* vb, size_t vstride, const LAS float* pl, int nkeys, int lane) {
    const int kq = lane >> 4, dq = lane & 15;
    const float* v = vb + (size_t)kq * vstride + 4 * dq;
#pragma unroll 16
    for (int k = kq; k < nkeys; k += 4) {
        const float4 x = *(const float4*)v; const float pr = pl[k];
        acc.x += pr * x.x; acc.y += pr * x.y; acc.z += pr * x.z; acc.w += pr * x.w;
        v += 4 * vstride;
    }
}
__device__ __forceinline__ void pv4_reduce(float4& a) {
    a.x = xsum4(a.x); a.y = xsum4(a.y); a.z = xsum4(a.z); a.w = xsum4(a.w);
}
__device__ __forceinline__ void pv4_bf16_row(float4& acc, const bf16_t* vrow, float pr, int lane) {
    if ((lane >> 4) == 0) {
        const uint2 u = *(const uint2*)(vrow + 4 * (lane & 15));
        acc.x += pr * __uint_as_float(u.x << 16); acc.y += pr * __uint_as_float(u.x & 0xffff0000u); acc.z += pr * __uint_as_float(u.y << 16); acc.w += pr * __uint_as_float(u.y & 0xffff0000u);
    }
}
__device__ __forceinline__ void store4_gated(bf16_t* zdst, const bf16_t* gate, const float4& a, float scale, int lane) {
    if ((lane >> 4) == 0) {
        const int dq = lane & 15;
        const uint2 gm = *(const uint2*)(gate + 4 * dq);
        const float g0 = __uint_as_float(gm.x << 16), g1 = __uint_as_float(gm.x & 0xffff0000u), g2 = __uint_as_float(gm.y << 16), g3 = __uint_as_float(gm.y & 0xffff0000u);
        uint2 o; o.x = cvt_pk(a.x * scale * silu_f(g0), a.y * scale * silu_f(g1)); o.y = cvt_pk(a.z * scale * silu_f(g2), a.w * scale * silu_f(g3));
        *(uint2*)(zdst + 4 * dq) = o;
    }
}

__device__ __forceinline__ void dec_cross(const Params& p, int i, int n, int h, int qoff, int goff, int zld, int zoff, LAS float* sb, int lane) {
    const size_t row = (size_t)(MP + n);
    float q[64]; LD64_B(q, p.proj + row * WP + qoff + h * 64);
    const float* kb = p.cache_mem_kv + ((size_t)i * NS + n) * NM * 512 + h * 64;
    float mx = -INFINITY;
    for (int m = lane; m < NM; m += 64) { const float x = dot_qf(kb + (size_t)m * 512, q) * C1; sb[m] = x; mx = fmaxf(mx, x); }
    mx = wave_max(mx);
    LDS_SYNC_WAVE();
    float l = 0.f;
    for (int m = lane; m < NM; m += 64) { const float e = ex2(sb[m] - mx); sb[m] = e; l += e; }
    l = wave_sum(l);
    LDS_SYNC_WAVE();
    float4 o = make_float4(0.f, 0.f, 0.f, 0.f);
    pv4_f32(o, kb + 256, 512, sb, NM, lane);
    pv4_reduce(o);
    LDS_SYNC_WAVE();
    store4_gated(p.z + row * zld + zoff + h * 64, p.proj + row * WP + goff + h * 64, o, 1.0f / l, lane);
}

__device__ __forceinline__ void fast_dec_a(const Params& p, int i, LAS unsigned char* lds) {
    int tid_l = threadIdx.x; asm volatile("" : "+v"(tid_l));
    const int lane = tid_l & 63, wid = __builtin_amdgcn_readfirstlane(tid_l >> 6), li = i >> 1;
    LAS float* sb = (LAS float*)(lds + wid * 16640);
    const int part = wid & 3;
    for (int u = blockIdx.x; u < NS * 2; u += gridDim.x) {
        const int unit = 2 * u + (wid >> 2), n = unit >> 2, h = unit & 3;
        const size_t row = (size_t)(MP + n);
        if (part < 3) {
            const int g = part, d = dil_of(g), lb = lb_of(g);
            const float sl2 = slope_a(g, h) * LOG2E;
            const float* cache = (g == 0 ? +p.cache_a0 : (g == 1 ? +p.cache_a1 : +p.cache_a2)) + ((size_t)li * NS + n) * lb * 512 + h * 64;
            float q[64]; LD64_B(q, p.proj + row * WP + g * 256 + h * 64);
            const float x0 = dot_qb(p.proj + row * WP + 768 + g * 256 + h * 64, q) * C1;
            const int jmax = (lb / d) < 128 ? (lb / d) : 128;
            float x1 = -INFINITY, x2 = -INFINITY;
            { const int j = 1 + lane; if (j <= jmax) x1 = dot_qf(cache + (size_t)(lb - j * d) * 512, q) * C1 - sl2 * (float)(j * d); }
            { const int j = 65 + lane; if (j <= jmax) x2 = dot_qf(cache + (size_t)(lb - j * d) * 512, q) * C1 - sl2 * (float)(j * d); }
            const float mx = wave_max(fmaxf(x0, fmaxf(x1, x2)));
            const float e1 = ex2(x1 - mx), e2 = ex2(x2 - mx), e0 = ex2(x0 - mx);
            sb[lane] = e1; sb[64 + lane] = e2;
            const float l = wave_sum(e1 + e2) + e0;
            LDS_SYNC_WAVE();
            float4 o = make_float4(0.f, 0.f, 0.f, 0.f);
            pv4_bf16_row(o, p.proj + row * WP + 1536 + g * 256 + h * 64, e0, lane);
            pv4_f32(o, cache + 256 + (size_t)(lb - d) * 512, (size_t)0 - (size_t)d * 512, sb, jmax, lane);
            pv4_reduce(o);
            LDS_SYNC_WAVE();
            if ((lane >> 4) == 0) { sb[256 + 4 * (lane & 15) + 0] = o.x; sb[256 + 4 * (lane & 15) + 1] = o.y; sb[256 + 4 * (lane & 15) + 2] = o.z; sb[256 + 4 * (lane & 15) + 3] = o.w; }
            if (lane == 0) { sb[320] = mx; sb[321] = l; }
        } else {
            dec_cross(p, i, n, h, 2560, 2816, 512, 256, sb, lane);
        }
        __syncthreads();
        if (part == 0) {
            const LAS float* s0 = (const LAS float*)(lds + (wid + 0) * 16640), *s1 = (const LAS float*)(lds + (wid + 1) * 16640), *s2 = (const LAS float*)(lds + (wid + 2) * 16640);
            const float m0 = s0[320], m1 = s1[320], m2 = s2[320], mm = fmaxf(m0, fmaxf(m1, m2));
            const float w0 = ex2(m0 - mm), w1 = ex2(m1 - mm), w2 = ex2(m2 - mm);
            const float l = s0[321] * w0 + s1[321] * w1 + s2[321] * w2;
            const float o = s0[256 + lane] * w0 + s1[256 + lane] * w1 + s2[256 + lane] * w2;
            p.z[row * 512 + h * 64 + lane] = f2bf(o / l * silu_f(bf2f(p.proj[row * WP + 2304 + h * 64 + lane])));
        }
        __syncthreads();
    }
}
__device__ __forceinline__ void fast_dec_cross_b(const Params& p, int i, LAS unsigned char* lds) {
    int tid_l = threadIdx.x; asm volatile("" : "+v"(tid_l));
    const int lane = tid_l & 63, wid = __builtin_amdgcn_readfirstlane(tid_l >> 6);
    LAS float* sb = (LAS float*)(lds + wid * 16640);
    const int gw = wid * gridDim.x + (gridDim.x - 1 - blockIdx.x), nw = gridDim.x * (NTHREADS / 64);
    for (int u = gw; u < NS * 4; u += nw) dec_cross(p, i, u >> 2, u & 3, 2340, 2596, 1024, 768, sb, lane);
}

__device__ __forceinline__ void fast_dec_nsa(const Params& p, int i, LAS unsigned char* lds) {
    int tid_l = threadIdx.x; asm volatile("" : "+v"(tid_l));
    const int lane = tid_l & 63, wid = __builtin_amdgcn_readfirstlane(tid_l >> 6), li = i >> 1;
    static_assert(NSEL_S == 129 && NC_S == 511 && PL % 128 == 0 && LBW == 512, "decode NSA is written for PAST_LEN 8192");
    LAS float* sb = (LAS float*)(lds + wid * 16640);
    LAS float* pcw = (LAS float*)(lds + wid * 16640 + 8192);
    LAS int* sel = (LAS int*)(lds + 8 * 16640 - 1024);
    for (int u = blockIdx.x; u < NS * 2; u += gridDim.x) {
        const int n = u >> 1, kv = u & 1, hd = kv * 6 + wid;
        const size_t row = (size_t)(MP + n);
        const bool act = wid < 6;
        const float sl2 = slope_b(act ? hd : 0) * LOG2E;
        float q[64]; LD64_B(q, p.proj + row * WP + (act ? hd : 0) * 64);
        float oacc = 0.f; float4 oacc4 = make_float4(0.f, 0.f, 0.f, 0.f);
        if (act) {
            const bf16_t* kb = p.kcmp_s + ((size_t)li * NS * 2 + n * 2 + kv) * CSTR * 64;
            const bf16_t* vb = p.vcmpt_s + ((size_t)li * NS * 2 + n * 2 + kv) * 64 * CSTR + (size_t)lane * CSTR;
            float mx = -INFINITY;
#pragma unroll 2
            for (int c = lane; c < 512; c += 64) {
                float x = dot_qb(kb + (size_t)c * 64, q) * C1 - sl2 * (float)(PL - (16 * c + 31));
                if (c >= NC_S) x = -INFINITY;
                sb[c] = x; mx = fmaxf(mx, x);
            }
            mx = wave_max(mx);
            LDS_SYNC_WAVE();
            float l = 0.f;
            for (int c = lane; c < 512; c += 64) { const float e = ex2(sb[c] - mx); sb[c] = e; l += e; }
            l = wave_sum(l);
            const float il = 1.0f / l;
            LDS_SYNC_WAVE();
            for (int c = lane; c < 512; c += 64) pcw[c] = sb[c] * il;
            LDS_SYNC_WAVE();
            float o = 0.f;
#pragma unroll 8
            for (int c0 = 0; c0 < 512; c0 += 8) {
                float v[8]; ld8(vb + c0, v);
#pragma unroll
                for (int j = 0; j < 8; ++j) o += pcw[c0 + j] * v[j];
            }
            oacc = o * sigmoid_f(bf2f(p.proj[row * WP + 1536 + hd * 3 + 0]));
            LDS_SYNC_WAVE();
            sb[lane] = oacc;
            LDS_SYNC_WAVE();
            oacc4 = make_float4(sb[4 * (lane & 15)], sb[4 * (lane & 15) + 1], sb[4 * (lane & 15) + 2], sb[4 * (lane & 15) + 3]);
            LDS_SYNC_WAVE();
        }
        __syncthreads();
        if (wid == 6) {
            float v[3]; unsigned k[3];
#pragma unroll
            for (int t = 0; t < 3; ++t) {
                const int b = lane + 64 * t;
                float a = -1.f;
                if (b < NSEL_S) {
                    a = 0.f;
                    for (int w = 0; w < 6; ++w) {
                        const LAS float* pc = (const LAS float*)(lds + w * 16640 + 8192);
#pragma unroll
                        for (int ii = 4 * b; ii < 4 * b + 4; ++ii) { if (ii < 512) a += pc[ii]; if (ii >= 1 && ii - 1 < 512) a += pc[ii - 1]; }
                    }
                    if (b == 0 || b == 128 || b == 127) a = 1e4f;
                }
                v[t] = a; k[t] = a < 0.f ? 0u : __float_as_uint(a) + 1u;
            }
            unsigned T = 0u;
            for (int bit = 31; bit >= 0; --bit) {
                const unsigned cand = T | (1u << bit);
                const int cnt = __popcll(__ballot(k[0] >= cand)) + __popcll(__ballot(k[1] >= cand)) + __popcll(__ballot(k[2] >= cand));
                if (cnt >= 16) T = cand;
            }
            const unsigned long long below = (1ull << lane) - 1ull;
            int base = 0; const int ngt = __popcll(__ballot(k[0] > T)) + __popcll(__ballot(k[1] > T)) + __popcll(__ballot(k[2] > T));
            const int need = 16 - ngt;
            int eqbefore = 0;
#pragma unroll
            for (int t = 0; t < 3; ++t) {
                const unsigned long long eqm = __ballot(k[t] == T);
                const bool s = (k[t] > T) || ((k[t] == T) && (eqbefore + __popcll(eqm & below) < need));
                const unsigned long long sm = __ballot(s);
                if (s) sel[base + __popcll(sm & below)] = lane + 64 * t;
                base += __popcll(sm); eqbefore += __popcll(eqm);
            }
        }
        __syncthreads();
        if (act) {
            const float g1 = sigmoid_f(bf2f(p.proj[row * WP + 1536 + hd * 3 + 1])), g2 = sigmoid_f(bf2f(p.proj[row * WP + 1536 + hd * 3 + 2]));
            const int myb = sel[lane & 15];
            const int mypage = myb < 128 ? p.page_table[n * NPAGES + (myb >> 1)] : 0;
            float mx = -INFINITY;
            for (int s = 0; s < 16; ++s) {
                const int b = __builtin_amdgcn_readlane(myb, s);
                float x = -INFINITY;
                if (b < 128) {
                    const int kp = b * 64 + lane;
                    const int page = __builtin_amdgcn_readlane(mypage, s);
                    x = dot_qf(p.cache_b_pages + ((((size_t)page * 128 + (kp & 127)) * 2 + li) * 4 + 2) * 128 + kv * 64, q) * C1 - sl2 * (float)(PL - kp);
                } else if (lane == 0) x = dot_qb(p.proj + row * WP + 768 + 2 * 128 + kv * 64, q) * C1;
                sb[s * 64 + lane] = x; mx = fmaxf(mx, x);
            }
            mx = wave_max(mx);
            LDS_SYNC_WAVE();
            float l = 0.f;
            for (int e = lane; e < 1024; e += 64) { const float v = ex2(sb[e] - mx); sb[e] = v; l += v; }
            l = wave_sum(l);
            LDS_SYNC_WAVE();
            float4 o = make_float4(0.f, 0.f, 0.f, 0.f);
            for (int s = 0; s < 16; ++s) {
                const int b = __builtin_amdgcn_readlane(myb, s);
                if (b < 128) {
                    const int page = __builtin_amdgcn_readlane(mypage, s);
                    pv4_f32(o, p.cache_b_pages + ((((size_t)page * 128 + (b & 1) * 64) * 2 + li) * 4 + 3) * 128 + kv * 64, 1024, sb + s * 64, 64, lane);
                } else pv4_bf16_row(o, p.proj + row * WP + 768 + 3 * 128 + kv * 64, sb[s * 64], lane);
            }
            pv4_reduce(o);
            { const float sc = g1 / l; oacc4.x += sc * o.x; oacc4.y += sc * o.y; oacc4.z += sc * o.z; oacc4.w += sc * o.w; }
            LDS_SYNC_WAVE();
            const float* wb = p.cache_b_win + ((size_t)li * NS + n) * LBW * 256 + kv * 64;
            mx = -INFINITY;
            for (int idx = lane; idx < 576; idx += 64) {
                float x = -INFINITY;
                if (idx < 512) x = dot_qf(wb + (size_t)idx * 256, q) * C1 - sl2 * (float)(512 - idx);
                else if (idx == 512) x = dot_qb(p.proj + row * WP + 768 + 4 * 128 + kv * 64, q) * C1;
                sb[idx] = x; mx = fmaxf(mx, x);
            }
            mx = wave_max(mx);
            LDS_SYNC_WAVE();
            l = 0.f;
            for (int e = lane; e < 576; e += 64) { const float v = ex2(sb[e] - mx); sb[e] = v; l += v; }
            l = wave_sum(l);
            LDS_SYNC_WAVE();
            o = make_float4(0.f, 0.f, 0.f, 0.f);
            pv4_bf16_row(o, p.proj + row * WP + 768 + 5 * 128 + kv * 64, sb[512], lane);
            pv4_f32(o, wb + 128, 256, sb, 512, lane);
            pv4_reduce(o);
            { const float sc = g2 / l; oacc4.x += sc * o.x; oacc4.y += sc * o.y; oacc4.z += sc * o.z; oacc4.w += sc * o.w; }
            store4_gated(p.z + row * 1024 + hd * 64, p.proj + row * WP + 1572 + hd * 64, oacc4, 1.0f, lane);
        }
        __syncthreads();
    }
}


constexpr int DSTR = 1152;
__device__ __forceinline__ void dot6_store(const float4 (&x)[16], const LAS float* qs, LAS float* dst, int hd0, float dist, bool valid) {
#pragma unroll 1
    for (int h = 0; h < 6; ++h) {
        float a = 0.f;
#pragma unroll
        for (int j = 0; j < 16; ++j) { const f32x4_t q4 = *(const LAS f32x4_t*)(qs + h * 64 + 4 * j); a += x[j].x * q4[0] + x[j].y * q4[1] + x[j].z * q4[2] + x[j].w * q4[3]; }
        dst[h * DSTR] = valid ? a * C1 - slope_b(hd0 + h) * LOG2E * dist : -INFINITY;
    }
}
__device__ __forceinline__ void ld_row_f32(const float* r, float4 (&x)[16]) {
#pragma unroll
    for (int j = 0; j < 16; ++j) x[j] = *(const float4*)(r + 4 * j);
}
__device__ __forceinline__ void ld_row_b16(const bf16_t* r, float4 (&x)[16]) {
#pragma unroll
    for (int j = 0; j < 8; ++j) {
        const uint4 u = *(const uint4*)(r + 8 * j);
        x[2 * j] = make_float4(__uint_as_float(u.x << 16), __uint_as_float(u.x & 0xffff0000u), __uint_as_float(u.y << 16), __uint_as_float(u.y & 0xffff0000u));
        x[2 * j + 1] = make_float4(__uint_as_float(u.z << 16), __uint_as_float(u.z & 0xffff0000u), __uint_as_float(u.w << 16), __uint_as_float(u.w & 0xffff0000u));
    }
}
__device__ __forceinline__ float dec_softmax(LAS float* sch, int nk, bool norm, int lane) {
    float mx = -INFINITY;
    for (int k = lane; k < nk; k += 64) mx = fmaxf(mx, sch[k]);
    mx = wave_max(mx);
    float l = 0.f;
    for (int k = lane; k < nk; k += 64) { const float e = ex2(sch[k] - mx); sch[k] = e; l += e; }
    l = wave_sum(l);
    LDS_SYNC_WAVE();
    if (norm) { const float il = 1.0f / l; for (int k = lane; k < nk; k += 64) sch[k] *= il; }
    return l;
}
__device__ __forceinline__ void fast_dec_nsa3(const Params& p, int i, LAS unsigned char* lds) {
    int tid = threadIdx.x; asm volatile("" : "+v"(tid));
    const int lane = tid & 63, wid = __builtin_amdgcn_readfirstlane(tid >> 6), li = i >> 1;
    static_assert(NSEL_S == 129 && NC_S == 511 && PL % 128 == 0 && LBW == 512 && NTHREADS == 512, "decode NSA is written for PAST_LEN 8192 and 512 threads");
    LAS float* qs = (LAS float*)lds;
    LAS float* sc = (LAS float*)(lds + 2048);
    LAS float* part = (LAS float*)(lds + 30720);
    LAS int* sel = (LAS int*)(lds + 43008);
    LAS int* pgs = sel + 16;
    LAS float* lsum = (LAS float*)(lds + 43264);
#define DEC_OPAQUE_TID() int tid_s = tid; asm volatile("" : "+v"(tid_s)); const int lane_s = tid_s & 63, kq = lane_s >> 4, dq = lane_s & 15; (void)kq; (void)dq
    for (int u = blockIdx.x; u < NS * 2; u += gridDim.x) {
        const int n = u >> 1, kv = u & 1;
        const size_t row = (size_t)(MP + n);
        const int myh = tid >> 6, myd = tid & 63;
        __syncthreads();
        if (tid < 384) qs[tid] = bf2f(p.proj[row * WP + (kv * 6 + myh) * 64 + myd]);
        __syncthreads();
        float oacc = 0.f;
        float4 x[16];
        {
            DEC_OPAQUE_TID();
            const bf16_t* kb = p.kcmp_s + ((size_t)li * NS * 2 + n * 2 + kv) * CSTR * 64;
            ld_row_b16(kb + (size_t)tid_s * 64, x);
            dot6_store(x, qs, sc + tid_s, kv * 6, (float)(PL - (16 * tid_s + 31)), tid_s < NC_S);
        }
        __syncthreads();
        if (wid < 6) (void)dec_softmax(sc + wid * DSTR, 512, true, lane);
        __syncthreads();
        {
            DEC_OPAQUE_TID();
            const bf16_t* vb = p.vcmpt_s + ((size_t)li * NS * 2 + n * 2 + kv) * 64 * CSTR + (size_t)lane_s * CSTR + wid * 64;
            float a[6] = {0.f, 0.f, 0.f, 0.f, 0.f, 0.f};
#pragma unroll 1
            for (int hf = 0; hf < 2; ++hf) {
                float v[32];
#pragma unroll
                for (int j = 0; j < 4; ++j) ld8(vb + 32 * hf + 8 * j, v + 8 * j);
#pragma unroll
                for (int c = 0; c < 32; ++c) {
#pragma unroll
                    for (int h = 0; h < 6; ++h) a[h] += sc[h * DSTR + wid * 64 + 32 * hf + c] * v[c];
                }
            }
#pragma unroll
            for (int h = 0; h < 6; ++h) part[(wid * 6 + h) * 64 + lane_s] = a[h];
        }
        if (wid == 7) {
            unsigned k[3];
#pragma unroll
            for (int t = 0; t < 3; ++t) {
                const int b = lane + 64 * t;
                float a = -1.f;
                if (b < NSEL_S) {
                    a = 0.f;
                    for (int w = 0; w < 6; ++w) {
                        const LAS float* pc = sc + w * DSTR;
#pragma unroll
                        for (int ii = 4 * b; ii < 4 * b + 4; ++ii) { if (ii < 512) a += pc[ii]; if (ii >= 1 && ii - 1 < 512) a += pc[ii - 1]; }
                    }
                    if (b == 0 || b == 128 || b == 127) a = 1e4f;
                }
                k[t] = a < 0.f ? 0u : __float_as_uint(a) + 1u;
            }
            unsigned T = 0u;
            for (int bit = 31; bit >= 0; --bit) {
                const unsigned cand = T | (1u << bit);
                const int cnt = __popcll(__ballot(k[0] >= cand)) + __popcll(__ballot(k[1] >= cand)) + __popcll(__ballot(k[2] >= cand));
                if (cnt >= 16) T = cand;
            }
            const unsigned long long below = (1ull << lane) - 1ull;
            int base = 0; const int ngt = __popcll(__ballot(k[0] > T)) + __popcll(__ballot(k[1] > T)) + __popcll(__ballot(k[2] > T));
            const int need = 16 - ngt;
            int eqbefore = 0;
#pragma unroll
            for (int t = 0; t < 3; ++t) {
                const unsigned long long eqm = __ballot(k[t] == T);
                const bool sl = (k[t] > T) || ((k[t] == T) && (eqbefore + __popcll(eqm & below) < need));
                const unsigned long long sm = __ballot(sl);
                if (sl) { const int slot = base + __popcll(sm & below), b = lane + 64 * t; sel[slot] = b; pgs[slot] = b < 128 ? p.page_table[n * NPAGES + (b >> 1)] : 0; }
                base += __popcll(sm); eqbefore += __popcll(eqm);
            }
        }
        __syncthreads();
        if (tid < 384) {
            float o = 0.f;
#pragma unroll
            for (int w = 0; w < 8; ++w) o += part[(w * 6 + myh) * 64 + myd];
            oacc = o * sigmoid_f(bf2f(p.proj[row * WP + 1536 + (kv * 6 + myh) * 3 + 0]));
        }
#pragma unroll 1
        for (int t = 0; t < 2; ++t) {
            DEC_OPAQUE_TID();
            const int key = tid_s + 512 * t, s = key >> 6, j = key & 63, b = sel[s], page = pgs[s];
            if (b < 128) {
                ld_row_f32(p.cache_b_pages + ((((size_t)page * 128 + (b & 1) * 64 + j) * 2 + li) * 4 + 2) * 128 + kv * 64, x);
                dot6_store(x, qs, sc + key, kv * 6, (float)(PL - (b * 64 + j)), true);
            } else if (j == 0) {
                ld_row_b16(p.proj + row * WP + 768 + 2 * 128 + kv * 64, x);
                dot6_store(x, qs, sc + key, kv * 6, 0.f, true);
            } else {
#pragma unroll
                for (int h = 0; h < 6; ++h) sc[h * DSTR + key] = -INFINITY;
            }
        }
        __syncthreads();
        if (wid < 6) { const float l = dec_softmax(sc + wid * DSTR, 1024, false, lane); if (lane == 0) lsum[wid] = l; }
        __syncthreads();
        {
            DEC_OPAQUE_TID();
            float4 a[6];
#pragma unroll
            for (int h = 0; h < 6; ++h) a[h] = make_float4(0.f, 0.f, 0.f, 0.f);
#pragma unroll 1
            for (int ss = 0; ss < 2; ++ss) {
                const int s = 2 * wid + ss, b = sel[s], page = pgs[s];
                if (b < 128) {
                    const float* vb = p.cache_b_pages + ((((size_t)page * 128 + (b & 1) * 64 + kq) * 2 + li) * 4 + 3) * 128 + kv * 64 + 4 * dq;
#pragma unroll 4
                    for (int t = 0; t < 16; ++t) {
                        const float4 v = *(const float4*)(vb + (size_t)(4 * t) * 1024);
#pragma unroll
                        for (int h = 0; h < 6; ++h) { const float pr = sc[h * DSTR + s * 64 + 4 * t + kq]; a[h].x += pr * v.x; a[h].y += pr * v.y; a[h].z += pr * v.z; a[h].w += pr * v.w; }
                    }
                } else if (kq == 0) {
                    const uint2 w2 = *(const uint2*)(p.proj + row * WP + 768 + 3 * 128 + kv * 64 + 4 * dq);
                    const float4 v = make_float4(__uint_as_float(w2.x << 16), __uint_as_float(w2.x & 0xffff0000u), __uint_as_float(w2.y << 16), __uint_as_float(w2.y & 0xffff0000u));
#pragma unroll
                    for (int h = 0; h < 6; ++h) { const float pr = sc[h * DSTR + s * 64]; a[h].x += pr * v.x; a[h].y += pr * v.y; a[h].z += pr * v.z; a[h].w += pr * v.w; }
                }
            }
#pragma unroll
            for (int h = 0; h < 6; ++h) {
                pv4_reduce(a[h]);
                if (kq == 0) { part[(wid * 6 + h) * 64 + 4 * dq + 0] = a[h].x; part[(wid * 6 + h) * 64 + 4 * dq + 1] = a[h].y; part[(wid * 6 + h) * 64 + 4 * dq + 2] = a[h].z; part[(wid * 6 + h) * 64 + 4 * dq + 3] = a[h].w; }
            }
        }
        __syncthreads();
        if (tid < 384) {
            float o = 0.f;
#pragma unroll
            for (int w = 0; w < 8; ++w) o += part[(w * 6 + myh) * 64 + myd];
            oacc += sigmoid_f(bf2f(p.proj[row * WP + 1536 + (kv * 6 + myh) * 3 + 1])) * o / lsum[myh];
        }
        __syncthreads();
        {
            DEC_OPAQUE_TID();
            const float* wb = p.cache_b_win + ((size_t)li * NS + n) * LBW * 256 + kv * 64;
            ld_row_f32(wb + (size_t)tid_s * 256, x);
            dot6_store(x, qs, sc + tid_s, kv * 6, (float)(512 - tid_s), true);
            if (tid_s == 0) {
                ld_row_b16(p.proj + row * WP + 768 + 4 * 128 + kv * 64, x);
                dot6_store(x, qs, sc + 512, kv * 6, 0.f, true);
            }
        }
        __syncthreads();
        if (wid < 6) { const float l = dec_softmax(sc + wid * DSTR, 513, false, lane); if (lane == 0) lsum[wid] = l; }
        __syncthreads();
        {
            DEC_OPAQUE_TID();
            const float* wb = p.cache_b_win + ((size_t)li * NS + n) * LBW * 256 + 128 + kv * 64;
            float4 a[6];
#pragma unroll
            for (int h = 0; h < 6; ++h) a[h] = make_float4(0.f, 0.f, 0.f, 0.f);
            const float* vb = wb + (size_t)(wid * 64 + kq) * 256 + 4 * dq;
#pragma unroll 4
            for (int t = 0; t < 16; ++t) {
                const float4 v = *(const float4*)(vb + (size_t)(4 * t) * 256);
#pragma unroll
                for (int h = 0; h < 6; ++h) { const float pr = sc[h * DSTR + wid * 64 + 4 * t + kq]; a[h].x += pr * v.x; a[h].y += pr * v.y; a[h].z += pr * v.z; a[h].w += pr * v.w; }
            }
            if (wid == 0 && kq == 0) {
                const uint2 w2 = *(const uint2*)(p.proj + row * WP + 768 + 5 * 128 + kv * 64 + 4 * dq);
                const float4 v = make_float4(__uint_as_float(w2.x << 16), __uint_as_float(w2.x & 0xffff0000u), __uint_as_float(w2.y << 16), __uint_as_float(w2.y & 0xffff0000u));
#pragma unroll
                for (int h = 0; h < 6; ++h) { const float pr = sc[h * DSTR + 512]; a[h].x += pr * v.x; a[h].y += pr * v.y; a[h].z += pr * v.z; a[h].w += pr * v.w; }
            }
#pragma unroll
            for (int h = 0; h < 6; ++h) {
                pv4_reduce(a[h]);
                if (kq == 0) { part[(wid * 6 + h) * 64 + 4 * dq + 0] = a[h].x; part[(wid * 6 + h) * 64 + 4 * dq + 1] = a[h].y; part[(wid * 6 + h) * 64 + 4 * dq + 2] = a[h].z; part[(wid * 6 + h) * 64 + 4 * dq + 3] = a[h].w; }
            }
        }
        __syncthreads();
        if (tid < 384) {
            float o = 0.f;
#pragma unroll
            for (int w = 0; w < 8; ++w) o += part[(w * 6 + myh) * 64 + myd];
            oacc += sigmoid_f(bf2f(p.proj[row * WP + 1536 + (kv * 6 + myh) * 3 + 2])) * o / lsum[myh];
            const int hd = kv * 6 + myh;
            p.z[row * 1024 + hd * 64 + myd] = f2bf(oacc * silu_f(bf2f(p.proj[row * WP + 1572 + hd * 64 + myd])));
        }
    }
    __syncthreads();
#undef DEC_OPAQUE_TID
}


__global__ void __launch_bounds__(NTHREADS, 2) mega(Params p) {
    extern __shared__ __attribute__((aligned(16))) unsigned char smem[];
    LAS unsigned char* lds = (LAS unsigned char*)smem;
    volatile LAS unsigned* xbw = (volatile LAS unsigned*)(lds + LDS_STAGE);
    if (threadIdx.x == 0) { xbw[0] = 0u; xbw[1] = 0u; xbw[2] = 0u; xbw[3] = 0u; }
    __syncthreads();
    XcdBarrier bar = xcd_barrier_post(p.bar, xbw);
#define BAR() xcd_barrier(bar)
#define STG(call) do { __syncthreads(); call; } while (0)
#define NVRUN(fn, ...) do { int t_ = threadIdx.x; asm volatile("" : "+v"(t_)); fn(__VA_ARGS__, (long)blockIdx.x * NTHREADS + t_, (long)gridDim.x * NTHREADS); } while (0)
    STG(fast_prep_weights(p, lds)); STG(fast_prep_x(p)); BAR();
    STG(fast_memkv(p)); STG(fast_inproj(p, 0, lds)); BAR();
    STG(fast_post(p, 0)); BAR();
    for (int i = 0; i < 4; ++i) {
        if (i > 0) { STG(fast_inproj(p, i, lds)); BAR(); STG(fast_post(p, i)); if (i & 1) fast_pq_p(p, i >> 1); BAR(); }
        if ((i & 1) == 0) { STG(fast_dec_a(p, i, lds)); fast_attn_a(p, i, i == 0); fast_cross_a(p, i); BAR();     }
        else {
            STG(fast_cmpc_p(p, i >> 1)); BAR();
            STG(fast_dec_nsa3(p, i, lds)); STG(fast_dec_cross_b(p, i, lds)); fast_nsa_prompt(p, i, lds); fast_cross_b(p, i); BAR();
        }
        STG(fast_outproj(p, i, lds)); if (i == 0) STG(fast_pq_s(p, lds)); BAR();
        STG(fast_finish(p, i)); if (i == 0) STG(fast_cmpc_s(p)); if (i < 3) BAR();
    }
}

extern "C" void kernel_launch(void* const* d_in, const int* in_sizes, int n_in,
                              void* d_out, int out_size, void* d_ws, size_t ws_size,
                              hipStream_t stream) {
    static int grid = 0;
    if (grid == 0) {
        int dev = 0, cus = 0, per_cu = 0;
        if (hipGetDevice(&dev) != hipSuccess || hipDeviceGetAttribute(&cus, hipDeviceAttributeMultiprocessorCount, dev) != hipSuccess) { grid = -1; return; }
        if (hipFuncSetAttribute((const void*)mega, hipFuncAttributeMaxDynamicSharedMemorySize, LDS_BYTES) != hipSuccess) { grid = -1; return; }
        if (hipOccupancyMaxActiveBlocksPerMultiprocessor(&per_cu, (const void*)mega, NTHREADS, LDS_BYTES) != hipSuccess || per_cu < 1) { (void)hipGetLastError(); }
        grid = cus;
    }
    if (grid < 0) return;
    Params p; fill_params(p, d_in, d_out, d_ws);
    (void)hipMemsetAsync(p.bar, 0, 4096 * sizeof(unsigned), stream);
    hipLaunchKernelGGL(mega, dim3(grid), dim3(NTHREADS), LDS_BYTES, stream, p);
}
```
